# Optimizing an MI355X kernel written in HIP

```python
import math
import jax, jax.numpy as jnp
from jax import lax
import numpy as np

D_MODEL = 1024
BATCH = 16
SEQ = 4096
DEPTH = 1

HEAD_DIM = 64
FOX_HEADS = 8
FOX_WIDTH = FOX_HEADS * HEAD_DIM
DIFF_HEADS = 4
DIFF_QK_WIDTH = DIFF_HEADS * 2 * HEAD_DIM
DIFF_V_DIM = 2 * HEAD_DIM
DIFF_V_WIDTH = DIFF_HEADS * DIFF_V_DIM
IN_WIDTH = 3 * FOX_WIDTH + FOX_HEADS + 2 * DIFF_QK_WIDTH + DIFF_V_WIDTH + 2 * D_MODEL
MEM_LEN = 256
CROSS_HEADS = 4
CROSS_WIDTH = CROSS_HEADS * HEAD_DIM
N_GROUPS = 4
EXPERTS_PER_GROUP = 8
N_EXPERTS = N_GROUPS * EXPERTS_PER_GROUP
TOP_K = 2
D_FF_EXPERT = 512
MOE_BLOCK = 256
Q_BLOCK = 128
ROPE_THETA = 10000.0
NORM_EPS = 1e-6
SUBLN_EPS = 1e-5
FGATE_BIAS_INIT = 3.0

kernel_name = 'hybrid_fox_diffattn_hmoe_block'


def _rms_norm(t, g, eps=NORM_EPS):
    tf = t.astype(jnp.float32)
    tf = tf * lax.rsqrt(jnp.mean(tf * tf, axis=-1, keepdims=True) + eps)
    return (tf * g.astype(jnp.float32)).astype(t.dtype)


def _split_heads(t, n):
    b, s, w = t.shape
    return t.reshape(b, s, n, w // n).transpose(0, 2, 1, 3)


def _merge_heads(t):
    b, h, s, d = t.shape
    return t.transpose(0, 2, 1, 3).reshape(b, s, h * d)


def _in_offsets():
    sizes = (FOX_WIDTH, FOX_WIDTH, FOX_WIDTH, FOX_HEADS, DIFF_QK_WIDTH, DIFF_QK_WIDTH,
             DIFF_V_WIDTH, D_MODEL, D_MODEL)
    return [int(o) for o in np.cumsum(sizes)[:-1]]


def _rope_tables(positions, dtype):
    half = HEAD_DIM // 2
    inv_freq = ROPE_THETA ** (-jnp.arange(half, dtype=jnp.float32) * 2.0 / HEAD_DIM)
    ang = positions.astype(jnp.float32)[..., None] * inv_freq
    cos = jnp.cos(ang)[:, :, None, None, :].astype(dtype)
    sin = jnp.sin(ang)[:, :, None, None, :].astype(dtype)
    return cos, sin


def _rope(t, cos, sin):
    half = t.shape[-1] // 2
    t1, t2 = t[..., :half], t[..., half:]
    return jnp.concatenate([t1 * cos - t2 * sin, t2 * cos + t1 * sin], axis=-1)


def _causal_mask(q0, q1):
    qpos = q0 + jnp.arange(q1 - q0)
    kpos = jnp.arange(q1)
    return qpos[:, None] >= kpos[None, :]


def _fox_attention(q, k, v, log_f):
    c = jnp.cumsum(log_f, axis=-1)
    scale = HEAD_DIM ** -0.5
    n_q = q.shape[2]
    outs = []
    for blk in range(n_q // Q_BLOCK):
        q0, q1 = blk * Q_BLOCK, (blk + 1) * Q_BLOCK
        s = jnp.einsum('bhqd,bhkd->bhqk', q[:, :, q0:q1], k[:, :, :q1]).astype(jnp.float32) * scale
        s = s + c[:, :, q0:q1, None] - c[:, :, None, :q1]
        s = jnp.where(_causal_mask(q0, q1), s, -jnp.inf)
        p = jax.nn.softmax(s, axis=-1).astype(v.dtype)
        outs.append(jnp.einsum('bhqk,bhkd->bhqd', p, v[:, :, :q1]))
    return jnp.concatenate(outs, axis=2)


def _diff_attention(q1, q2, k1, k2, v, lam):
    scale = HEAD_DIM ** -0.5
    n_q = q1.shape[2]
    outs = []
    for blk in range(n_q // Q_BLOCK):
        q0, qe = blk * Q_BLOCK, (blk + 1) * Q_BLOCK
        mask = _causal_mask(q0, qe)
        s1 = jnp.einsum('bhqd,bhkd->bhqk', q1[:, :, q0:qe], k1[:, :, :qe]).astype(jnp.float32) * scale
        s2 = jnp.einsum('bhqd,bhkd->bhqk', q2[:, :, q0:qe], k2[:, :, :qe]).astype(jnp.float32) * scale
        p1 = jax.nn.softmax(jnp.where(mask, s1, -jnp.inf), axis=-1)
        p2 = jax.nn.softmax(jnp.where(mask, s2, -jnp.inf), axis=-1)
        a = (p1 - lam * p2).astype(v.dtype)
        outs.append(jnp.einsum('bhqk,bhkd->bhqd', a, v[:, :, :qe]))
    return jnp.concatenate(outs, axis=2)


def _cross_attention(hx, hm, w_q, w_kv, w_o):
    b, m = hm.shape[0], hm.shape[1]
    q = _split_heads(hx @ w_q, CROSS_HEADS)
    kv = (hm @ w_kv).reshape(b, m, 2, CROSS_HEADS, HEAD_DIM)
    k = kv[:, :, 0].transpose(0, 2, 1, 3)
    v = kv[:, :, 1].transpose(0, 2, 1, 3)
    s = jnp.einsum('bhsd,bhmd->bhsm', q, k).astype(jnp.float32) * HEAD_DIM ** -0.5
    p = jax.nn.softmax(s, axis=-1).astype(v.dtype)
    return _merge_heads(jnp.einsum('bhsm,bhmd->bhsd', p, v)) @ w_o


def _routed_experts(t, expert_ids, gate_w, w_gate, w_up, w_down):
    n_tok, d = t.shape
    n_assign = n_tok * TOP_K
    flat_e = expert_ids.reshape(n_assign).astype(jnp.int32)
    flat_tok = jnp.arange(n_assign, dtype=jnp.int32) // TOP_K
    flat_w = gate_w.reshape(n_assign)
    order = jnp.argsort(flat_e)
    e_sorted = flat_e[order]
    counts = jnp.zeros((N_EXPERTS,), jnp.int32).at[flat_e].add(1)
    padded = (counts + MOE_BLOCK - 1) // MOE_BLOCK * MOE_BLOCK
    pad_end = jnp.cumsum(padded)
    pad_start = pad_end - padded
    seg_start = jnp.cumsum(counts) - counts
    dest = pad_start[e_sorted] + jnp.arange(n_assign, dtype=jnp.int32) - seg_start[e_sorted]
    n_blocks = -(-n_assign // MOE_BLOCK) + N_EXPERTS
    n_rows = n_blocks * MOE_BLOCK
    row_tok = jnp.full((n_rows,), n_tok, jnp.int32).at[dest].set(flat_tok[order])
    row_w = jnp.zeros((n_rows,), t.dtype).at[dest].set(flat_w[order])
    block_start = jnp.arange(n_blocks, dtype=jnp.int32) * MOE_BLOCK
    block_expert = jnp.minimum(jnp.searchsorted(pad_end, block_start, side='right'), N_EXPERTS - 1)
    t_pad = jnp.concatenate([t, jnp.zeros((1, d), t.dtype)], axis=0)
    xs = t_pad[row_tok].reshape(n_blocks, MOE_BLOCK, d)

    def expert_block(args):
        xb, e = args
        hb = jax.nn.silu(xb @ w_gate[e]) * (xb @ w_up[e])
        return hb @ w_down[e]

    ys = lax.map(expert_block, (xs, block_expert)).reshape(n_rows, d)
    out = jnp.zeros((n_tok + 1, d), t.dtype).at[row_tok].add(ys * row_w[:, None])
    return out[:n_tok]


def _hier_moe(t, w_group, b_group, w_expert, b_expert, w_gate, w_up, w_down):
    n_tok = t.shape[0]
    group_logits = (t @ w_group + b_group).astype(jnp.float32)
    group_prob = jax.nn.softmax(group_logits, axis=-1)
    g_sel = jnp.argmax(group_logits, axis=-1)
    g_w = jnp.take_along_axis(group_prob, g_sel[:, None], axis=-1)
    exp_logits = (t @ w_expert + b_expert).astype(jnp.float32).reshape(n_tok, N_GROUPS, EXPERTS_PER_GROUP)
    sel_logits = jnp.take_along_axis(exp_logits, g_sel[:, None, None], axis=1)[:, 0]
    top_vals, top_idx = lax.top_k(sel_logits, TOP_K)
    weights = jax.nn.softmax(top_vals, axis=-1) * g_w
    expert_ids = g_sel[:, None].astype(jnp.int32) * EXPERTS_PER_GROUP + top_idx.astype(jnp.int32)
    return _routed_experts(t, expert_ids, weights.astype(t.dtype), w_gate, w_up, w_down)


def setup_inputs(seed: int = 0) -> dict:
    key = jax.random.key(seed)
    ks = jax.random.split(key, 32)
    f32 = jnp.float32
    L = DEPTH

    def nrm(k, shape, fan_in):
        return jax.random.normal(k, shape, f32) * fan_in ** -0.5

    def gain(k, shape):
        return 1.0 + 0.02 * jax.random.normal(k, shape, f32)

    return {
        'x': jax.random.normal(ks[0], (BATCH, SEQ, D_MODEL), f32),
        'mem': jax.random.normal(ks[1], (BATCH, MEM_LEN, D_MODEL), f32),
        'positions': jnp.broadcast_to(jnp.arange(SEQ, dtype=jnp.int32), (BATCH, SEQ)),
        'g_mix': gain(ks[2], (L, D_MODEL)),
        'w_in': nrm(ks[3], (L, D_MODEL, IN_WIDTH), D_MODEL),
        'b_fgate': FGATE_BIAS_INIT + 0.1 * jax.random.normal(ks[4], (L, FOX_HEADS), f32),
        'w_branch_a': nrm(ks[5], (L, FOX_WIDTH, D_MODEL), FOX_WIDTH),
        'w_branch_b': nrm(ks[6], (L, DIFF_V_WIDTH, D_MODEL), DIFF_V_WIDTH),
        'w_out': nrm(ks[7], (L, D_MODEL, D_MODEL), D_MODEL),
        'lambda_q1': 0.1 * jax.random.normal(ks[8], (L, HEAD_DIM), f32),
        'lambda_k1': 0.1 * jax.random.normal(ks[9], (L, HEAD_DIM), f32),
        'lambda_q2': 0.1 * jax.random.normal(ks[10], (L, HEAD_DIM), f32),
        'lambda_k2': 0.1 * jax.random.normal(ks[11], (L, HEAD_DIM), f32),
        'g_diff_sub': gain(ks[12], (L, DIFF_V_DIM)),
        'g_cross': gain(ks[13], (L, D_MODEL)),
        'g_mem': gain(ks[14], (L, D_MODEL)),
        'w_cq': nrm(ks[15], (L, D_MODEL, CROSS_WIDTH), D_MODEL),
        'w_ckv': nrm(ks[16], (L, D_MODEL, 2 * CROSS_WIDTH), D_MODEL),
        'w_co': nrm(ks[17], (L, CROSS_WIDTH, D_MODEL), CROSS_WIDTH),
        'g_ffn': gain(ks[18], (L, D_MODEL)),
        'w_group': nrm(ks[19], (L, D_MODEL, N_GROUPS), D_MODEL),
        'b_group': 0.01 * jax.random.normal(ks[20], (L, N_GROUPS), f32),
        'w_expert': nrm(ks[21], (L, D_MODEL, N_EXPERTS), D_MODEL),
        'b_expert': 0.01 * jax.random.normal(ks[22], (L, N_EXPERTS), f32),
        'w_exp_gate': nrm(ks[23], (L, N_EXPERTS, D_MODEL, D_FF_EXPERT), D_MODEL),
        'w_exp_up': nrm(ks[24], (L, N_EXPERTS, D_MODEL, D_FF_EXPERT), D_MODEL),
        'w_exp_down': nrm(ks[25], (L, N_EXPERTS, D_FF_EXPERT, D_MODEL), D_FF_EXPERT),
        'g_final': gain(ks[26], (D_MODEL,)),
    }


def reference(x, mem, positions, g_mix, w_in, b_fgate, w_branch_a, w_branch_b, w_out,
              lambda_q1, lambda_k1, lambda_q2, lambda_k2, g_diff_sub, g_cross, g_mem,
              w_cq, w_ckv, w_co, g_ffn, w_group, b_group, w_expert, b_expert,
              w_exp_gate, w_exp_up, w_exp_down, g_final):
    b, s, d = x.shape
    cos, sin = _rope_tables(positions, x.dtype)
    offsets = _in_offsets()
    for l in range(DEPTH):
        lambda_init = 0.8 - 0.6 * math.exp(-0.3 * l)
        h = _rms_norm(x, g_mix[l])
        fq, fk, fv, f_logit, dq, dk, dv, gate_a, gate_b = jnp.split(h @ w_in[l], offsets, axis=-1)
        log_f = jax.nn.log_sigmoid((f_logit + b_fgate[l]).astype(jnp.float32)).transpose(0, 2, 1)
        y_a = _fox_attention(_split_heads(fq, FOX_HEADS), _split_heads(fk, FOX_HEADS),
                             _split_heads(fv, FOX_HEADS), log_f)
        y_a = _merge_heads(y_a)
        dq = _rope(dq.reshape(b, s, DIFF_HEADS, 2, HEAD_DIM), cos, sin)
        dk = _rope(dk.reshape(b, s, DIFF_HEADS, 2, HEAD_DIM), cos, sin)
        lam = (jnp.exp(jnp.sum(lambda_q1[l].astype(jnp.float32) * lambda_k1[l].astype(jnp.float32)))
               - jnp.exp(jnp.sum(lambda_q2[l].astype(jnp.float32) * lambda_k2[l].astype(jnp.float32)))
               + lambda_init)
        y_b = _diff_attention(dq[:, :, :, 0].transpose(0, 2, 1, 3), dq[:, :, :, 1].transpose(0, 2, 1, 3),
                              dk[:, :, :, 0].transpose(0, 2, 1, 3), dk[:, :, :, 1].transpose(0, 2, 1, 3),
                              _split_heads(dv, DIFF_HEADS), lam)
        y_b = _merge_heads(_rms_norm(y_b, g_diff_sub[l], SUBLN_EPS) * (1.0 - lambda_init))
        merged = (jax.nn.sigmoid(gate_a) * (y_a @ w_branch_a[l])
                  + jax.nn.sigmoid(gate_b) * (y_b @ w_branch_b[l]))
        x = x + merged @ w_out[l]
        x = x + _cross_attention(_rms_norm(x, g_cross[l]), _rms_norm(mem, g_mem[l]),
                                 w_cq[l], w_ckv[l], w_co[l])
        hm = _rms_norm(x, g_ffn[l]).reshape(b * s, d)
        x = x + _hier_moe(hm, w_group[l], b_group[l], w_expert[l], b_expert[l],
                          w_exp_gate[l], w_exp_up[l], w_exp_down[l]).reshape(b, s, d)
    return _rms_norm(x, g_final)
```

```cpp
#include <hip/hip_runtime.h>
#include <stdint.h>
#include <math.h>
#include <stdio.h>

typedef unsigned short bf16_t;
constexpr int T_ = 65536, D_ = 1024, S_ = 4096, B_ = 16, INW = 5128, MEML = 256;
constexpr float LOG2E = 1.4426950408889634f;
constexpr float C2 = 0.125f * LOG2E;
constexpr size_t MiB = 1u << 20;
constexpr size_t WS_CTL = 0;
constexpr size_t WS_LOGF = 2 * MiB;
constexpr size_t WS_KAUG = 4 * MiB;
constexpr size_t WS_ROPE = 8 * MiB;
constexpr size_t WS_MKV = 24 * MiB;
constexpr size_t WS_MEMN = 28 * MiB;
constexpr size_t WS_QC = 36 * MiB;
constexpr size_t WS_OC = 68 * MiB;
constexpr size_t WS_LTOK = 100 * MiB;
constexpr size_t WS_LW = 108 * MiB;
constexpr size_t WS_WT = 128 * MiB;
constexpr size_t WS_R1 = 240 * MiB;
constexpr size_t WS_FQ = 368 * MiB, WS_FK = 432 * MiB, WS_FV = 496 * MiB, WS_DQ = 560 * MiB, WS_DK = 624 * MiB, WS_DV = 688 * MiB;
constexpr size_t WS_Y = 752 * MiB;
constexpr size_t WS_OD = 880 * MiB;
constexpr size_t WS_YS = 368 * MiB;
constexpr size_t WS_H = 752 * MiB;
constexpr size_t WS_RAW = 752 * MiB;

__device__ __forceinline__ float bf2f(bf16_t h) { return __uint_as_float(((unsigned)h) << 16); }
__device__ __forceinline__ bf16_t f2bf(float f) { unsigned u = __float_as_uint(f); u += 0x7fffu + ((u >> 16) & 1u); return (bf16_t)(u >> 16); }
__device__ __forceinline__ float wave_sum(float v) {
#pragma unroll
    for (int o = 1; o < 64; o <<= 1) v += __shfl_xor(v, o);
    return v;
}
__device__ __forceinline__ float sigmoidf_(float x) { return 1.f / (1.f + __expf(-x)); }

namespace pg8 {
#define PG8_LAS __attribute__((address_space(3)))
typedef short bf16x8 __attribute__((ext_vector_type(8)));
typedef float f32x4 __attribute__((ext_vector_type(4)));
typedef unsigned u32x4 __attribute__((ext_vector_type(4)));
typedef int v4i __attribute__((ext_vector_type(4)));
typedef int v8i __attribute__((ext_vector_type(8)));
constexpr int BM = 256, BK = 64, HALF = 128, HTB = HALF * BK * 2  , STAGE_BYTES = 8 * HTB, NXCD = 8, WGM = 8;

__host__ __device__ __forceinline__ int lds_byte(int r, int c) { const int st = (r >> 4) * 2 + (c >> 5), rr = r & 15, cc = c & 31, ob = rr * 64 + cc * 2; return st * 1024 + (ob ^ (((ob >> 9) & 1) << 5)); }
__host__ __device__ __forceinline__ void stage_rc(int b, int& R, int& C) { const int st = b / 1024, sb = b % 1024, swz = sb ^ (((sb >> 9) & 1) << 5); R = (st >> 1) * 16 + swz / 64; C = (st & 1) * 32 + (swz % 64) / 2; }
__host__ __device__ __forceinline__ int perm32(int rho) { const int n = rho >> 4, i = rho & 15; return 8 * (i >> 2) + 4 * n + (i & 3); }

struct Unit { int pm, pn, e, rt; };
struct Gemm { const bf16_t* A; const bf16_t* Bt; int lda, ldb, K; };

struct StaticOrder {
    static constexpr bool GATHER = false;
    int nM, nN, nwg, G, c;
    __host__ __device__ void init(int M, int N, int G_, int c_) { nM = M / BM; nN = N / BM; nwg = nM * nN; G = G_; c = c_; }
    __host__ __device__ bool next(int i, Unit& u) const {
        const long L = (long)i * G + c; if (L >= nwg) return false;
        int wgid = (int)L; { const int q = nwg / NXCD, r = nwg % NXCD, xcd = wgid % NXCD, off = wgid / NXCD; wgid = (xcd < r ? xcd * (q + 1) : r * (q + 1) + (xcd - r) * q) + off; }
        const int nig = WGM * nN, gid = wgid / nig, fm = gid * WGM, gsz = (nM - fm) < WGM ? (nM - fm) : WGM;
        u.pm = fm + ((wgid % nig) % gsz); u.pn = (wgid % nig) / gsz; u.e = 0; u.rt = 0; return true;
    }
    __device__ __forceinline__ unsigned arow(const Unit&, int) const { return 0u; }
};
struct PanelOrder {
    static constexpr bool GATHER = false;
    int pm, nN;
    __device__ bool next(int i, Unit& u) const { if (i >= nN) return false; u.pm = pm; u.pn = i; u.e = 0; u.rt = 0; return true; }
    __device__ __forceinline__ unsigned arow(const Unit&, int) const { return 0u; }
};

__device__ __forceinline__ unsigned cvt_pk_bf16(float lo, float hi) { unsigned r; asm volatile("v_cvt_pk_bf16_f32 %0, %1, %2" : "=v"(r) : "v"(lo), "v"(hi)); return r; }

template <class Epi, class Sched, bool ALIGN_EPI, bool FP8 = false>
__device__ __forceinline__ void gemm_phase(PG8_LAS unsigned char* lds, const Gemm g, const Sched& S, const Epi& E) {
    int tid_ = threadIdx.x; asm volatile("" : "+v"(tid_));
    const int tid = tid_, wid = __builtin_amdgcn_readfirstlane(tid >> 6), lane = tid & 63, wr = wid >> 2, wc = wid & 3, fr = lane & 15, fq = lane >> 4;
    const int K = g.K, nt = K / BK;
    int Rr[2], Cc[2]; unsigned voffB[2];
#pragma unroll
    for (int i = 0; i < 2; ++i) { int R, C; stage_rc(tid * 16 + i * 8192, R, C); const int Rb = Epi::PERM ? ((R & ~31) + perm32(R & 31)) : R;
        Rr[i] = R; Cc[i] = C; voffB[i] = (unsigned)(Rb * g.ldb + C) * 2u; }
    const size_t kstep = (size_t)(BK * 2);
    const unsigned hstepA = (unsigned)HALF * (unsigned)g.lda * 2u;
    const size_t tstepA = (size_t)2 * hstepA;
    const size_t hstepB = (size_t)HALF * g.ldb * 2, tstepB = 2 * hstepB;
    const unsigned ldsw = (unsigned)wid * 1024u;
    const int aoff = lds_byte(wr * 64 + fr, fq * 8), boff = lds_byte(wc * 32 + fr, fq * 8);
#define PG8_SA(b, h) (((b) * 2 + (h)) * HTB)
#define PG8_SB(b, h) ((4 + (b) * 2 + (h)) * HTB)
#define PG8_GAS __attribute__((address_space(1)))
#define PG8_STAGE(bufoff, gbase, voff) do { _Pragma("unroll") for (int _i = 0; _i < 2; ++_i) \
        __builtin_amdgcn_global_load_lds((const unsigned*)((const char*)(gbase) + (voff)[_i]), (PG8_LAS unsigned*)(lds + (bufoff) + ldsw + _i * 8192), 16, 0, 0); } while (0)
#define PG8_LDA(dst, b, h) do { _Pragma("unroll") for (int m = 0; m < 4; ++m) { dst[m].lo = *(const PG8_LAS v4i*)(lds + PG8_SA(b, h) + aoff + m * 2048); dst[m].hi = *(const PG8_LAS v4i*)(lds + PG8_SA(b, h) + aoff + m * 2048 + 1024); } } while (0)
#define PG8_LDB(dst, b, h) do { _Pragma("unroll") for (int n = 0; n < 2; ++n) { dst[n].lo = *(const PG8_LAS v4i*)(lds + PG8_SB(b, h) + boff + n * 2048); dst[n].hi = *(const PG8_LAS v4i*)(lds + PG8_SB(b, h) + boff + n * 2048 + 1024); } } while (0)
#define PG8_MMA(ai, bj, At, Bt) do { __builtin_amdgcn_s_setprio(1); _Pragma("unroll") for (int m = 0; m < 4; ++m) _Pragma("unroll") for (int n = 0; n < 2; ++n) { \
        if constexpr (FP8) asm volatile("v_mfma_f32_16x16x128_f8f6f4 %0, %1, %2, %0" : "+v"(acc[ai][bj][m][n]) : "v"(Bt[n]), "v"(At[m])); \
        else { const v4i bl_ = Bt[n].lo, bh_ = Bt[n].hi, al_ = At[m].lo, ah_ = At[m].hi;     \
               acc[ai][bj][m][n] = __builtin_amdgcn_mfma_f32_16x16x32_bf16(__builtin_bit_cast(bf16x8, bl_), __builtin_bit_cast(bf16x8, al_), acc[ai][bj][m][n], 0, 0, 0); \
               acc[ai][bj][m][n] = __builtin_amdgcn_mfma_f32_16x16x32_bf16(__builtin_bit_cast(bf16x8, bh_), __builtin_bit_cast(bf16x8, ah_), acc[ai][bj][m][n], 0, 0, 0); } } __builtin_amdgcn_s_setprio(0); } while (0)
#define PG8_WAIT_V(n) asm volatile("s_waitcnt vmcnt(" #n ")" ::: "memory")
#define PG8_WAIT_L(n) asm volatile("s_waitcnt lgkmcnt(" #n ")" ::: "memory")
#define PG8_BAR __builtin_amdgcn_s_barrier()
#define PG8_SCHED __builtin_amdgcn_sched_barrier(0)
#define PG8_VOFF(u, v0, v1) do { _Pragma("unroll") for (int _i = 0; _i < 2; ++_i) { \
        if (Sched::GATHER) { v0[_i] = (S.arow(u, Rr[_i]) * (unsigned)g.lda + (unsigned)Cc[_i]) * 2u; v1[_i] = (S.arow(u, Rr[_i] + HALF) * (unsigned)g.lda + (unsigned)Cc[_i]) * 2u; } \
        else { v0[_i] = (unsigned)(Rr[_i] * g.lda + Cc[_i]) * 2u; v1[_i] = v0[_i] + hstepA; } } } while (0)
    Unit cur, nxt; int ui = 0;
    if (!S.next(0, cur)) return;
    unsigned pf_sink = 0u;
    f32x4 acc[2][2][4][2];
#pragma unroll
    for (int a = 0; a < 2; ++a)
#pragma unroll
        for (int b = 0; b < 2; ++b)
#pragma unroll
            for (int m = 0; m < 4; ++m)
#pragma unroll
                for (int n = 0; n < 2; ++n) acc[a][b][m][n] = (f32x4){0.f, 0.f, 0.f, 0.f};
    v8i At[4], B0[2], B1[2];
    unsigned cv0[2], cv1[2], nv0[2], nv1[2];
    PG8_VOFF(cur, cv0, cv1);
    const char* cA = (const char*)g.A + (Sched::GATHER ? (size_t)0 : (size_t)cur.pm * tstepA); const char* cB = (const char*)g.Bt + (size_t)cur.pn * tstepB;
    PG8_STAGE(PG8_SB(0, 0), cB, voffB); PG8_STAGE(PG8_SB(0, 1), cB + hstepB, voffB); PG8_STAGE(PG8_SA(0, 0), cA, cv0); PG8_STAGE(PG8_SA(0, 1), cA, cv1);
    if (wr == 1) PG8_BAR;
    PG8_WAIT_V(2); PG8_BAR;
    PG8_STAGE(PG8_SB(1, 0), cB + kstep, voffB); PG8_STAGE(PG8_SA(1, 0), cA + kstep, cv0); PG8_STAGE(PG8_SB(1, 1), cB + hstepB + kstep, voffB);
    PG8_WAIT_V(6); PG8_BAR;
    for (;;) {
        const bool has_next = S.next(ui + 1, nxt);
        const char* nA = has_next ? ((const char*)g.A + (Sched::GATHER ? (size_t)0 : (size_t)nxt.pm * tstepA)) : cA; const char* nB = has_next ? (const char*)g.Bt + (size_t)nxt.pn * tstepB : cB;
        if (has_next) { PG8_VOFF(nxt, nv0, nv1); } else {
#pragma unroll
            for (int i = 0; i < 2; ++i) { nv0[i] = cv0[i]; nv1[i] = cv1[i]; } }
#pragma nounroll
        for (int t = 0; t < nt; t += 2) {
            const bool last = (t == nt - 2);
            if constexpr (Epi::HAS_PF) { if (t == (nt > 6 ? nt - 6 : 0)) E.prefetch(cur, wr, wc, fr, fq, pf_sink, false); if (Epi::HAS_MID && t == (nt / 2 > 4 ? nt / 2 - 4 : 0)) E.prefetch(cur, wr, wc, fr, fq, pf_sink, true); }
            if constexpr (Epi::HAS_MID) { if (t == nt / 2) E.mid(acc, cur, wr, wc, fr, fq); }
            const char* a1 = cA + (size_t)(t + 1) * kstep;
            const char* a2 = last ? nA : cA + (size_t)(t + 2) * kstep; const char* b2 = last ? nB : cB + (size_t)(t + 2) * kstep;
            const char* a3 = a2 + kstep; const char* b3 = b2 + kstep;
            unsigned f0[2], f1[2];
#pragma unroll
            for (int i = 0; i < 2; ++i) { f0[i] = last ? nv0[i] : cv0[i]; f1[i] = last ? nv1[i] : cv1[i]; }
            PG8_LDB(B0, 0, 0); PG8_LDB(B1, 0, 1); PG8_SCHED; PG8_LDA(At, 0, 0); PG8_STAGE(PG8_SA(1, 1), a1, cv1);
            PG8_WAIT_V(8); PG8_WAIT_L(0); PG8_BAR; PG8_MMA(0, 0, At, B0); PG8_MMA(0, 1, At, B1); PG8_BAR; PG8_SCHED;
            PG8_LDA(At, 0, 1); PG8_STAGE(PG8_SB(0, 0), b2, voffB); PG8_STAGE(PG8_SB(0, 1), b2 + hstepB, voffB); PG8_STAGE(PG8_SA(0, 0), a2, f0);
            PG8_WAIT_V(8); PG8_WAIT_L(0); PG8_BAR; PG8_MMA(1, 0, At, B0); PG8_MMA(1, 1, At, B1); PG8_BAR; PG8_SCHED;
            PG8_LDB(B0, 1, 0); PG8_LDB(B1, 1, 1); PG8_SCHED; PG8_LDA(At, 1, 0); PG8_STAGE(PG8_SA(0, 1), a2, f1);
            PG8_WAIT_V(8); PG8_WAIT_L(0); PG8_BAR; PG8_MMA(0, 0, At, B0); PG8_MMA(0, 1, At, B1); PG8_BAR; PG8_SCHED;
            PG8_LDA(At, 1, 1); PG8_STAGE(PG8_SB(1, 0), b3, voffB); PG8_STAGE(PG8_SB(1, 1), b3 + hstepB, voffB); PG8_STAGE(PG8_SA(1, 0), a3, f0);
            PG8_WAIT_V(8); PG8_WAIT_L(0); PG8_BAR; PG8_MMA(1, 0, At, B0); PG8_MMA(1, 1, At, B1); PG8_BAR; PG8_SCHED;
        }
        if constexpr (ALIGN_EPI) { if (wr == 0) PG8_BAR; }
        if constexpr (FP8) asm volatile("s_nop 15\n\ts_nop 15" ::: "memory");
        E(acc, cur, wr, wc, fr, fq);
        if constexpr (Epi::HAS_PF) asm volatile("" :: "v"(pf_sink));
        if (!has_next) break;
#pragma unroll
        for (int a = 0; a < 2; ++a)
#pragma unroll
            for (int b = 0; b < 2; ++b)
#pragma unroll
                for (int m = 0; m < 4; ++m)
#pragma unroll
                    for (int n = 0; n < 2; ++n) acc[a][b][m][n] = (f32x4){0.f, 0.f, 0.f, 0.f};
        cur = nxt; cA = nA; cB = nB; ++ui;
#pragma unroll
        for (int i = 0; i < 2; ++i) { cv0[i] = nv0[i]; cv1[i] = nv1[i]; }
        if constexpr (ALIGN_EPI) { if (wr == 1) PG8_BAR; }
    }
    PG8_WAIT_V(0);
    if constexpr (!ALIGN_EPI) { if (wr == 0) PG8_BAR; }
    PG8_BAR;
#undef PG8_SA
#undef PG8_SB
#undef PG8_STAGE
#undef PG8_LDA
#undef PG8_LDB
#undef PG8_MMA
#undef PG8_WAIT_V
#undef PG8_WAIT_L
#undef PG8_BAR
#undef PG8_SCHED
#undef PG8_VOFF
}
}
namespace attn_body {
typedef unsigned short bf16;
using bf16x8=__attribute__((ext_vector_type(8)))short;
using s16x4=__attribute__((ext_vector_type(4)))short;
using f32x16=__attribute__((ext_vector_type(16)))float;
using u32x4=__attribute__((ext_vector_type(4)))unsigned;
constexpr int D=64;
constexpr int NW=8,QBLK=32,QB=QBLK*NW,KVBLK=64;
__device__ __forceinline__ int crow(int r,int hi){return (r&3)+8*(r>>2)+4*hi;}
#define SBAR() __builtin_amdgcn_sched_barrier(0)
__device__ __forceinline__ void cmask(f32x16&p0,f32x16&p1,int jb,int qrel,int hi){
  const float NEG=-INFINITY; int kb=64*jb+4*hi;
  #pragma unroll
  for(int r=0;r<16;++r){int kv=kb+(r&3)+8*(r>>2); if(kv>qrel)p0[r]=NEG; if(kv+32>qrel)p1[r]=NEG;}
}

constexpr int NSLOT=3, SLOTB=8192;
constexpr int LDS_K=0, LDS_V=NSLOT*SLOTB, LDS_WS=2*NSLOT*SLOTB, LDS_OST=LDS_WS+NW*64*4, LDS_AUG=LDS_OST+NW*4096, LDS_BYTES=LDS_AUG+65536;
constexpr float C2=0.125f*1.4426950408889634f;
__device__ __forceinline__ void glds16(const void*gsrc,unsigned lds_dst){unsigned keep;
  asm volatile("s_mov_b32 %0, m0\n\ts_mov_b32 m0, %2\n\ts_nop 0\n\tglobal_load_lds_dwordx4 %1, off\n\ts_mov_b32 m0, %0":"=&s"(keep):"v"(gsrc),"s"(lds_dst):"memory");}
__device__ __forceinline__ float max3f(float a,float b,float c){float r;asm("v_max3_f32 %0, %1, %2, %3":"=v"(r):"v"(a),"v"(b),"v"(c));return r;}
__device__ __forceinline__ float max2f(float a,float b){float r;asm("v_max_f32_e32 %0, %1, %2":"=v"(r):"v"(a),"v"(b));return r;}
__device__ __forceinline__ float fadd_s(float a,float b){float r;asm("v_add_f32_e32 %0, %1, %2":"=v"(r):"v"(a),"v"(b));return r;}
__device__ __forceinline__ float fsub_s(float a,float b){float r;asm("v_sub_f32_e32 %0, %1, %2":"=v"(r):"v"(a),"v"(b));return r;}
typedef float f32x2_t __attribute__((ext_vector_type(2))); typedef __bf16 bf16x2_t __attribute__((ext_vector_type(2)));
__device__ __forceinline__ unsigned cvtpk_s(float lo,float hi){f32x2_t v={lo,hi};bf16x2_t b=__builtin_convertvector(v,bf16x2_t);return __builtin_bit_cast(unsigned,b);}
#define WAIT_BAR(N) asm volatile("s_waitcnt vmcnt(" #N ") lgkmcnt(0)\n\ts_barrier":::"memory")

template<bool AUG> __device__ __forceinline__ void qkt(f32x16&p0,f32x16&p1,const char*Kslot,const bf16x8*qr,const f32x16&negm,int r32,int hi,bf16x8 ka0,bf16x8 ka1,bf16x8 qaug){
  const char*kb=Kslot+hi*1024+r32*16;
  #pragma unroll
  for(int d0=0;d0<4;++d0){
    const bf16x8 b0=*reinterpret_cast<const bf16x8*>(kb+d0*2048);
    const bf16x8 b1=*reinterpret_cast<const bf16x8*>(kb+d0*2048+512);
    if(d0==0){p0=__builtin_amdgcn_mfma_f32_32x32x16_bf16(b0,qr[0],negm,0,0,0);p1=__builtin_amdgcn_mfma_f32_32x32x16_bf16(b1,qr[0],negm,0,0,0);}
    else{p0=__builtin_amdgcn_mfma_f32_32x32x16_bf16(b0,qr[d0],p0,0,0,0);p1=__builtin_amdgcn_mfma_f32_32x32x16_bf16(b1,qr[d0],p1,0,0,0);}}
  if(AUG){p0=__builtin_amdgcn_mfma_f32_32x32x16_bf16(ka0,qaug,p0,0,0,0);p1=__builtin_amdgcn_mfma_f32_32x32x16_bf16(ka1,qaug,p1,0,0,0);}
}
typedef __attribute__((address_space(3))) const char* lds_cptr;
typedef short v4i16_t __attribute__((ext_vector_type(4)));
__device__ __forceinline__ void kload8(bf16x8*kf,lds_cptr kp){
  kf[0]=*(const __attribute__((address_space(3))) bf16x8*)(kp);      kf[1]=*(const __attribute__((address_space(3))) bf16x8*)(kp+512);
  kf[2]=*(const __attribute__((address_space(3))) bf16x8*)(kp+2048); kf[3]=*(const __attribute__((address_space(3))) bf16x8*)(kp+2560);
  kf[4]=*(const __attribute__((address_space(3))) bf16x8*)(kp+4096); kf[5]=*(const __attribute__((address_space(3))) bf16x8*)(kp+4608);
  kf[6]=*(const __attribute__((address_space(3))) bf16x8*)(kp+6144); kf[7]=*(const __attribute__((address_space(3))) bf16x8*)(kp+6656);
}
__device__ __forceinline__ void kload2(bf16x8*kf,lds_cptr kp,int j){ kf[2*j]=*(const __attribute__((address_space(3))) bf16x8*)(kp+j*2048); kf[2*j+1]=*(const __attribute__((address_space(3))) bf16x8*)(kp+j*2048+512); }
__device__ __forceinline__ s16x4 vtr(lds_cptr p){ return __builtin_bit_cast(s16x4,__builtin_amdgcn_ds_read_tr16_b64_v4i16((__attribute__((address_space(3))) v4i16_t*)p)); }
__device__ __forceinline__ float rowmax(const f32x16&p0,const f32x16&p1){
  float a=max3f(p0[0],p0[1],p1[0]),b=max3f(p0[2],p0[3],p1[1]);a=max3f(a,p1[2],p1[3]);
  #pragma unroll
  for(int r=4;r<16;r+=4){a=max3f(a,p0[r],p0[r+1]);b=max3f(b,p0[r+2],p0[r+3]);a=max3f(a,p1[r],p1[r+1]);b=max3f(b,p1[r+2],p1[r+3]);}
  const float m=max2f(a,b);
  auto rr=__builtin_amdgcn_permlane32_swap(__float_as_uint(m),__float_as_uint(m),false,false);
  return max2f(__uint_as_float(rr[0]),__uint_as_float(rr[1]));
}
__device__ __forceinline__ void pv(f32x16*o,int vb,bf16x8 pa0,bf16x8 pa1,bf16x8 pa2,bf16x8 pa3){
  #pragma unroll
  for(int d0=0;d0<2;++d0){s16x4 lo[4],hi[4];
    #pragma unroll
    for(int ks=0;ks<4;++ks){
      asm volatile("ds_read_b64_tr_b16 %0,%1 offset:%c2":"=&v"(lo[ks]):"v"(vb),"i"(d0*4096+ks*1024):"memory");
      asm volatile("ds_read_b64_tr_b16 %0,%1 offset:%c2":"=&v"(hi[ks]):"v"(vb),"i"(d0*4096+ks*1024+512):"memory");}
    asm volatile("s_waitcnt lgkmcnt(0)":::"memory");SBAR();
    #define PK(k) (bf16x8){lo[k][0],lo[k][1],lo[k][2],lo[k][3],hi[k][0],hi[k][1],hi[k][2],hi[k][3]}
    o[d0]=__builtin_amdgcn_mfma_f32_32x32x16_bf16(pa0,PK(0),o[d0],0,0,0);
    o[d0]=__builtin_amdgcn_mfma_f32_32x32x16_bf16(pa1,PK(1),o[d0],0,0,0);
    o[d0]=__builtin_amdgcn_mfma_f32_32x32x16_bf16(pa2,PK(2),o[d0],0,0,0);
    o[d0]=__builtin_amdgcn_mfma_f32_32x32x16_bf16(pa3,PK(3),o[d0],0,0,0);
    #undef PK
  }
}

#ifndef ATTN_STORE16
#define ATTN_STORE16(p,v) (*(u32x4*)(p)=(v))
#endif
template<bool CAUSAL,bool AUG,int THRL> __device__ __forceinline__ void attn_unit(const bf16*Qu,int ldq,const bf16*__restrict__ Kh,int ldk,const bf16*__restrict__ Vh,int ldv,bf16*Ou,int ldo,const bf16*__restrict__ aug,int NT,char*shm,bf16x8(&qr)[4],bool primed,int par,const bf16*Qn,const bf16*Kn,const bf16*augn,int NTn){
  int tid_=threadIdx.x; asm volatile("":"+v"(tid_));
  const int tid=tid_,lane=tid&63,r32=lane&31,hi=lane>>5; const int wid=__builtin_amdgcn_readfirstlane(tid>>6);
  const bf16*Qw=Qu+(long)(wid*QBLK)*ldq;
  const unsigned lds0=(unsigned)(uintptr_t)shm;
  float*wsf=(float*)(shm+LDS_WS)+wid*64;
  const bf16*ksrc=Kh+(long)lane*ldk+wid*8;
  const bf16*vsrc=Vh+(long)(16*(wid&3)+(lane>>2))*ldv+(wid>>2)*32+(lane&3)*8;
  const unsigned kdst=lds0+LDS_K+wid*1024, vdst=lds0+LDS_V+wid*1024;
  #define DMA_K(t,slot) glds16(ksrc+(long)(t)*KVBLK*ldk,(unsigned)__builtin_amdgcn_readfirstlane(kdst+(slot)))
  #define DMA_V(t,slot) glds16(vsrc+(long)(t)*KVBLK*ldv,(unsigned)__builtin_amdgcn_readfirstlane(vdst+(slot)))
  const int vb0=(int)(lds0+LDS_V)+((lane>>4)&1)*32+(lane&3)*8+(4*hi+((lane&15)>>2))*64;
  const char*Kbase=shm+LDS_K; bf16x8 kf[8];
  const lds_cptr shm3=(lds_cptr)shm; const lds_cptr kp0=shm3+LDS_K+hi*1024+r32*16; const lds_cptr vp0=shm3+LDS_V+((lane>>4)&1)*32+(lane&3)*8+(4*hi+((lane&15)>>2))*64;
  typedef __attribute__((address_space(3))) unsigned long long* lds_u64p; typedef __attribute__((address_space(3))) u32x4* lds_v4p;
  bf16x8 qaug=bf16x8{}; const lds_cptr augp=(lds_cptr)shm+LDS_AUG+par*32768+r32*8;
  u32x4 av_[4];
  if(AUG){
    if(!primed){
    #pragma unroll
    for(int k_=0;k_<4;++k_){ const int i=tid+512*k_; if(i<NT*32) av_[k_]=*(const u32x4*)(aug+(long)i*8); } }
    if(hi==0){qaug[0]=(short)0x3F80;qaug[1]=(short)0x3F80;qaug[2]=(short)0x3F80;} }
  #define KAUG(t,w) ({ bf16x8 r_=bf16x8{}; if(AUG){ const unsigned long long u_=*(const __attribute__((address_space(3))) unsigned long long*)(augp+(t)*512+(w)*256); const u32x4 q_={(unsigned)u_,(unsigned)(u_>>32),0u,0u}; r_=__builtin_bit_cast(bf16x8,q_);} r_; })
  if(!primed){
  DMA_K(0,0);DMA_V(0,0);DMA_K(1,SLOTB);
  #pragma unroll
  for(int d0=0;d0<4;++d0)qr[d0]=*reinterpret_cast<const bf16x8*>(&Qw[(long)r32*ldq+d0*16+hi*8]);
  } else { DMA_V(0,0); }
  float mhat=0.f,l_reg=0.f;float z_=0.f;asm volatile("":"+v"(z_));f32x16 o[2];f32x16 negm;
  #pragma unroll
  for(int r=0;r<16;++r){o[0][r]=z_;o[1][r]=z_;negm[r]=z_;}
  asm volatile("":"+v"(negm));
  const int qrel=wid*QBLK+r32;
  #define CMASK(P0,P1,t) do{ if(CAUSAL){int jb_=(t)-(NT-4); if(jb_>=0)cmask(P0,P1,jb_,qrel,hi);} }while(0)
  bool resc=false;
  #define START(P0,P1) do{ const float rm=rowmax(P0,P1); resc=false; \
    { const float dl=rm; mhat=fadd_s(mhat,dl); \
      _Pragma("unroll") for(int r=0;r<16;++r){P0[r]=fsub_s(P0[r],dl);P1[r]=fsub_s(P1[r],dl);} \
      _Pragma("unroll") for(int r=0;r<16;++r)negm[r]=-mhat; asm volatile("":"+v"(negm)); } \
    _Pragma("unroll") for(int r=0;r<16;++r)P0[r]=__builtin_amdgcn_exp2f(P0[r]); }while(0)
  #define RESC() do{ if(resc){ asm volatile("s_waitcnt lgkmcnt(0)":::"memory"); \
      _Pragma("unroll") for(int d_=0;d_<2;++d_) _Pragma("unroll") for(int r=0;r<16;++r)o[d_][r]*=wsf[crow(r,hi)]; } }while(0)
  f32x16 pA0,pA1,pB0,pB1;
  int sl_prev=0,sl_cur=0,sl_next=SLOTB;
  #define ROT() do{sl_prev=sl_cur;sl_cur=sl_next;sl_next=(sl_next==(NSLOT-1)*SLOTB)?0:sl_next+SLOTB;}while(0)
  if(!primed){
  DMA_K(2,2*SLOTB);
  if(AUG){ asm volatile("s_waitcnt vmcnt(0)":::"memory");
    #pragma unroll
    for(int k_=0;k_<4;++k_){ const int i=tid+512*k_; if(i<NT*32) *(lds_v4p)((lds_cptr)shm+LDS_AUG+par*32768+i*16)=av_[k_]; }
    WAIT_BAR(0); }
  else { WAIT_BAR(3); }
  } else { WAIT_BAR(1); }
  { const bf16x8 ka0_=KAUG(0,0),ka1_=KAUG(0,1); qkt<AUG>(pA0,pA1,Kbase,qr,negm,r32,hi,ka0_,ka1_,qaug); } asm volatile("s_nop 15\n\ts_nop 7":"+v"(pA0),"+v"(pA1));CMASK(pA0,pA1,0);
  START(pA0,pA1);
  _Pragma("unroll") for(int r=0;r<16;++r)pA1[r]=__builtin_amdgcn_exp2f(pA1[r]);
  WAIT_BAR(0);
  DMA_K(3,0);DMA_V(1,SLOTB);
  ROT();
  kload8(kf,kp0+sl_cur);
  WAIT_BAR(2);
  s16x4 vlo[8],vhi[8]; u32x4 pw0,pw1,pw2,pw3;
  #define PKW(P,B) cvtpk_s(P[B],P[B+1])
  #define PAF(k) __builtin_bit_cast(bf16x8,pw##k)
  #define VFR(i) (bf16x8){vlo[i][0],vlo[i][1],vlo[i][2],vlo[i][3],vhi[i][0],vhi[i][1],vhi[i][2],vhi[i][3]}
  #define PIN(x) asm volatile("":"+v"(x))
  #define MX3(a,b,c) __builtin_fmaxf(__builtin_fmaxf((a),(b)),(c))
  #define GAPA(MF,A0,A1,A2,A3,W0,W1,PW) do{ MF; sacc+=A0; sacc+=A1; sacc+=A2; sacc+=A3; PIN(sacc); W0; W1; PIN(PW); SBAR(); }while(0)
  #define EX(v) __builtin_amdgcn_exp2f(v)
  #define GAPB(MF,X,B) do{ MF; X[B]=EX(X[B]); X[B+1]=EX(X[B+1]); X[B+2]=EX(X[B+2]); X[B+3]=EX(X[B+3]); PIN(X); SBAR(); }while(0)
  #define VRD(i) do{ vlo[i]=vtr(vp_+(((i)>>2)*4096+((i)&3)*1024)); vhi[i]=vtr(vp_+(((i)>>2)*4096+((i)&3)*1024+512)); }while(0)
  #define KRD(G,j) do{ if(G){ kload2(kf,kp0+sl_next,j); SBAR(); } }while(0)
  #define STEP(C0,C1,P0,P1,t,GK,GV,GL) do{ SBAR(); \
    const lds_cptr vp_=vp0+sl_prev; bf16x8 ka0_=bf16x8{},ka1_=bf16x8{}; \
    VRD(0); SBAR(); float sacc=(P0[0]+P0[1]); \
    GAPA(C0=__builtin_amdgcn_mfma_f32_32x32x16_bf16(kf[0],qr[0],negm,0,0,0), P0[2],P0[3],P0[4],P0[5],     pw0[0]=PKW(P0,0), pw0[1]=PKW(P0,2), pw0); \
    VRD(4); SBAR(); GAPA(C1=__builtin_amdgcn_mfma_f32_32x32x16_bf16(kf[1],qr[0],negm,0,0,0), P0[6],P0[7],P0[8],P0[9],     pw0[2]=PKW(P0,4), pw0[3]=PKW(P0,6), pw0); \
    VRD(1); SBAR(); GAPA(C0=__builtin_amdgcn_mfma_f32_32x32x16_bf16(kf[2],qr[1],C0,0,0,0),   P0[10],P0[11],P0[12],P0[13], pw1[0]=PKW(P0,8), pw1[1]=PKW(P0,10), pw1); \
    VRD(5); SBAR(); GAPA(C1=__builtin_amdgcn_mfma_f32_32x32x16_bf16(kf[3],qr[1],C1,0,0,0),   P0[14],P0[15],P1[0],P1[1],   pw1[2]=PKW(P0,12),pw1[3]=PKW(P0,14), pw1); \
    VRD(2); SBAR(); GAPA(C0=__builtin_amdgcn_mfma_f32_32x32x16_bf16(kf[4],qr[2],C0,0,0,0),   P1[2],P1[3],P1[4],P1[5],     pw2[0]=PKW(P1,0), pw2[1]=PKW(P1,2), pw2); \
    VRD(6); SBAR(); GAPA(C1=__builtin_amdgcn_mfma_f32_32x32x16_bf16(kf[5],qr[2],C1,0,0,0),   P1[6],P1[7],P1[8],P1[9],     pw2[2]=PKW(P1,4), pw2[3]=PKW(P1,6), pw2); \
    if(AUG){ ka0_=KAUG(t,0); ka1_=KAUG(t,1); SBAR(); } \
    VRD(3); SBAR(); GAPA(C0=__builtin_amdgcn_mfma_f32_32x32x16_bf16(kf[6],qr[3],C0,0,0,0),   P1[10],P1[11],P1[12],P1[13], pw3[0]=PKW(P1,8), pw3[1]=PKW(P1,10), pw3); \
    VRD(7); SBAR(); GAPA(C1=__builtin_amdgcn_mfma_f32_32x32x16_bf16(kf[7],qr[3],C1,0,0,0),   P1[14],P1[15],0.f,0.f,       pw3[2]=PKW(P1,12),pw3[3]=PKW(P1,14), pw3); \
    if(AUG){ C0=__builtin_amdgcn_mfma_f32_32x32x16_bf16(ka0_,qaug,C0,0,0,0); C1=__builtin_amdgcn_mfma_f32_32x32x16_bf16(ka1_,qaug,C1,0,0,0); } \
    l_reg+=sacc; \
    if(GK){DMA_K((t)+3,sl_cur);} if(GV){DMA_V((t)+1,sl_next);} \
    CMASK(C0,C1,t); \
    { float a=MX3(C0[0],C0[1],C1[0]),b=MX3(C0[2],C0[3],C1[1]); a=MX3(a,C1[2],C1[3]); \
      _Pragma("unroll") for(int r=4;r<16;r+=4){a=MX3(a,C0[r],C0[r+1]);b=MX3(b,C0[r+2],C0[r+3]);a=MX3(a,C1[r],C1[r+1]);b=MX3(b,C1[r+2],C1[r+3]);} \
      float rm=__builtin_fmaxf(a,b); { auto rr=__builtin_amdgcn_permlane32_swap(__float_as_uint(rm),__float_as_uint(rm),false,false); rm=__builtin_fmaxf(__uint_as_float(rr[0]),__uint_as_float(rr[1])); } \
      resc=false; \
      if(__builtin_expect(__any(rm>(float)THRL),0)){ const float dl=__builtin_fmaxf(rm,0.f); mhat+=dl; \
        _Pragma("unroll") for(int r=0;r<16;++r){C0[r]-=dl;C1[r]-=dl;} \
        _Pragma("unroll") for(int r=0;r<16;++r)negm[r]=-mhat; asm volatile("":"+v"(negm)); \
        const float f=__builtin_amdgcn_exp2f(-dl); l_reg*=f; if(hi==0)wsf[r32]=f; resc=true; } } \
    SBAR(); \
    GAPB(o[0]=__builtin_amdgcn_mfma_f32_32x32x16_bf16(PAF(0),VFR(0),o[0],0,0,0), C0,0); \
    GAPB(o[1]=__builtin_amdgcn_mfma_f32_32x32x16_bf16(PAF(0),VFR(4),o[1],0,0,0), C0,4); \
    KRD(GL,0); GAPB(o[0]=__builtin_amdgcn_mfma_f32_32x32x16_bf16(PAF(1),VFR(1),o[0],0,0,0), C0,8); \
    KRD(GL,1); GAPB(o[1]=__builtin_amdgcn_mfma_f32_32x32x16_bf16(PAF(1),VFR(5),o[1],0,0,0), C0,12); \
    KRD(GL,2); GAPB(o[0]=__builtin_amdgcn_mfma_f32_32x32x16_bf16(PAF(2),VFR(2),o[0],0,0,0), C1,0); \
    KRD(GL,3); GAPB(o[1]=__builtin_amdgcn_mfma_f32_32x32x16_bf16(PAF(2),VFR(6),o[1],0,0,0), C1,4); \
    GAPB(o[0]=__builtin_amdgcn_mfma_f32_32x32x16_bf16(PAF(3),VFR(3),o[0],0,0,0), C1,8); \
    GAPB(o[1]=__builtin_amdgcn_mfma_f32_32x32x16_bf16(PAF(3),VFR(7),o[1],0,0,0), C1,12); \
    }while(0)
  int t=1;
  #undef CMASK
  #define CMASK(P0,P1,t) do{}while(0)
  for(;t+5<NT;t+=2){
    STEP(pB0,pB1,pA0,pA1,t,true,true,true);     WAIT_BAR(2); RESC(); ROT();
    STEP(pA0,pA1,pB0,pB1,t+1,true,true,true);   WAIT_BAR(2); RESC(); ROT();
  }
  #undef CMASK
  #define CMASK(P0,P1,t) do{ if(CAUSAL){int jb_=(t)-(NT-4); if(jb_>=0)cmask(P0,P1,jb_,qrel,hi);} }while(0)
  #define ENDW(tt) do{ if((tt)+3<NT){WAIT_BAR(2);} else if((tt)+2<NT){WAIT_BAR(1);} else {WAIT_BAR(0);} }while(0)
  for(;t+1<NT;t+=2){
    STEP(pB0,pB1,pA0,pA1,t,(t+3<NT),(t+1<NT),(t+1<NT));       ENDW(t);   RESC(); ROT();
    STEP(pA0,pA1,pB0,pB1,t+1,(t+4<NT),(t+2<NT),(t+2<NT));     ENDW(t+1); RESC(); ROT();
  }
  if(Qn){ const bf16*ksn=Kn+(long)lane*ldk+wid*8;
    glds16(ksn,(unsigned)__builtin_amdgcn_readfirstlane(kdst)); glds16(ksn+(long)KVBLK*ldk,(unsigned)__builtin_amdgcn_readfirstlane(kdst+SLOTB)); glds16(ksn+2L*KVBLK*ldk,(unsigned)__builtin_amdgcn_readfirstlane(kdst+2*SLOTB)); }
  STEP(pB0,pB1,pA0,pA1,NT-1,false,false,false); RESC();
  if(Qn){ const bf16*Qwn=Qn+(long)(wid*QBLK)*ldq;
    #pragma unroll
    for(int d0=0;d0<4;++d0)qr[d0]=*reinterpret_cast<const bf16x8*>(&Qwn[(long)r32*ldq+d0*16+hi*8]);
    if(AUG){
      #pragma unroll
      for(int k_=0;k_<4;++k_){ const int i=tid+512*k_; if(i<NTn*32) av_[k_]=*(const u32x4*)(augn+(long)i*8); } } }
  { float sacc=pB0[0]+pB0[1]; _Pragma("unroll") for(int r=2;r<16;++r)sacc+=pB0[r]; _Pragma("unroll") for(int r=0;r<16;++r)sacc+=pB1[r]; l_reg+=sacc;
    pw0=(u32x4){PKW(pB0,0),PKW(pB0,2),PKW(pB0,4),PKW(pB0,6)};pw1=(u32x4){PKW(pB0,8),PKW(pB0,10),PKW(pB0,12),PKW(pB0,14)};pw2=(u32x4){PKW(pB1,0),PKW(pB1,2),PKW(pB1,4),PKW(pB1,6)};pw3=(u32x4){PKW(pB1,8),PKW(pB1,10),PKW(pB1,12),PKW(pB1,14)};
    SBAR(); pv(o,vb0+sl_cur,PAF(0),PAF(1),PAF(2),PAF(3)); }
  #undef PKW
  #undef PAF
  #undef VFR
  #undef PIN
  #undef MX3
  #undef GAPA
  #undef GAPB
  #undef EX
  #undef VRD
  #undef KRD
  #undef STEP
  #undef ENDW
  {auto rr=__builtin_amdgcn_permlane32_swap(__float_as_uint(l_reg),__float_as_uint(l_reg),false,false);l_reg=__uint_as_float(rr[0])+__uint_as_float(rr[1]);}
  if(hi==0)wsf[32+r32]=l_reg;asm volatile("s_waitcnt lgkmcnt(0)":::"memory");
  float rli[16];
  #pragma unroll
  for(int r=0;r<16;++r)rli[r]=__builtin_amdgcn_rcpf(wsf[32+crow(r,hi)]);
  bf16*Ow=Ou+(long)(wid*QBLK)*ldo;
  { bf16*stg=(bf16*)(shm+LDS_OST)+wid*2048;
    #pragma unroll
    for(int r=0;r<16;++r){const int orow=crow(r,hi);
      #pragma unroll
      for(int d0=0;d0<2;++d0)stg[orow*64+d0*32+r32]=f2bf(o[d0][r]*rli[r]);}
    asm volatile("s_waitcnt lgkmcnt(0)":::"memory");
    #pragma unroll
    for(int i=0;i<4;++i){const int row=i*8+(lane>>3),ch=lane&7; const u32x4 v=*(const u32x4*)(stg+row*64+ch*8); ATTN_STORE16(Ow+(long)row*ldo+ch*8,v);} }
  if(AUG&&Qn){
    #pragma unroll
    for(int k_=0;k_<4;++k_){ const int i=tid+512*k_; if(i<NTn*32) *(lds_v4p)((lds_cptr)shm+LDS_AUG+(par^1)*32768+i*16)=av_[k_]; } }
  asm volatile("s_waitcnt lgkmcnt(0)\n\ts_barrier":::"memory");
  #undef DMA_K
  #undef DMA_V
  #undef KAUG
  #undef CMASK
  #undef START
  #undef RESC
  #undef ROT
}
template<int THRL> __device__ __forceinline__ void attn_unit128(const bf16*Qu,int ldq,const bf16*__restrict__ Kh,int ldk,const bf16*__restrict__ Vh,int ldv,bf16*Ou,int ldo,const bf16*__restrict__ aug,int NT,char*shm,bf16x8(&qr)[4],bool primed,int par,const bf16*Qn,const bf16*Kn,const bf16*augn,int NTn){
  u32x4 av_[4]; (void)av_;
  constexpr bool CAUSAL=true, AUG=false; constexpr int LDS_WS=LDS_V+3*16384, LDS_OST=LDS_WS+NW*64*4;
  int tid_=threadIdx.x; asm volatile("":"+v"(tid_));
  const int tid=tid_,lane=tid&63,r32=lane&31,hi=lane>>5; const int wid=__builtin_amdgcn_readfirstlane(tid>>6);
  const bf16*Qw=Qu+(long)(wid*QBLK)*ldq;
  const unsigned lds0=(unsigned)(uintptr_t)shm;
  float*wsf=(float*)(shm+LDS_WS)+wid*64;
  const bf16*ksrc=Kh+(long)lane*ldk+wid*8;
  const bf16*vsrc=Vh+(long)(16*(wid&3)+(lane>>2))*ldv+(wid>>2)*32+(lane&3)*8;
  const unsigned kdst=lds0+LDS_K+wid*1024, vdst=lds0+LDS_V+wid*1024;
  #define DMA_K(t,slot) glds16(ksrc+(long)(t)*KVBLK*ldk,(unsigned)__builtin_amdgcn_readfirstlane(kdst+(slot)))
  #define DMA_V(t,slot) do{ glds16(vsrc+(long)(t)*KVBLK*ldv,(unsigned)__builtin_amdgcn_readfirstlane(vdst+2*(slot))); glds16(vsrc+(long)(t)*KVBLK*ldv+64,(unsigned)__builtin_amdgcn_readfirstlane(vdst+2*(slot)+8192)); }while(0)
  const int vb0=(int)(lds0+LDS_V)+((lane>>4)&1)*32+(lane&3)*8+(4*hi+((lane&15)>>2))*64;
  const char*Kbase=shm+LDS_K; bf16x8 kf[8];
  const lds_cptr shm3=(lds_cptr)shm; const lds_cptr kp0=shm3+LDS_K+hi*1024+r32*16; const lds_cptr vp0=shm3+LDS_V+((lane>>4)&1)*32+(lane&3)*8+(4*hi+((lane&15)>>2))*64;
  typedef __attribute__((address_space(3))) unsigned long long* lds_u64p; typedef __attribute__((address_space(3))) u32x4* lds_v4p;
  bf16x8 qaug=bf16x8{}; const lds_cptr augp=(lds_cptr)shm+LDS_AUG+par*32768+r32*8;
  if(AUG){ for(int i=tid;i<NT*32;i+=512){ const u32x4 v=*(const u32x4*)(aug+(long)i*8); *(lds_v4p)((lds_cptr)shm+LDS_AUG+i*16)=v; }
    asm volatile("s_waitcnt vmcnt(0)":::"memory");
    if(hi==0){qaug[0]=(short)0x3F80;qaug[1]=(short)0x3F80;qaug[2]=(short)0x3F80;} }
  #define KAUG(t,w) ({ bf16x8 r_=bf16x8{}; if(AUG){ const unsigned long long u_=*(const __attribute__((address_space(3))) unsigned long long*)(augp+(t)*512+(w)*256); const u32x4 q_={(unsigned)u_,(unsigned)(u_>>32),0u,0u}; r_=__builtin_bit_cast(bf16x8,q_);} r_; })
  if(!primed){
  DMA_K(0,0);DMA_V(0,0);DMA_K(1,SLOTB);
  #pragma unroll
  for(int d0=0;d0<4;++d0)qr[d0]=*reinterpret_cast<const bf16x8*>(&Qw[(long)r32*ldq+d0*16+hi*8]);
  } else { DMA_V(0,0); }
  float mhat=0.f,l_reg=0.f;float z_=0.f;asm volatile("":"+v"(z_));f32x16 o[4];f32x16 negm;
  #pragma unroll
  for(int r=0;r<16;++r){o[0][r]=z_;o[1][r]=z_;o[2][r]=z_;o[3][r]=z_;negm[r]=z_;}
  asm volatile("":"+v"(negm));
  const int qrel=wid*QBLK+r32;
  #define CMASK(P0,P1,t) do{ if(CAUSAL){int jb_=(t)-(NT-4); if(jb_>=0)cmask(P0,P1,jb_,qrel,hi);} }while(0)
  bool resc=false;
  #define START(P0,P1) do{ const float rm=rowmax(P0,P1); resc=false; \
    { const float dl=rm; mhat=fadd_s(mhat,dl); \
      _Pragma("unroll") for(int r=0;r<16;++r){P0[r]=fsub_s(P0[r],dl);P1[r]=fsub_s(P1[r],dl);} \
      _Pragma("unroll") for(int r=0;r<16;++r)negm[r]=-mhat; asm volatile("":"+v"(negm)); } \
    _Pragma("unroll") for(int r=0;r<16;++r)P0[r]=__builtin_amdgcn_exp2f(P0[r]); }while(0)
  #define RESC() do{ if(resc){ asm volatile("s_waitcnt lgkmcnt(0)":::"memory"); \
      _Pragma("unroll") for(int d_=0;d_<4;++d_) _Pragma("unroll") for(int r=0;r<16;++r)o[d_][r]*=wsf[crow(r,hi)]; } }while(0)
  f32x16 pA0,pA1,pB0,pB1;
  int sl_prev=0,sl_cur=0,sl_next=SLOTB;
  #define ROT() do{sl_prev=sl_cur;sl_cur=sl_next;sl_next=(sl_next==(NSLOT-1)*SLOTB)?0:sl_next+SLOTB;}while(0)
  if(!primed){
  DMA_K(2,2*SLOTB);
  WAIT_BAR(4);
  } else { WAIT_BAR(2); }
  { const bf16x8 ka0_=KAUG(0,0),ka1_=KAUG(0,1); qkt<AUG>(pA0,pA1,Kbase,qr,negm,r32,hi,ka0_,ka1_,qaug); } asm volatile("s_nop 15\n\ts_nop 7":"+v"(pA0),"+v"(pA1));CMASK(pA0,pA1,0);
  START(pA0,pA1);
  _Pragma("unroll") for(int r=0;r<16;++r)pA1[r]=__builtin_amdgcn_exp2f(pA1[r]);
  WAIT_BAR(0);
  DMA_K(3,0);DMA_V(1,SLOTB);
  ROT();
  kload8(kf,kp0+sl_cur);
  WAIT_BAR(3);
  s16x4 vlo[8],vhi[8],wlo[8],whi[8]; u32x4 pw0,pw1,pw2,pw3;
  #define PKW(P,B) cvtpk_s(P[B],P[B+1])
  #define PAF(k) __builtin_bit_cast(bf16x8,pw##k)
  #define VFR(i) (bf16x8){vlo[i][0],vlo[i][1],vlo[i][2],vlo[i][3],vhi[i][0],vhi[i][1],vhi[i][2],vhi[i][3]}
  #define WFR(i) (bf16x8){wlo[i][0],wlo[i][1],wlo[i][2],wlo[i][3],whi[i][0],whi[i][1],whi[i][2],whi[i][3]}
  #define PIN(x) asm volatile("":"+v"(x))
  #define MX3(a,b,c) __builtin_fmaxf(__builtin_fmaxf((a),(b)),(c))
  #define GAPA(MF,A0,A1,A2,A3,W0,W1,PW) do{ MF; sacc+=A0; sacc+=A1; sacc+=A2; sacc+=A3; PIN(sacc); W0; W1; PIN(PW); SBAR(); }while(0)
  #define EX(v) __builtin_amdgcn_exp2f(v)
  #define GAPB(MF,X,B) do{ MF; X[B]=EX(X[B]); X[B+1]=EX(X[B+1]); PIN(X); SBAR(); }while(0)
  #define VRD(i) do{ vlo[i]=vtr(vp_+(((i)>>2)*4096+((i)&3)*1024)); vhi[i]=vtr(vp_+(((i)>>2)*4096+((i)&3)*1024+512)); }while(0)
  #define WRD(i) do{ wlo[i]=vtr(vp_+(8192+((i)>>2)*4096+((i)&3)*1024)); whi[i]=vtr(vp_+(8192+((i)>>2)*4096+((i)&3)*1024+512)); SBAR(); }while(0)
  #define KRD(G,j) do{ if(G){ kload2(kf,kp0+sl_next,j); SBAR(); } }while(0)
  #define STEP(C0,C1,P0,P1,t,GK,GV,GL) do{ SBAR(); \
    const lds_cptr vp_=vp0+2*sl_prev; bf16x8 ka0_=bf16x8{},ka1_=bf16x8{}; \
    VRD(0); SBAR(); float sacc=(P0[0]+P0[1]); \
    GAPA(C0=__builtin_amdgcn_mfma_f32_32x32x16_bf16(kf[0],qr[0],negm,0,0,0), P0[2],P0[3],P0[4],P0[5],     pw0[0]=PKW(P0,0), pw0[1]=PKW(P0,2), pw0); \
    VRD(4); SBAR(); GAPA(C1=__builtin_amdgcn_mfma_f32_32x32x16_bf16(kf[1],qr[0],negm,0,0,0), P0[6],P0[7],P0[8],P0[9],     pw0[2]=PKW(P0,4), pw0[3]=PKW(P0,6), pw0); \
    VRD(1); SBAR(); GAPA(C0=__builtin_amdgcn_mfma_f32_32x32x16_bf16(kf[2],qr[1],C0,0,0,0),   P0[10],P0[11],P0[12],P0[13], pw1[0]=PKW(P0,8), pw1[1]=PKW(P0,10), pw1); \
    VRD(5); SBAR(); GAPA(C1=__builtin_amdgcn_mfma_f32_32x32x16_bf16(kf[3],qr[1],C1,0,0,0),   P0[14],P0[15],P1[0],P1[1],   pw1[2]=PKW(P0,12),pw1[3]=PKW(P0,14), pw1); \
    VRD(2); SBAR(); GAPA(C0=__builtin_amdgcn_mfma_f32_32x32x16_bf16(kf[4],qr[2],C0,0,0,0),   P1[2],P1[3],P1[4],P1[5],     pw2[0]=PKW(P1,0), pw2[1]=PKW(P1,2), pw2); \
    VRD(6); SBAR(); GAPA(C1=__builtin_amdgcn_mfma_f32_32x32x16_bf16(kf[5],qr[2],C1,0,0,0),   P1[6],P1[7],P1[8],P1[9],     pw2[2]=PKW(P1,4), pw2[3]=PKW(P1,6), pw2); \
    if(AUG){ ka0_=KAUG(t,0); ka1_=KAUG(t,1); SBAR(); } \
    VRD(3); SBAR(); GAPA(C0=__builtin_amdgcn_mfma_f32_32x32x16_bf16(kf[6],qr[3],C0,0,0,0),   P1[10],P1[11],P1[12],P1[13], pw3[0]=PKW(P1,8), pw3[1]=PKW(P1,10), pw3); \
    VRD(7); SBAR(); GAPA(C1=__builtin_amdgcn_mfma_f32_32x32x16_bf16(kf[7],qr[3],C1,0,0,0),   P1[14],P1[15],0.f,0.f,       pw3[2]=PKW(P1,12),pw3[3]=PKW(P1,14), pw3); \
    if(AUG){ C0=__builtin_amdgcn_mfma_f32_32x32x16_bf16(ka0_,qaug,C0,0,0,0); C1=__builtin_amdgcn_mfma_f32_32x32x16_bf16(ka1_,qaug,C1,0,0,0); } \
    l_reg+=sacc; \
    if(GK){DMA_K((t)+3,sl_cur);} if(GV){DMA_V((t)+1,sl_next);} \
    CMASK(C0,C1,t); \
    { float a=MX3(C0[0],C0[1],C1[0]),b=MX3(C0[2],C0[3],C1[1]); a=MX3(a,C1[2],C1[3]); \
      _Pragma("unroll") for(int r=4;r<16;r+=4){a=MX3(a,C0[r],C0[r+1]);b=MX3(b,C0[r+2],C0[r+3]);a=MX3(a,C1[r],C1[r+1]);b=MX3(b,C1[r+2],C1[r+3]);} \
      float rm=__builtin_fmaxf(a,b); { auto rr=__builtin_amdgcn_permlane32_swap(__float_as_uint(rm),__float_as_uint(rm),false,false); rm=__builtin_fmaxf(__uint_as_float(rr[0]),__uint_as_float(rr[1])); } \
      resc=false; \
      if(__builtin_expect(__any(rm>(float)THRL),0)){ const float dl=__builtin_fmaxf(rm,0.f); mhat+=dl; \
        _Pragma("unroll") for(int r=0;r<16;++r){C0[r]-=dl;C1[r]-=dl;} \
        _Pragma("unroll") for(int r=0;r<16;++r)negm[r]=-mhat; asm volatile("":"+v"(negm)); \
        const float f=__builtin_amdgcn_exp2f(-dl); l_reg*=f; if(hi==0)wsf[r32]=f; resc=true; } } \
    SBAR(); \
    WRD(0); GAPB(o[0]=__builtin_amdgcn_mfma_f32_32x32x16_bf16(PAF(0),VFR(0),o[0],0,0,0), C0,0); \
    WRD(4); GAPB(o[1]=__builtin_amdgcn_mfma_f32_32x32x16_bf16(PAF(0),VFR(4),o[1],0,0,0), C0,2); \
    WRD(1); GAPB(o[0]=__builtin_amdgcn_mfma_f32_32x32x16_bf16(PAF(1),VFR(1),o[0],0,0,0), C0,4); \
    WRD(5); GAPB(o[1]=__builtin_amdgcn_mfma_f32_32x32x16_bf16(PAF(1),VFR(5),o[1],0,0,0), C0,6); \
    WRD(2); GAPB(o[0]=__builtin_amdgcn_mfma_f32_32x32x16_bf16(PAF(2),VFR(2),o[0],0,0,0), C0,8); \
    WRD(6); GAPB(o[1]=__builtin_amdgcn_mfma_f32_32x32x16_bf16(PAF(2),VFR(6),o[1],0,0,0), C0,10); \
    WRD(3); GAPB(o[0]=__builtin_amdgcn_mfma_f32_32x32x16_bf16(PAF(3),VFR(3),o[0],0,0,0), C0,12); \
    WRD(7); GAPB(o[1]=__builtin_amdgcn_mfma_f32_32x32x16_bf16(PAF(3),VFR(7),o[1],0,0,0), C0,14); \
    GAPB(o[2]=__builtin_amdgcn_mfma_f32_32x32x16_bf16(PAF(0),WFR(0),o[2],0,0,0), C1,0); \
    GAPB(o[3]=__builtin_amdgcn_mfma_f32_32x32x16_bf16(PAF(0),WFR(4),o[3],0,0,0), C1,2); \
    KRD(GL,0); GAPB(o[2]=__builtin_amdgcn_mfma_f32_32x32x16_bf16(PAF(1),WFR(1),o[2],0,0,0), C1,4); \
    KRD(GL,1); GAPB(o[3]=__builtin_amdgcn_mfma_f32_32x32x16_bf16(PAF(1),WFR(5),o[3],0,0,0), C1,6); \
    KRD(GL,2); GAPB(o[2]=__builtin_amdgcn_mfma_f32_32x32x16_bf16(PAF(2),WFR(2),o[2],0,0,0), C1,8); \
    KRD(GL,3); GAPB(o[3]=__builtin_amdgcn_mfma_f32_32x32x16_bf16(PAF(2),WFR(6),o[3],0,0,0), C1,10); \
    GAPB(o[2]=__builtin_amdgcn_mfma_f32_32x32x16_bf16(PAF(3),WFR(3),o[2],0,0,0), C1,12); \
    GAPB(o[3]=__builtin_amdgcn_mfma_f32_32x32x16_bf16(PAF(3),WFR(7),o[3],0,0,0), C1,14); \
    }while(0)
  int t=1;
  #undef CMASK
  #define CMASK(P0,P1,t) do{}while(0)
  for(;t+5<NT;t+=2){
    STEP(pB0,pB1,pA0,pA1,t,true,true,true);     WAIT_BAR(3); RESC(); ROT();
    STEP(pA0,pA1,pB0,pB1,t+1,true,true,true);   WAIT_BAR(3); RESC(); ROT();
  }
  #undef CMASK
  #define CMASK(P0,P1,t) do{ if(CAUSAL){int jb_=(t)-(NT-4); if(jb_>=0)cmask(P0,P1,jb_,qrel,hi);} }while(0)
  #define ENDW(tt) do{ if((tt)+3<NT){WAIT_BAR(3);} else if((tt)+2<NT){WAIT_BAR(2);} else {WAIT_BAR(0);} }while(0)
  for(;t+1<NT;t+=2){
    STEP(pB0,pB1,pA0,pA1,t,(t+3<NT),(t+1<NT),(t+1<NT));       ENDW(t);   RESC(); ROT();
    STEP(pA0,pA1,pB0,pB1,t+1,(t+4<NT),(t+2<NT),(t+2<NT));     ENDW(t+1); RESC(); ROT();
  }
  if(Qn){ const bf16*ksn=Kn+(long)lane*ldk+wid*8;
    glds16(ksn,(unsigned)__builtin_amdgcn_readfirstlane(kdst)); glds16(ksn+(long)KVBLK*ldk,(unsigned)__builtin_amdgcn_readfirstlane(kdst+SLOTB)); glds16(ksn+2L*KVBLK*ldk,(unsigned)__builtin_amdgcn_readfirstlane(kdst+2*SLOTB)); }
  STEP(pB0,pB1,pA0,pA1,NT-1,false,false,false); RESC();
  if(Qn){ const bf16*Qwn=Qn+(long)(wid*QBLK)*ldq;
    #pragma unroll
    for(int d0=0;d0<4;++d0)qr[d0]=*reinterpret_cast<const bf16x8*>(&Qwn[(long)r32*ldq+d0*16+hi*8]);
    if(AUG){
      #pragma unroll
      for(int k_=0;k_<4;++k_){ const int i=tid+512*k_; if(i<NTn*32) av_[k_]=*(const u32x4*)(augn+(long)i*8); } } }
  { float sacc=pB0[0]+pB0[1]; _Pragma("unroll") for(int r=2;r<16;++r)sacc+=pB0[r]; _Pragma("unroll") for(int r=0;r<16;++r)sacc+=pB1[r]; l_reg+=sacc;
    pw0=(u32x4){PKW(pB0,0),PKW(pB0,2),PKW(pB0,4),PKW(pB0,6)};pw1=(u32x4){PKW(pB0,8),PKW(pB0,10),PKW(pB0,12),PKW(pB0,14)};pw2=(u32x4){PKW(pB1,0),PKW(pB1,2),PKW(pB1,4),PKW(pB1,6)};pw3=(u32x4){PKW(pB1,8),PKW(pB1,10),PKW(pB1,12),PKW(pB1,14)};
    SBAR(); pv(o,vb0+2*sl_cur,PAF(0),PAF(1),PAF(2),PAF(3)); pv(o+2,vb0+2*sl_cur+8192,PAF(0),PAF(1),PAF(2),PAF(3)); }
  #undef PKW
  #undef PAF
  #undef VFR
  #undef WFR
  #undef WRD
  #undef PIN
  #undef MX3
  #undef GAPA
  #undef GAPB
  #undef EX
  #undef VRD
  #undef KRD
  #undef STEP
  #undef ENDW
  {auto rr=__builtin_amdgcn_permlane32_swap(__float_as_uint(l_reg),__float_as_uint(l_reg),false,false);l_reg=__uint_as_float(rr[0])+__uint_as_float(rr[1]);}
  if(hi==0)wsf[32+r32]=l_reg;asm volatile("s_waitcnt lgkmcnt(0)":::"memory");
  float rli[16];
  #pragma unroll
  for(int r=0;r<16;++r)rli[r]=__builtin_amdgcn_rcpf(wsf[32+crow(r,hi)]);
  bf16*Ow=Ou+(long)(wid*QBLK)*ldo;
  { bf16*stg=(bf16*)(shm+LDS_OST)+wid*4096;
    #pragma unroll
    for(int r=0;r<16;++r){const int orow=crow(r,hi);
      #pragma unroll
      for(int d0=0;d0<4;++d0)stg[orow*128+d0*32+r32]=f2bf(o[d0][r]*rli[r]);}
    asm volatile("s_waitcnt lgkmcnt(0)":::"memory");
    #pragma unroll
    for(int i=0;i<8;++i){const int row=i*4+(lane>>4),ch=lane&15; const u32x4 v=*(const u32x4*)(stg+row*128+ch*8); ATTN_STORE16(Ow+(long)row*ldo+ch*8,v);} }
  asm volatile("s_waitcnt lgkmcnt(0)\n\ts_barrier":::"memory");
  #undef DMA_K
  #undef DMA_V
  #undef KAUG
  #undef CMASK
  #undef START
  #undef RESC
  #undef ROT
}

__device__ __forceinline__ void cross_panel(const bf16*Qp,int ldq,const bf16*__restrict__ Kp,int ldk,const bf16*__restrict__ Vp,int ldv,bf16*Op,int ldo,char*shm){
  int tid_=threadIdx.x; asm volatile("":"+v"(tid_));
  const int tid=tid_,lane=tid&63,r32=lane&31,hi=lane>>5; const int wid=__builtin_amdgcn_readfirstlane(tid>>6);
  const unsigned lds0=(unsigned)(uintptr_t)shm;
  float*wsf=(float*)(shm+147456)+wid*64;
  bf16*stg=(bf16*)(shm+131072)+wid*1024;
  const bf16*ksrc0=Kp+(long)lane*ldk+wid*8;
  const bf16*vsrc0=Vp+(long)(16*(wid&3)+(lane>>2))*ldv+(wid>>2)*32+(lane&3)*8;
  const int vlane=((lane>>4)&1)*32+(lane&3)*8+(4*hi+((lane&15)>>2))*64;
  #define XDMA(h_,b_) do{ _Pragma("unroll") for(int t_=0;t_<4;++t_){ \
      glds16(ksrc0+(h_)*64+(long)t_*64*ldk,(unsigned)__builtin_amdgcn_readfirstlane(lds0+(b_)*65536+t_*8192+wid*1024)); \
      glds16(vsrc0+(h_)*64+(long)t_*64*ldv,(unsigned)__builtin_amdgcn_readfirstlane(lds0+(b_)*65536+32768+t_*8192+wid*1024)); } }while(0)
  XDMA(0,0);
  float z_=0.f;asm volatile("":"+v"(z_));
  #pragma nounroll
  for(int h=0;h<4;++h){ const int b=h&1;
    bf16x8 qr[4]; const bf16*Qw=Qp+(long)(wid*QBLK)*ldq+h*64;
    #pragma unroll
    for(int d0=0;d0<4;++d0)qr[d0]=*reinterpret_cast<const bf16x8*>(&Qw[(long)r32*ldq+d0*16+hi*8]);
    asm volatile("s_waitcnt vmcnt(0) lgkmcnt(0)\n\ts_barrier":::"memory");
    if(h<3)XDMA(h+1,b^1);
    f32x16 o[2],zero; float mrow=-INFINITY,l=0.f;
    #pragma unroll
    for(int r=0;r<16;++r){o[0][r]=z_;o[1][r]=z_;zero[r]=z_;}
    #pragma unroll
    for(int t=0;t<4;++t){
      f32x16 p0,p1;
      qkt<false>(p0,p1,shm+b*65536+t*8192,qr,zero,r32,hi,bf16x8{},bf16x8{},bf16x8{});
      asm volatile("s_nop 15\n\ts_nop 7":"+v"(p0),"+v"(p1));
      const float rm=rowmax(p0,p1); const float mn=__builtin_fmaxf(mrow,rm); const float alpha=__builtin_amdgcn_exp2f(mrow-mn); mrow=mn;
      float rs=0.f;
      #pragma unroll
      for(int r=0;r<16;++r){p0[r]=__builtin_amdgcn_exp2f(p0[r]-mn);p1[r]=__builtin_amdgcn_exp2f(p1[r]-mn);rs+=p0[r]+p1[r];}
      l=l*alpha+rs;
      if(t>0){ if(hi==0)wsf[r32]=alpha; asm volatile("s_waitcnt lgkmcnt(0)":::"memory");
        #pragma unroll
        for(int d_=0;d_<2;++d_)
          #pragma unroll
          for(int r=0;r<16;++r)o[d_][r]*=wsf[crow(r,hi)];
        asm volatile("s_waitcnt lgkmcnt(0)":::"memory"); }
      const u32x4 pw0={cvtpk_s(p0[0],p0[1]),cvtpk_s(p0[2],p0[3]),cvtpk_s(p0[4],p0[5]),cvtpk_s(p0[6],p0[7])},pw1={cvtpk_s(p0[8],p0[9]),cvtpk_s(p0[10],p0[11]),cvtpk_s(p0[12],p0[13]),cvtpk_s(p0[14],p0[15])};
      const u32x4 pw2={cvtpk_s(p1[0],p1[1]),cvtpk_s(p1[2],p1[3]),cvtpk_s(p1[4],p1[5]),cvtpk_s(p1[6],p1[7])},pw3={cvtpk_s(p1[8],p1[9]),cvtpk_s(p1[10],p1[11]),cvtpk_s(p1[12],p1[13]),cvtpk_s(p1[14],p1[15])};
      SBAR(); pv(o,(int)(lds0+b*65536+32768+t*8192)+vlane,__builtin_bit_cast(bf16x8,pw0),__builtin_bit_cast(bf16x8,pw1),__builtin_bit_cast(bf16x8,pw2),__builtin_bit_cast(bf16x8,pw3));
    }
    {auto rr=__builtin_amdgcn_permlane32_swap(__float_as_uint(l),__float_as_uint(l),false,false);l=__uint_as_float(rr[0])+__uint_as_float(rr[1]);}
    if(hi==0)wsf[32+r32]=l;asm volatile("s_waitcnt lgkmcnt(0)":::"memory");
    float rli[16];
    #pragma unroll
    for(int r=0;r<16;++r)rli[r]=__builtin_amdgcn_rcpf(wsf[32+crow(r,hi)]);
    bf16*Ow=Op+(long)(wid*QBLK)*ldo+h*64;
    #pragma unroll
    for(int d0=0;d0<2;++d0){
      #pragma unroll
      for(int r=0;r<16;++r)stg[crow(r,hi)*32+r32]=f2bf(o[d0][r]*rli[r]);
      asm volatile("s_waitcnt lgkmcnt(0)":::"memory");
      #pragma unroll
      for(int i=0;i<2;++i){const int row=i*16+(lane>>2),ch=lane&3; const u32x4 v=*(const u32x4*)(stg+row*32+ch*8); *(u32x4*)(Ow+(long)row*ldo+d0*32+ch*8)=v;}
      asm volatile("s_waitcnt lgkmcnt(0)":::"memory");
    }
  }
  asm volatile("s_waitcnt lgkmcnt(0)\n\ts_barrier":::"memory");
  #undef XDMA
}
constexpr int ATTN_LDS_BYTES=LDS_BYTES;
#undef SBAR
#undef WAIT_BAR
}
#include <hip/hip_cooperative_groups.h>
namespace cg = cooperative_groups;
#define LAS __attribute__((address_space(3)))
typedef float f32x4 __attribute__((ext_vector_type(4)));
typedef unsigned u32x4 __attribute__((ext_vector_type(4)));
constexpr int NWAVES = 8;
constexpr int RING_BYTES = 131072;
constexpr int STAT_OFF = RING_BYTES;
constexpr int MISC_OFF = STAT_OFF + 16384;
constexpr int LDS_BYTES = 151552;
constexpr size_t WT_IN = 0;
constexpr size_t WT_A = WT_IN + (size_t)5120 * 1024;
constexpr size_t WT_B = WT_A + (size_t)1024 * 512;
constexpr size_t WT_O = WT_B + (size_t)1024 * 512;
constexpr size_t WT_CQ = WT_O + (size_t)1024 * 1024;
constexpr size_t WT_CKV = WT_CQ + (size_t)256 * 1024;
constexpr size_t WT_CO = WT_CKV + (size_t)512 * 1024;
constexpr size_t WT_E1 = WT_CO + (size_t)1024 * 256;
constexpr size_t WT_E2 = WT_E1 + (size_t)32 * 1024 * 1024;
constexpr size_t WT_END = WT_E2 + (size_t)32 * 1024 * 512;
static_assert(WT_END * 2 <= 112 * MiB, "weights fit");

constexpr size_t WS_WG8 = 126 * MiB;
constexpr size_t WS_XN8 = 880 * MiB;
constexpr float WSCALE = 32.f;
struct Args {
    const float* in[28]; float* out; unsigned char* ws; int ph_lo, ph_hi, coop, pad;
};

__device__ __forceinline__ int wcol_in(int n) {
    const int tile = n >> 8, p = n & 255;
    if (tile < 6) return n;
    if (tile < 10) { const int base = tile < 8 ? 1544 : 2056, tl = (tile - 6) & 1; return base + (tl * 4 + ((p & 127) >> 5)) * 64 + (p >> 7) * 32 + (p & 31); }
    if (tile < 12) return 2568 + (n - 2560);
    return 3080 + (n - 3072);
}
__device__ __forceinline__ void p0_transpose_item(const float* W, int ldw, int sc, bf16_t* WT, int K, int n0, int k0, LAS float* scr, int lane, const float* gk = nullptr) {
#pragma unroll
    for (int i = 0; i < 32; ++i) { const int kk = 2 * i + (lane >> 5); const float gv = gk ? gk[k0 + kk] : 1.f; scr[kk * 33 + (lane & 31)] = W[(size_t)(k0 + kk) * ldw + sc + (lane & 31)] * gv; }
    asm volatile("s_waitcnt lgkmcnt(0)" ::: "memory");
    const int c = lane & 7;
#pragma unroll
    for (int j = 0; j < 4; ++j) { const int n = (lane >> 3) + 8 * j; const LAS float* s = scr + (8 * c) * 33 + n;
        u32x4 o; o.x = pg8::cvt_pk_bf16(s[0 * 33], s[1 * 33]); o.y = pg8::cvt_pk_bf16(s[2 * 33], s[3 * 33]); o.z = pg8::cvt_pk_bf16(s[4 * 33], s[5 * 33]); o.w = pg8::cvt_pk_bf16(s[6 * 33], s[7 * 33]);
        *(u32x4*)(WT + (size_t)(n0 + n) * K + k0 + 8 * c) = o; }
    asm volatile("s_waitcnt lgkmcnt(0)" ::: "memory");
}
__device__ __forceinline__ void p0_transpose_item_f8(const float* W, int ldw, int sc, unsigned char* WT8, int Kb, int n0, int k0, LAS float* scr, int lane, const float* gk, float scale) {
#pragma unroll
    for (int i = 0; i < 32; ++i) { const int kk = 2 * i + (lane >> 5); const float gv = (gk ? gk[k0 + kk] : 1.f) * scale; scr[kk * 33 + (lane & 31)] = W[(size_t)(k0 + kk) * ldw + sc + (lane & 31)] * gv; }
    asm volatile("s_waitcnt lgkmcnt(0)" ::: "memory");
    const int c = lane & 7;
#pragma unroll
    for (int j = 0; j < 4; ++j) { const int n = (lane >> 3) + 8 * j; const LAS float* s = scr + (8 * c) * 33 + n;
        unsigned w0 = 0u, w1 = 0u;
        w0 = __builtin_amdgcn_cvt_pk_fp8_f32(s[0 * 33], s[1 * 33], w0, false); w0 = __builtin_amdgcn_cvt_pk_fp8_f32(s[2 * 33], s[3 * 33], w0, true);
        w1 = __builtin_amdgcn_cvt_pk_fp8_f32(s[4 * 33], s[5 * 33], w1, false); w1 = __builtin_amdgcn_cvt_pk_fp8_f32(s[6 * 33], s[7 * 33], w1, true);
        *(uint2*)(WT8 + (size_t)(n0 + n) * Kb + k0 + 8 * c) = make_uint2(w0, w1); }
    asm volatile("s_waitcnt lgkmcnt(0)" ::: "memory");
}
__device__ __forceinline__ bool p0_job_plain(int& r, const float* W, int Kd, int Nd, bf16_t* WT, LAS float* scr, int lane, const float* gk = nullptr, int ldt = 0) {
    const int nblk = Nd / 32, items = (Kd / 64) * nblk;
    if (r >= items) { r -= items; return false; }
    const int kb = r / nblk, nb = r % nblk;
    p0_transpose_item(W, Nd, nb * 32, WT, ldt ? ldt : Kd, nb * 32, kb * 64, scr, lane, gk); return true;
}

template <bool E1MAP> __device__ __forceinline__ void p0_slab_f8(const float* W, int ldw, int c0, int k0, unsigned char* WT8, int Kb, int up, const float* gk, float scale, LAS float* scr, int tid) {
    const int col = (tid & 63) * 4;
    f32x4 v[16];
#pragma unroll
    for (int i = 0; i < 16; ++i) v[i] = *(const f32x4*)(W + (size_t)(k0 + (tid >> 6) + 8 * i) * ldw + c0 + col);
#pragma unroll
    for (int i = 0; i < 16; ++i) { const int r = (tid >> 6) + 8 * i; const float s = (gk ? gk[k0 + r] : 1.f) * scale; LAS float* d = scr + r * 257 + col;
        d[0] = v[i][0] * s; d[1] = v[i][1] * s; d[2] = v[i][2] * s; d[3] = v[i][3] * s; }
    asm volatile("s_waitcnt lgkmcnt(0)" ::: "memory");
    __syncthreads();
#pragma unroll
    for (int j = 0; j < 8; ++j) { const int idx = tid + 512 * j; const int kc = idx & 15, n = idx >> 4; const LAS float* s = scr + (8 * kc) * 257 + n;
        unsigned w0 = 0u, w1 = 0u;
        w0 = __builtin_amdgcn_cvt_pk_fp8_f32(s[0 * 257], s[1 * 257], w0, false); w0 = __builtin_amdgcn_cvt_pk_fp8_f32(s[2 * 257], s[3 * 257], w0, true);
        w1 = __builtin_amdgcn_cvt_pk_fp8_f32(s[4 * 257], s[5 * 257], w1, false); w1 = __builtin_amdgcn_cvt_pk_fp8_f32(s[6 * 257], s[7 * 257], w1, true);
        const int c = c0 + n; const int row = E1MAP ? ((c >> 7) * 256 + (c & 127) + 128 * up) : c;
        *(uint2*)(WT8 + (size_t)row * Kb + k0 + 8 * kc) = make_uint2(w0, w1); }
    asm volatile("s_waitcnt lgkmcnt(0)" ::: "memory");
    __syncthreads();
}
template <bool WIN> __device__ __forceinline__ void p0_slab_bf16(const float* W, int ldw, int c0, int k0, bf16_t* WT, int Kd, const float* gk, LAS float* scr, int tid) {
    const int col = (tid & 63) * 4; const int scol = WIN ? wcol_in(c0 + col) : c0 + col;
    f32x4 v[16];
#pragma unroll
    for (int i = 0; i < 16; ++i) v[i] = *(const f32x4*)(W + (size_t)(k0 + (tid >> 6) + 8 * i) * ldw + scol);
#pragma unroll
    for (int i = 0; i < 16; ++i) { const int r = (tid >> 6) + 8 * i; const float s = gk ? gk[k0 + r] : 1.f; LAS float* d = scr + r * 257 + col;
        d[0] = v[i][0] * s; d[1] = v[i][1] * s; d[2] = v[i][2] * s; d[3] = v[i][3] * s; }
    asm volatile("s_waitcnt lgkmcnt(0)" ::: "memory");
    __syncthreads();
#pragma unroll
    for (int j = 0; j < 8; ++j) { const int idx = tid + 512 * j; const int kc = idx & 15, n = idx >> 4; const LAS float* s = scr + (8 * kc) * 257 + n;
        u32x4 o; o.x = pg8::cvt_pk_bf16(s[0 * 257], s[1 * 257]); o.y = pg8::cvt_pk_bf16(s[2 * 257], s[3 * 257]); o.z = pg8::cvt_pk_bf16(s[4 * 257], s[5 * 257]); o.w = pg8::cvt_pk_bf16(s[6 * 257], s[7 * 257]);
        *(u32x4*)(WT + (size_t)(c0 + n) * Kd + k0 + 8 * kc) = o; }
    asm volatile("s_waitcnt lgkmcnt(0)" ::: "memory");
    __syncthreads();
}
__device__ __forceinline__ void p0_prologue(const Args& a, LAS unsigned char* lds, int vcu, int G, int wave, int lane, int tid) {
    unsigned char* ws = a.ws;
    bf16_t* wt = (bf16_t*)(ws + WS_WT);
    LAS float* scr = (LAS float*)(lds + wave * 16384);
    const int gw = vcu * NWAVES + wave, NGW = G * NWAVES;
    constexpr int I_IN = 16 * 160, I_A = 8 * 32, I_O = 16 * 32, I_CQ = 16 * 8, I_CKV = 16 * 16, I_CO = 4 * 32, I_E1 = 16 * 32, I_E2 = 8 * 32;
    constexpr int NITEMS = I_IN + 2 * I_A + I_O + I_CQ + I_CKV + I_CO;
    for (int it = vcu; it < 1024 + 512; it += G) {
        if (it < 1024) { const int e = it >> 5, q = it & 31, up = q >> 4, ks = (q >> 1) & 7, cs = q & 1;
            p0_slab_f8<true>((up ? a.in[25] : a.in[24]) + (size_t)e * 1024 * 512, 512, cs * 256, ks * 128, (unsigned char*)(wt + WT_E1) + (size_t)e * 1024 * 1024, 1024, up, a.in[19], WSCALE, (LAS float*)lds, tid); }
        else { const int r2 = it - 1024, e = r2 >> 4, q = r2 & 15, ks = q >> 2, cs = q & 3;
            p0_slab_f8<false>(a.in[26] + (size_t)e * 512 * 1024, 1024, cs * 256, ks * 128, (unsigned char*)(wt + WT_E2) + (size_t)e * 1024 * 512, 512, 0, nullptr, WSCALE, (LAS float*)lds, tid); }
    }
#ifndef REP_PHASE
#define REP_PHASE -1
#endif
    for (int it = vcu; it < 256; it += G) {
        int r = it; LAS float* sl = (LAS float*)lds;
        if (r < 160) { p0_slab_bf16<true>(a.in[4], INW, (r % 20) * 256, (r / 20) * 128, wt + WT_IN, 1024, nullptr, sl, tid); continue; } r -= 160;
        if (r < 16) { p0_slab_bf16<false>(a.in[6], 1024, (r & 3) * 256, (r >> 2) * 128, wt + WT_A, 512, nullptr, sl, tid); continue; } r -= 16;
        if (r < 16) { p0_slab_bf16<false>(a.in[7], 1024, (r & 3) * 256, (r >> 2) * 128, wt + WT_B, 512, nullptr, sl, tid); continue; } r -= 16;
        if (r < 32) { p0_slab_bf16<false>(a.in[8], 1024, (r & 3) * 256, (r >> 2) * 128, wt + WT_O, 1024, nullptr, sl, tid); continue; } r -= 32;
        if (r < 8) { p0_slab_bf16<false>(a.in[16], 256, 0, r * 128, wt + WT_CQ, 1024, a.in[14], sl, tid); continue; } r -= 8;
        if (r < 16) { p0_slab_bf16<false>(a.in[17], 512, (r & 1) * 256, (r >> 1) * 128, wt + WT_CKV, 1024, nullptr, sl, tid); continue; } r -= 16;
        p0_slab_bf16<false>(a.in[18], 1024, (r & 3) * 256, (r >> 2) * 128, wt + WT_CO, 256, nullptr, sl, tid);
    }
    {
        const float* w_in = a.in[4]; const float* x = a.in[0]; const float* g = a.in[3]; const float* bfg = a.in[5];
        bf16_t* xn = (bf16_t*)(ws + WS_R1); float* logf = (float*)(ws + WS_LOGF); unsigned char* xn8 = ws + WS_XN8;
        float wf[16][8]; f32x4 gg[4];
#pragma unroll
        for (int j = 0; j < 4; ++j) { const int c = (lane + 64 * j) * 4; gg[j] = *(const f32x4*)(g + c);
#pragma unroll
            for (int q = 0; q < 4; ++q) { const f32x4 w0 = *(const f32x4*)(w_in + (size_t)(c + q) * INW + 1536), w1 = *(const f32x4*)(w_in + (size_t)(c + q) * INW + 1540);
                wf[j * 4 + q][0] = w0[0]; wf[j * 4 + q][1] = w0[1]; wf[j * 4 + q][2] = w0[2]; wf[j * 4 + q][3] = w0[3]; wf[j * 4 + q][4] = w1[0]; wf[j * 4 + q][5] = w1[1]; wf[j * 4 + q][6] = w1[2]; wf[j * 4 + q][7] = w1[3]; } }
        float bb[8];
#pragma unroll
        for (int h = 0; h < 8; ++h) bb[h] = bfg[h];
        const int hsel = ((lane >> 5) & 1) * 4 + ((lane >> 4) & 1) * 2 + ((lane >> 3) & 1);
        for (int rq_ = 0; rq_ < ((REP_PHASE) == 31 ? 2 : 1); ++rq_)
        for (int base = gw; base < T_; base += 4 * NGW) {
            f32x4 v[4][4];
#pragma unroll
            for (int q4 = 0; q4 < 4; ++q4) { const int row = base + q4 * NGW; if (row < T_) { const f32x4* xr = (const f32x4*)(x + (size_t)row * D_);
#pragma unroll
                for (int j = 0; j < 4; ++j) v[q4][j] = xr[lane + 64 * j]; } }
#pragma unroll
            for (int q4 = 0; q4 < 4; ++q4) { const int row = base + q4 * NGW; if (row < T_) {
                float ss = 0.f;
#pragma unroll
                for (int j = 0; j < 4; ++j) ss += v[q4][j][0] * v[q4][j][0] + v[q4][j][1] * v[q4][j][1] + v[q4][j][2] * v[q4][j][2] + v[q4][j][3] * v[q4][j][3];
                ss = wave_sum(ss);
                const float rstd = rsqrtf(ss * (1.f / D_) + 1e-6f);
                float fl[8];
#pragma unroll
                for (int h = 0; h < 8; ++h) fl[h] = 0.f;
#pragma unroll
                for (int j = 0; j < 4; ++j) {
                    const int c = (lane + 64 * j) * 4;
                    const f32x4 o = v[q4][j] * rstd * gg[j];
                    uint2 pk; pk.x = pg8::cvt_pk_bf16(o[0], o[1]); pk.y = pg8::cvt_pk_bf16(o[2], o[3]);
                    *(uint2*)(xn + (size_t)row * D_ + c) = pk;
#pragma unroll
                    for (int q = 0; q < 4; ++q)
#pragma unroll
                        for (int h = 0; h < 8; ++h) fl[h] += o[q] * wf[j * 4 + q][h];
                }
                float f4[4], f2[2], f1;
                { const bool up = (lane & 32) != 0;
#pragma unroll
                  for (int h = 0; h < 4; ++h) { const float snd = up ? fl[h] : fl[h + 4], kp = up ? fl[h + 4] : fl[h]; f4[h] = kp + __shfl_xor(snd, 32); } }
                { const bool up = (lane & 16) != 0;
#pragma unroll
                  for (int h = 0; h < 2; ++h) { const float snd = up ? f4[h] : f4[h + 2], kp = up ? f4[h + 2] : f4[h]; f2[h] = kp + __shfl_xor(snd, 16); } }
                { const bool up = (lane & 8) != 0; const float snd = up ? f2[0] : f2[1], kp = up ? f2[1] : f2[0]; f1 = kp + __shfl_xor(snd, 8); }
                f1 += __shfl_xor(f1, 4); f1 += __shfl_xor(f1, 2); f1 += __shfl_xor(f1, 1);
                float bsel = bb[0];
#pragma unroll
                for (int h = 1; h < 8; ++h) bsel = (hsel == h) ? bb[h] : bsel;
                const float z = f1 + bsel;
                const float ls = fminf(z, 0.f) - log1pf(__expf(-fabsf(z)));
                const int b = row / S_, s = row % S_;
                if ((lane & 7) == 0) logf[((size_t)b * 8 + hsel) * S_ + s] = ls;
            } }
        }
    }
    {
        const float* x = a.in[1]; const float* g = a.in[15]; bf16_t* mn = (bf16_t*)(ws + WS_MEMN);
        for (int row = gw; row < B_ * MEML; row += NGW) {
            const f32x4* xr = (const f32x4*)(x + (size_t)row * D_);
            f32x4 v[4]; float ss = 0.f;
#pragma unroll
            for (int j = 0; j < 4; ++j) { v[j] = xr[lane + 64 * j]; ss += v[j][0] * v[j][0] + v[j][1] * v[j][1] + v[j][2] * v[j][2] + v[j][3] * v[j][3]; }
            ss = wave_sum(ss);
            const float rstd = rsqrtf(ss * (1.f / D_) + 1e-6f);
#pragma unroll
            for (int j = 0; j < 4; ++j) { const int c = (lane + 64 * j) * 4; const f32x4 o = v[j] * rstd * *(const f32x4*)(g + c);
                uint2 pk; pk.x = pg8::cvt_pk_bf16(o[0], o[1]); pk.y = pg8::cvt_pk_bf16(o[2], o[3]); *(uint2*)(mn + (size_t)row * D_ + c) = pk; }
        }
    }
    {
        bf16_t* wrh = (bf16_t*)(ws + (size_t)116 * MiB); bf16_t* wrl = wrh + 48 * 1024;
        const int gt = gw * 64 + lane, NGT = NGW * 64;
        for (int i = gt; i < 48 * 1024; i += NGT) { const int o = i >> 10, k = i & 1023;
            const float w = (o < 4 ? a.in[20][k * 4 + o] : (o < 36 ? a.in[22][k * 32 + o - 4] : 0.f)) * a.in[19][k];
            const bf16_t h = f2bf(w); wrh[i] = h; wrl[i] = f2bf(w - bf2f(h)); }
    }
    {
        const int* pos = (const int*)a.in[2]; float* tab = (float*)(ws + WS_ROPE);
        const int gt = gw * 64 + lane, NGT = NGW * 64;
        for (int i = gt; i < T_ * 32; i += NGT) {
            const int f = i & 31, r = i >> 5;
            const float inv = exp2f(-(float)f * (2.0f / 64.0f) * 13.287712379549449f);
            const float ang = (float)pos[r] * inv;
            float sn, cs; sincosf(ang, &sn, &cs);
            *(float2*)(tab + (size_t)i * 2) = make_float2(cs, sn);
        }
    }
}

__device__ __forceinline__ void p1_cumsum(float* c, bf16_t* kaug, int bh, LAS float* part, int tid) {
    float* p = c + (size_t)bh * S_ + tid * 8;
    float v[8]; float s = 0.f;
    const f32x4 a0 = *(const f32x4*)p, a1 = *(const f32x4*)(p + 4);
    const float in[8] = {a0[0], a0[1], a0[2], a0[3], a1[0], a1[1], a1[2], a1[3]};
#pragma unroll
    for (int i = 0; i < 8; ++i) { s += in[i]; v[i] = s; }
    part[tid] = s; __syncthreads();
    float pre = 0.f;
    for (int i = 0; i < tid; ++i) pre += part[i];
    __syncthreads();
#pragma unroll
    for (int i = 0; i < 8; ++i) {
        const float cv = v[i] + pre; p[i] = cv;
        const float bia = -cv * LOG2E;
        const bf16_t h0 = f2bf(bia); const float r1 = bia - bf2f(h0); const bf16_t h1 = f2bf(r1); const float r2 = r1 - bf2f(h1); const bf16_t h2 = f2bf(r2);
        uint2 pk; pk.x = (unsigned)h0 | ((unsigned)h1 << 16); pk.y = (unsigned)h2;
        *(uint2*)(kaug + ((size_t)bh * S_ + tid * 8 + i) * 4) = pk;
    }
}

struct EpiIn {
    static constexpr bool PERM = true, HAS_MID = false, HAS_PF = false;
    bf16_t *fq, *fk, *fv, *dq, *dk, *dv, *sig; const float* rope;
    __device__ __forceinline__ void operator()(const f32x4 (&acc)[2][2][4][2], const pg8::Unit& u, int wr, int wc, int fr_, int fq_) const {
        int fr = fr_; asm volatile("" : "+v"(fr));
        const int row0 = u.pm * 256 + wr * 64 + fr; const int pn = u.pn;
        if (pn >= 6 && pn < 10) {
            bf16_t* base = pn < 8 ? dq : dk; const float sc = pn < 8 ? C2 : 1.f; const int tl = (pn - 6) & 1;
            const int colL = (tl * 4 + wc) * 64 + 8 * fq_;
#pragma unroll
            for (int ai = 0; ai < 2; ++ai)
#pragma unroll
                for (int m = 0; m < 4; ++m) {
                    const int row = row0 + ai * 128 + m * 16;
                    const f32x4* tb = (const f32x4*)(rope + ((size_t)row * 32 + 8 * fq_) * 2);
                    const f32x4 t0 = tb[0], t1 = tb[1], t2 = tb[2], t3 = tb[3];
                    const float cs[8] = {t0[0], t0[2], t1[0], t1[2], t2[0], t2[2], t3[0], t3[2]}, sn[8] = {t0[1], t0[3], t1[1], t1[3], t2[1], t2[3], t3[1], t3[3]};
                    const float x1[8] = {acc[ai][0][m][0][0], acc[ai][0][m][0][1], acc[ai][0][m][0][2], acc[ai][0][m][0][3], acc[ai][0][m][1][0], acc[ai][0][m][1][1], acc[ai][0][m][1][2], acc[ai][0][m][1][3]};
                    const float x2[8] = {acc[ai][1][m][0][0], acc[ai][1][m][0][1], acc[ai][1][m][0][2], acc[ai][1][m][0][3], acc[ai][1][m][1][0], acc[ai][1][m][1][1], acc[ai][1][m][1][2], acc[ai][1][m][1][3]};
                    float o1[8], o2[8];
#pragma unroll
                    for (int j = 0; j < 8; ++j) { o1[j] = (x1[j] * cs[j] - x2[j] * sn[j]) * sc; o2[j] = (x2[j] * cs[j] + x1[j] * sn[j]) * sc; }
                    u32x4 w1, w2;
                    w1.x = pg8::cvt_pk_bf16(o1[0], o1[1]); w1.y = pg8::cvt_pk_bf16(o1[2], o1[3]); w1.z = pg8::cvt_pk_bf16(o1[4], o1[5]); w1.w = pg8::cvt_pk_bf16(o1[6], o1[7]);
                    w2.x = pg8::cvt_pk_bf16(o2[0], o2[1]); w2.y = pg8::cvt_pk_bf16(o2[2], o2[3]); w2.z = pg8::cvt_pk_bf16(o2[4], o2[5]); w2.w = pg8::cvt_pk_bf16(o2[6], o2[7]);
                    bf16_t* rp = base + (size_t)row * 512 + colL;
                    *(u32x4*)rp = w1; *(u32x4*)(rp + 32) = w2;
                }
        } else {
            bf16_t* base; int ld, colt; float sc = 1.f; bool sg = false;
            if (pn < 2) { base = fq; ld = 512; colt = pn * 256; sc = C2; }
            else if (pn < 4) { base = fk; ld = 512; colt = (pn - 2) * 256; }
            else if (pn < 6) { base = fv; ld = 512; colt = (pn - 4) * 256; }
            else if (pn < 12) { base = dv; ld = 512; colt = (pn - 10) * 256; }
            else { base = sig; ld = 2048; colt = (pn - 12) * 256; sg = true; }
            const int col0 = colt + wc * 32 + 8 * fq_;
#pragma unroll
            for (int ai = 0; ai < 2; ++ai)
#pragma unroll
                for (int m = 0; m < 4; ++m) { bf16_t* rowp = base + (size_t)(row0 + ai * 128 + m * 16) * ld + col0;
#pragma unroll
                    for (int bj = 0; bj < 2; ++bj) { f32x4 v0 = acc[ai][bj][m][0], v1 = acc[ai][bj][m][1];
                        if (sg) {
#pragma unroll
                            for (int q = 0; q < 4; ++q) { v0[q] = __builtin_amdgcn_rcpf(1.f + __expf(-v0[q])); v1[q] = __builtin_amdgcn_rcpf(1.f + __expf(-v1[q])); } }
                        else { v0 = v0 * sc; v1 = v1 * sc; }
                        u32x4 w; w.x = pg8::cvt_pk_bf16(v0[0], v0[1]); w.y = pg8::cvt_pk_bf16(v0[2], v0[3]); w.z = pg8::cvt_pk_bf16(v1[0], v1[1]); w.w = pg8::cvt_pk_bf16(v1[2], v1[3]);
                        *(u32x4*)(rowp + bj * 128) = w; } }
        }
    }
};
struct EpiGate8 {
    static constexpr bool PERM = true, HAS_MID = false, HAS_PF = false;
    bf16_t* sig;
    __device__ __forceinline__ void operator()(const f32x4 (&acc)[2][2][4][2], const pg8::Unit& u, int wr, int wc, int fr_, int fq_) const {
        int fr = fr_; asm volatile("" : "+v"(fr));
        const int row0 = u.pm * 256 + wr * 64 + fr; const int col0 = u.pn * 256 + wc * 32 + 8 * fq_;
#pragma unroll
        for (int ai = 0; ai < 2; ++ai)
#pragma unroll
            for (int m = 0; m < 4; ++m) { bf16_t* rowp = sig + (size_t)(row0 + ai * 128 + m * 16) * 2048 + col0;
#pragma unroll
                for (int bj = 0; bj < 2; ++bj) { f32x4 v0 = acc[ai][bj][m][0], v1 = acc[ai][bj][m][1];
#pragma unroll
                    for (int q = 0; q < 4; ++q) { v0[q] = __builtin_amdgcn_rcpf(1.f + __expf(v0[q] * (-1.f / WSCALE))); v1[q] = __builtin_amdgcn_rcpf(1.f + __expf(v1[q] * (-1.f / WSCALE))); }
                    u32x4 w; w.x = pg8::cvt_pk_bf16(v0[0], v0[1]); w.y = pg8::cvt_pk_bf16(v0[2], v0[3]); w.z = pg8::cvt_pk_bf16(v1[0], v1[1]); w.w = pg8::cvt_pk_bf16(v1[2], v1[3]);
                    *(u32x4*)(rowp + bj * 128) = w; } }
    }
};
struct EpiBf {
    static constexpr bool PERM = true, HAS_MID = false, HAS_PF = false;
    bf16_t* O; int ldc; float sc;
    __device__ __forceinline__ void operator()(const f32x4 (&acc)[2][2][4][2], const pg8::Unit& u, int wr, int wc, int fr_, int fq_) const {
        int fr = fr_; asm volatile("" : "+v"(fr));
        const int row0 = u.pm * 256 + wr * 64 + fr; const int col0 = u.pn * 256 + wc * 32 + 8 * fq_;
#pragma unroll
        for (int ai = 0; ai < 2; ++ai)
#pragma unroll
            for (int m = 0; m < 4; ++m) { bf16_t* rowp = O + (size_t)(row0 + ai * 128 + m * 16) * ldc + col0;
#pragma unroll
                for (int bj = 0; bj < 2; ++bj) { const f32x4 v0 = acc[ai][bj][m][0] * sc, v1 = acc[ai][bj][m][1] * sc;
                    u32x4 w; w.x = pg8::cvt_pk_bf16(v0[0], v0[1]); w.y = pg8::cvt_pk_bf16(v0[2], v0[3]); w.z = pg8::cvt_pk_bf16(v1[0], v1[1]); w.w = pg8::cvt_pk_bf16(v1[2], v1[3]);
                    *(u32x4*)(rowp + bj * 128) = w; } }
    }
};

constexpr size_t WS_RT = 116 * MiB;
constexpr size_t WS_LRS = 118 * MiB;
__device__ __forceinline__ float shx(float v, int mask, int lane) { return __int_as_float(__builtin_amdgcn_ds_bpermute((lane ^ mask) << 2, __float_as_int(v))); }
__device__ __forceinline__ float wave_sum_l(float v, int lane) {
#pragma unroll
    for (int o = 1; o < 64; o <<= 1) v += shx(v, o, lane);
    return v;
}
__device__ __forceinline__ void wg_fence() {
    asm volatile("s_waitcnt vmcnt(0) lgkmcnt(0)" ::: "memory");
    __builtin_amdgcn_fence(__ATOMIC_ACQUIRE, "agent");
    __syncthreads();
}
__device__ __forceinline__ float bflo(unsigned w) { return __uint_as_float(w << 16); }
__device__ __forceinline__ float bfhi(unsigned w) { return __uint_as_float(w & 0xffff0000u); }
#define EPI_FENCE() asm volatile("" ::: "memory")
__device__ __forceinline__ void pf_touch(const void* p, unsigned& sink) { asm volatile("global_load_dword %0, %1, off" : "+v"(sink) : "v"(p) : "memory"); }
template <bool SECOND> struct EpiGate {
    static constexpr bool PERM = true, HAS_MID = false, HAS_PF = false;
    const bf16_t* sig; bf16_t* merged;
    __device__ __forceinline__ void operator()(const f32x4 (&acc)[2][2][4][2], const pg8::Unit& u, int wr, int wc, int fr_, int fq_) const {
        int fr = fr_; asm volatile("" : "+v"(fr));
        const int row0 = u.pm * 256 + wr * 64 + fr; const int col0 = u.pn * 256 + wc * 32 + 8 * fq_;
        u32x4 sgb[2][2], mob[2][2];
#define EG_LOAD(g, s) do { const size_t row_ = (size_t)(row0 + ((g) >> 2) * 128 + ((g) & 3) * 16); _Pragma("unroll") for (int bj = 0; bj < 2; ++bj) { \
            sgb[s][bj] = *(const u32x4*)(sig + row_ * 2048 + (SECOND ? 1024 : 0) + col0 + bj * 128); if (SECOND) mob[s][bj] = *(const u32x4*)(merged + row_ * 1024 + col0 + bj * 128); } } while (0)
        EG_LOAD(0, 0);
#pragma unroll
        for (int g = 0; g < 8; ++g) {
            const int s = g & 1, ai = g >> 2, m = g & 3;
            if (g + 1 < 8) EG_LOAD(g + 1, s ^ 1);
            EPI_FENCE();
            const size_t row = (size_t)(row0 + ai * 128 + m * 16);
#pragma unroll
            for (int bj = 0; bj < 2; ++bj) {
                const f32x4 v0 = acc[ai][bj][m][0], v1 = acc[ai][bj][m][1];
                float r[8] = {v0[0], v0[1], v0[2], v0[3], v1[0], v1[1], v1[2], v1[3]};
                const unsigned sw[4] = {sgb[s][bj].x, sgb[s][bj].y, sgb[s][bj].z, sgb[s][bj].w};
#pragma unroll
                for (int q = 0; q < 4; ++q) { r[2 * q] *= bflo(sw[q]); r[2 * q + 1] *= bfhi(sw[q]); }
                if (SECOND) { const unsigned mw[4] = {mob[s][bj].x, mob[s][bj].y, mob[s][bj].z, mob[s][bj].w};
#pragma unroll
                    for (int q = 0; q < 4; ++q) { r[2 * q] += bflo(mw[q]); r[2 * q + 1] += bfhi(mw[q]); } }
                u32x4 w; w.x = pg8::cvt_pk_bf16(r[0], r[1]); w.y = pg8::cvt_pk_bf16(r[2], r[3]); w.z = pg8::cvt_pk_bf16(r[4], r[5]); w.w = pg8::cvt_pk_bf16(r[6], r[7]);
                *(u32x4*)(merged + row * 1024 + col0 + bj * 128) = w; }
            EPI_FENCE();
        }
#undef EG_LOAD
    }
};
template <bool BASE_BF16> struct EpiRes {
    static constexpr bool PERM = true, HAS_MID = false, HAS_PF = false;
    const void* base; bf16_t* xo; LAS float* stats; unsigned char* q8;
    __device__ __forceinline__ void operator()(const f32x4 (&acc)[2][2][4][2], const pg8::Unit& u, int wr, int wc, int fr_, int fq_) const {
        int fr = fr_; asm volatile("" : "+v"(fr));
        const int col0 = u.pn * 256 + wc * 32 + 8 * fq_; const int rl0 = wr * 64 + fr;
        f32x4 fb[2][2][2]; u32x4 hb[2][2];
#define ER_LOAD(g, s) do { const size_t row_ = (size_t)(u.pm * 256 + rl0 + ((g) >> 2) * 128 + ((g) & 3) * 16); _Pragma("unroll") for (int bj = 0; bj < 2; ++bj) { \
            if (BASE_BF16) hb[s][bj] = *(const u32x4*)((const bf16_t*)base + row_ * 2048 + col0 + bj * 128); \
            else { const float* p_ = (const float*)base + row_ * 1024 + col0 + bj * 128; fb[s][bj][0] = *(const f32x4*)p_; fb[s][bj][1] = *(const f32x4*)(p_ + 4); } } } while (0)
        ER_LOAD(0, 0);
#pragma unroll
        for (int g = 0; g < 8; ++g) {
            const int s = g & 1, ai = g >> 2, m = g & 3;
            if (g + 1 < 8) ER_LOAD(g + 1, s ^ 1);
            EPI_FENCE();
            const int rl = rl0 + ai * 128 + m * 16; const size_t row = (size_t)(u.pm * 256 + rl); float ss = 0.f;
#pragma unroll
            for (int bj = 0; bj < 2; ++bj) {
                f32x4 o0, o1;
                if (BASE_BF16) { const u32x4 h = hb[s][bj]; o0 = (f32x4){bflo(h.x), bfhi(h.x), bflo(h.y), bfhi(h.y)}; o1 = (f32x4){bflo(h.z), bfhi(h.z), bflo(h.w), bfhi(h.w)}; }
                else { o0 = fb[s][bj][0]; o1 = fb[s][bj][1]; }
                o0 = o0 + acc[ai][bj][m][0]; o1 = o1 + acc[ai][bj][m][1];
                ss += (o0[0] * o0[0] + o0[1] * o0[1]) + (o0[2] * o0[2] + o0[3] * o0[3]) + (o1[0] * o1[0] + o1[1] * o1[1]) + (o1[2] * o1[2] + o1[3] * o1[3]);
                u32x4 w; w.x = pg8::cvt_pk_bf16(o0[0], o0[1]); w.y = pg8::cvt_pk_bf16(o0[2], o0[3]); w.z = pg8::cvt_pk_bf16(o1[0], o1[1]); w.w = pg8::cvt_pk_bf16(o1[2], o1[3]);
                *(u32x4*)(xo + row * 2048 + col0 + bj * 128) = w;
                if (q8) { unsigned q0 = 0u, q1 = 0u;
#define CL8(v) __builtin_amdgcn_fmed3f((v), -448.f, 448.f)
                    q0 = __builtin_amdgcn_cvt_pk_fp8_f32(CL8(o0[0]), CL8(o0[1]), q0, false); q0 = __builtin_amdgcn_cvt_pk_fp8_f32(CL8(o0[2]), CL8(o0[3]), q0, true);
                    q1 = __builtin_amdgcn_cvt_pk_fp8_f32(CL8(o1[0]), CL8(o1[1]), q1, false); q1 = __builtin_amdgcn_cvt_pk_fp8_f32(CL8(o1[2]), CL8(o1[3]), q1, true);
                    *(uint2*)(q8 + row * 2048 + col0 + bj * 128) = make_uint2(q0, q1); } }
            ss += shx(ss, 16, fq_ * 16 + fr); ss += shx(ss, 32, fq_ * 16 + fr);
            if (fq_ == 0) stats[(u.pn * 256 + rl) * 4 + wc] = ss;
            EPI_FENCE();
        }
#undef ER_LOAD
    }
};
__device__ __forceinline__ float row_rstd(const LAS float* stats, int rl, float eps) {
    float s = 0.f;
#pragma unroll
    for (int pn = 0; pn < 4; ++pn) { const f32x4 v = *(const LAS f32x4*)(stats + (pn * 256 + rl) * 4); s += (v[0] + v[1]) + (v[2] + v[3]); }
    return rsqrtf(s * (1.f / 1024.f) + eps);
}
struct EpiQ {
    static constexpr bool PERM = true, HAS_MID = false, HAS_PF = false;
    bf16_t* O; int ldc; float sc; const LAS float* stats;
    __device__ __forceinline__ void operator()(const f32x4 (&acc)[2][2][4][2], const pg8::Unit& u, int wr, int wc, int fr_, int fq_) const {
        int fr = fr_; asm volatile("" : "+v"(fr));
        const int col0 = u.pn * 256 + wc * 32 + 8 * fq_;
#pragma unroll
        for (int ai = 0; ai < 2; ++ai)
#pragma unroll
            for (int m = 0; m < 4; ++m) { const int rl = ai * 128 + wr * 64 + m * 16 + fr; const float rs = row_rstd(stats, rl, 1e-6f) * sc;
                bf16_t* rowp = O + (size_t)(u.pm * 256 + rl) * ldc + col0;
#pragma unroll
                for (int bj = 0; bj < 2; ++bj) { const f32x4 v0 = acc[ai][bj][m][0] * rs, v1 = acc[ai][bj][m][1] * rs;
                    u32x4 w; w.x = pg8::cvt_pk_bf16(v0[0], v0[1]); w.y = pg8::cvt_pk_bf16(v0[2], v0[3]); w.z = pg8::cvt_pk_bf16(v1[0], v1[1]); w.w = pg8::cvt_pk_bf16(v1[2], v1[3]);
                    *(u32x4*)(rowp + bj * 128) = w; } }
    }
};
__device__ __forceinline__ void c0_diffcomb(const Args& a, unsigned char* ws, int panel, int wave, int lane_) {
    int lane = lane_; asm volatile("" : "+v"(lane));
    const bf16_t* od = (const bf16_t*)(ws + WS_OD); bf16_t* y = (bf16_t*)(ws + WS_Y);
    const float lam = __expf(wave_sum_l(a.in[9][lane] * a.in[10][lane], lane)) - __expf(wave_sum_l(a.in[11][lane] * a.in[12][lane], lane)) + 0.2f;
    const int h = lane >> 4, d0 = (lane & 15) * 8;
    float gs[8];
#pragma unroll
    for (int i = 0; i < 8; ++i) gs[i] = a.in[13][d0 + i] * 0.8f;
#pragma unroll 4
    for (int r = 0; r < 32; ++r) {
        const size_t row = (size_t)panel * 256 + wave * 32 + r;
        const u32x4 pa = *(const u32x4*)(od + row * 1024 + (h * 2 + 0) * 128 + d0), pb = *(const u32x4*)(od + row * 1024 + (h * 2 + 1) * 128 + d0);
        const unsigned aw[4] = {pa.x, pa.y, pa.z, pa.w}, bw[4] = {pb.x, pb.y, pb.z, pb.w};
        float v[8]; float ss = 0.f;
#pragma unroll
        for (int q = 0; q < 4; ++q) { v[2 * q] = bflo(aw[q]) - lam * bflo(bw[q]); v[2 * q + 1] = bfhi(aw[q]) - lam * bfhi(bw[q]); }
#pragma unroll
        for (int i = 0; i < 8; ++i) ss += v[i] * v[i];
        ss += shx(ss, 1, lane); ss += shx(ss, 2, lane); ss += shx(ss, 4, lane); ss += shx(ss, 8, lane);
        const float rstd = rsqrtf(ss * (1.f / 128.f) + 1e-5f);
        u32x4 w; w.x = pg8::cvt_pk_bf16(v[0] * rstd * gs[0], v[1] * rstd * gs[1]); w.y = pg8::cvt_pk_bf16(v[2] * rstd * gs[2], v[3] * rstd * gs[3]);
        w.z = pg8::cvt_pk_bf16(v[4] * rstd * gs[4], v[5] * rstd * gs[5]); w.w = pg8::cvt_pk_bf16(v[6] * rstd * gs[6], v[7] * rstd * gs[7]);
        *(u32x4*)(y + row * 1024 + 512 + h * 128 + d0) = w;
    }
}
typedef short bf16x8_t __attribute__((ext_vector_type(8)));
__device__ __forceinline__ void c6_route(const Args& a, unsigned char* ws, LAS unsigned char* lds, const LAS float* stats, int panel, int wave, int lane_, int tid_) {
    int lane = lane_, tid = tid_; asm volatile("" : "+v"(lane), "+v"(tid));
    const bf16_t* x2b = (const bf16_t*)a.out + 1024;
    const bf16_t* wrh = (const bf16_t*)(ws + WS_RT); const bf16_t* wrl = wrh + 48 * 1024;
    LAS float* lg = (LAS float*)(lds + wave * 6144);
    LAS unsigned* hist = (LAS unsigned*)(lds + 49152);
    const int fr = lane & 15, fq = lane >> 4;
    if (tid < 64) hist[tid] = 0u;
    f32x4 acc[2][3];
#pragma unroll
    for (int rb = 0; rb < 2; ++rb)
#pragma unroll
        for (int ob = 0; ob < 3; ++ob) acc[rb][ob] = (f32x4){0.f, 0.f, 0.f, 0.f};
    const size_t rowb = (size_t)panel * 256 + wave * 32;
#pragma unroll 2
    for (int k0 = 0; k0 < 1024; k0 += 32) {
        const int kk = k0 + 8 * fq;
        bf16x8_t xh[2];
#pragma unroll
        for (int rb = 0; rb < 2; ++rb) xh[rb] = *(const bf16x8_t*)(x2b + (rowb + rb * 16 + fr) * 2048 + kk);
#pragma unroll
        for (int ob = 0; ob < 3; ++ob) {
            const bf16x8_t wh = *(const bf16x8_t*)(wrh + (size_t)(ob * 16 + fr) * 1024 + kk), wl = *(const bf16x8_t*)(wrl + (size_t)(ob * 16 + fr) * 1024 + kk);
#pragma unroll
            for (int rb = 0; rb < 2; ++rb) {
                acc[rb][ob] = __builtin_amdgcn_mfma_f32_16x16x32_bf16(wh, xh[rb], acc[rb][ob], 0, 0, 0);
                acc[rb][ob] = __builtin_amdgcn_mfma_f32_16x16x32_bf16(wl, xh[rb], acc[rb][ob], 0, 0, 0);
            }
        }
    }
#pragma unroll
    for (int rb = 0; rb < 2; ++rb) { const float rs = row_rstd(stats, wave * 32 + rb * 16 + fr, 1e-6f);
#pragma unroll
        for (int ob = 0; ob < 3; ++ob) *(LAS f32x4*)(lg + (rb * 16 + fr) * 48 + ob * 16 + 4 * fq) = acc[rb][ob] * rs; }
    asm volatile("s_waitcnt lgkmcnt(0)" ::: "memory");
    __syncthreads();
    int ex0 = 0, ex1 = 0; float w0 = 0.f, w1 = 0.f; unsigned rk0 = 0, rk1 = 0;
    if (lane < 32) {
        const LAS float* lr = lg + lane * 48;
        float l4[4], le[32];
#pragma unroll
        for (int i = 0; i < 4; ++i) l4[i] = lr[i] + a.in[21][i];
#pragma unroll
        for (int i = 0; i < 32; ++i) le[i] = lr[4 + i] + a.in[23][i];
        int gs = 0; float gm = l4[0];
#pragma unroll
        for (int i = 1; i < 4; ++i) if (l4[i] > gm) { gm = l4[i]; gs = i; }
        float gsum = 0.f;
#pragma unroll
        for (int i = 0; i < 4; ++i) gsum += __expf(l4[i] - gm);
        const float gw = 1.f / gsum;
        float sl[8];
#pragma unroll
        for (int e = 0; e < 8; ++e) { sl[e] = le[e];
#pragma unroll
            for (int gq = 1; gq < 4; ++gq) if (gs == gq) sl[e] = le[gq * 8 + e]; }
        int i0 = 0; float v0 = sl[0];
#pragma unroll
        for (int e = 1; e < 8; ++e) if (sl[e] > v0) { v0 = sl[e]; i0 = e; }
        int i1 = -1; float v1 = -INFINITY;
#pragma unroll
        for (int e = 0; e < 8; ++e) if (e != i0 && sl[e] > v1) { v1 = sl[e]; i1 = e; }
        const float e1 = __expf(v1 - v0); w0 = gw / (1.f + e1); w1 = gw * e1 / (1.f + e1);
        ex0 = gs * 8 + i0; ex1 = gs * 8 + i1;
        rk0 = __hip_atomic_fetch_add(hist + ex0, 1u, __ATOMIC_RELAXED, __HIP_MEMORY_SCOPE_WORKGROUP); rk1 = __hip_atomic_fetch_add(hist + ex1, 1u, __ATOMIC_RELAXED, __HIP_MEMORY_SCOPE_WORKGROUP);
    }
    asm volatile("s_waitcnt lgkmcnt(0)" ::: "memory");
    __syncthreads();
    if (tid < 32) { const unsigned c = hist[tid]; hist[32 + tid] = c ? atomicAdd((unsigned*)(ws + WS_CTL) + tid, c) : 0u; }
    asm volatile("s_waitcnt vmcnt(0) lgkmcnt(0)" ::: "memory");
    __syncthreads();
    if (lane < 32) {
        int* ltok = (int*)(ws + WS_LTOK); float* lwp = (float*)(ws + WS_LW); float* lrs = (float*)(ws + WS_LRS);
        const int row = (int)rowb + lane; const float rs2 = row_rstd(stats, wave * 32 + lane, 1e-6f);
        const size_t p0 = (size_t)ex0 * T_ + hist[32 + ex0] + rk0, p1 = (size_t)ex1 * T_ + hist[32 + ex1] + rk1;
        ltok[p0] = row * 2 + 0; lwp[p0] = w0; lrs[p0] = rs2; ltok[p1] = row * 2 + 1; lwp[p1] = w1; lrs[p1] = rs2;
    }
    __syncthreads();
}
__device__ __forceinline__ void p3_chain(const Args& a, LAS unsigned char* lds, unsigned char* lds_raw, int panel, int wave, int lane, int tid) {
    unsigned char* ws = a.ws; asm volatile("" : "+s"(ws));
    bf16_t* wt = (bf16_t*)(ws + WS_WT);
    LAS float* stats = (LAS float*)(lds + STAT_OFF);
    bf16_t* R1 = (bf16_t*)(ws + WS_R1); const bf16_t* Yp = (const bf16_t*)(ws + WS_Y);
    bf16_t* QC = (bf16_t*)(ws + WS_QC); bf16_t* OC = (bf16_t*)(ws + WS_OC); const bf16_t* MKV = (const bf16_t*)(ws + WS_MKV);
    bf16_t* XB = (bf16_t*)a.out;
    pg8::PanelOrder S4{panel, 4}, S1{panel, 1};
#ifndef REP_PHASE
#define REP_PHASE -1
#endif
#define RP3(k) for (int rp3_ = 0; rp3_ < ((REP_PHASE) == (k) ? 2 : 1); ++rp3_)
    RP3(40) { c0_diffcomb(a, ws, panel, wave, lane);
    wg_fence(); }
    RP3(41) {
    { pg8::Gemm g{Yp, wt + WT_A, 1024, 512, 512}; EpiGate<false> E{(const bf16_t*)a.out, R1}; pg8::gemm_phase<EpiGate<false>, pg8::PanelOrder, true>(lds, g, S4, E); }
    { pg8::Gemm g{Yp + 512, wt + WT_B, 1024, 512, 512}; EpiGate<true> E{(const bf16_t*)a.out, R1}; pg8::gemm_phase<EpiGate<true>, pg8::PanelOrder, true>(lds, g, S4, E); }
    wg_fence(); }
    RP3(42) {
    { pg8::Gemm g{R1, wt + WT_O, 1024, 1024, 1024}; EpiRes<false> E{(const void*)a.in[0], XB, stats, nullptr}; pg8::gemm_phase<EpiRes<false>, pg8::PanelOrder, true>(lds, g, S4, E); }
    wg_fence(); }
    RP3(43) {
    { pg8::Gemm g{XB, wt + WT_CQ, 2048, 1024, 1024}; EpiQ E{QC, 256, C2, stats}; pg8::gemm_phase<EpiQ, pg8::PanelOrder, true>(lds, g, S1, E); }
    wg_fence(); }
    RP3(44) {
    { const int b = panel >> 4; const size_t r0 = (size_t)panel * 256;
      attn_body::cross_panel(QC + r0 * 256, 256, MKV + (size_t)b * 256 * 512, 512, MKV + (size_t)b * 256 * 512 + 256, 512, OC + r0 * 256, 256, (char*)lds_raw); }
    wg_fence(); }
    RP3(45) {
    { pg8::Gemm g{OC, wt + WT_CO, 256, 256, 256}; EpiRes<true> E{(const void*)XB, XB + 1024, stats, (unsigned char*)R1};   pg8::gemm_phase<EpiRes<true>, pg8::PanelOrder, true>(lds, g, S4, E); }
    wg_fence(); }
    c6_route(a, ws, lds, stats, panel, wave, lane, tid);
}
constexpr int TAB_OFF = MISC_OFF;
template <bool GATHER_> struct GroupOrder {
    static constexpr bool GATHER = GATHER_;
    const LAS unsigned* tab; int NTl, G, c; const int* ltok; const unsigned* counts;
    __device__ bool next(int i, pg8::Unit& u) const {
        const int L = i * G + c; if (L >= NTl * 4) return false;
        const int ct = L & 3, t = L >> 2;     const unsigned w = (unsigned)__builtin_amdgcn_readfirstlane((int)tab[t]);
        u.e = (int)(w & 31u); u.rt = (int)((w >> 5) & 0x7ffu); u.pm = (int)(w >> 16); u.pn = u.e * 4 + ct; return true;
    }
    __device__ __forceinline__ unsigned arow(const pg8::Unit& u, int r) const {
        const unsigned idx = (unsigned)(u.rt * 256 + r); const unsigned cnt = counts[u.e];
        return idx < cnt ? (unsigned)(ltok[(size_t)u.e * T_ + idx] >> 1) : 0u;
    }
};
__device__ __forceinline__ int build_tile_table(const unsigned* counts, LAS unsigned* tab, int tid) {
    if (tid == 0) {
        unsigned nt = 0;
        for (int e = 0; e < 32; ++e) { const unsigned ntl = (counts[e] + 255u) >> 8;
            for (unsigned rt = 0; rt < ntl; ++rt) { tab[nt] = (unsigned)e | (rt << 5) | (nt << 16); ++nt; } }
        tab[600] = nt;
    }
    asm volatile("s_waitcnt vmcnt(0) lgkmcnt(0)" ::: "memory");
    __syncthreads();
    return __builtin_amdgcn_readfirstlane((int)tab[600]);
}
struct EpiE1 {
    static constexpr bool PERM = true, HAS_MID = false, HAS_PF = false;
    unsigned char* H; const float* lrs; const unsigned* counts;
    __device__ __forceinline__ void operator()(const f32x4 (&acc)[2][2][4][2], const pg8::Unit& u, int wr, int wc, int fr_, int fq_) const {
        int fr = fr_; asm volatile("" : "+v"(fr));
        const int row0 = u.pm * 256 + wr * 64 + fr; const int col0 = (u.pn & 3) * 128 + wc * 32 + 8 * fq_;
        const unsigned cnt = counts[u.e]; float rs[8];
#pragma unroll
        for (int g = 0; g < 8; ++g) { const unsigned idx = (unsigned)(u.rt * 256 + (g >> 2) * 128 + wr * 64 + (g & 3) * 16 + fr); rs[g] = idx < cnt ? lrs[(size_t)u.e * T_ + idx] * (1.f / WSCALE) : 0.f; }
#pragma unroll
        for (int ai = 0; ai < 2; ++ai)
#pragma unroll
            for (int m = 0; m < 4; ++m) { const float s = rs[ai * 4 + m];
                const f32x4 g0 = acc[ai][0][m][0] * s, g1 = acc[ai][0][m][1] * s, u0 = acc[ai][1][m][0] * s, u1 = acc[ai][1][m][1] * s;
                float r[8];
#pragma unroll
                for (int q = 0; q < 4; ++q) { r[q] = g0[q] * __builtin_amdgcn_rcpf(1.f + __expf(-g0[q])) * u0[q]; r[4 + q] = g1[q] * __builtin_amdgcn_rcpf(1.f + __expf(-g1[q])) * u1[q]; }
                unsigned q0 = 0u, q1 = 0u;
                q0 = __builtin_amdgcn_cvt_pk_fp8_f32(CL8(r[0]), CL8(r[1]), q0, false); q0 = __builtin_amdgcn_cvt_pk_fp8_f32(CL8(r[2]), CL8(r[3]), q0, true);
                q1 = __builtin_amdgcn_cvt_pk_fp8_f32(CL8(r[4]), CL8(r[5]), q1, false); q1 = __builtin_amdgcn_cvt_pk_fp8_f32(CL8(r[6]), CL8(r[7]), q1, true);
                *(uint2*)(H + (size_t)(row0 + ai * 128 + m * 16) * 512 + col0) = make_uint2(q0, q1); }
    }
};
struct EpiE2 {
    static constexpr bool PERM = true, HAS_MID = false, HAS_PF = false;
    bf16_t* ys; const int* ltok; const float* lw; const unsigned* counts;
    __device__ __forceinline__ void operator()(const f32x4 (&acc)[2][2][4][2], const pg8::Unit& u, int wr, int wc, int fr_, int fq_) const {
        int fr = fr_; asm volatile("" : "+v"(fr));
        const unsigned cnt = counts[u.e]; const int col0 = (u.pn & 3) * 256 + wc * 32 + 8 * fq_;
        int tk[8]; float wg[8];
#pragma unroll
        for (int g = 0; g < 8; ++g) { const unsigned idx = (unsigned)(u.rt * 256 + (g >> 2) * 128 + wr * 64 + (g & 3) * 16 + fr); const size_t li = (size_t)u.e * T_ + idx;
            tk[g] = idx < cnt ? ltok[li] : -1; wg[g] = idx < cnt ? lw[li] * (1.f / WSCALE) : 0.f; }
#pragma unroll
        for (int ai = 0; ai < 2; ++ai)
#pragma unroll
            for (int m = 0; m < 4; ++m) {
                const int tok2 = tk[ai * 4 + m]; const float wgt = wg[ai * 4 + m];
                if (tok2 >= 0) {
                    bf16_t* rowp = ys + (size_t)tok2 * 1024 + col0;
#pragma unroll
                    for (int bj = 0; bj < 2; ++bj) { const f32x4 v0 = acc[ai][bj][m][0] * wgt, v1 = acc[ai][bj][m][1] * wgt;
                        u32x4 w; w.x = pg8::cvt_pk_bf16(v0[0], v0[1]); w.y = pg8::cvt_pk_bf16(v0[2], v0[3]); w.z = pg8::cvt_pk_bf16(v1[0], v1[1]); w.w = pg8::cvt_pk_bf16(v1[2], v1[3]);
                        *(u32x4*)(rowp + bj * 128) = w; }
                }
            }
    }
};
__device__ __forceinline__ void p6_final(const Args& a, unsigned char* ws, int gw, int NGW, int lane_) {
    int lane = lane_; asm volatile("" : "+v"(lane));
    float* xo = a.out; const bf16_t* x2b = (const bf16_t*)a.out + 1024; const bf16_t* ys = (const bf16_t*)(ws + WS_YS); const float* g = a.in[27];
    f32x4 gg[4];
#pragma unroll
    for (int j = 0; j < 4; ++j) gg[j] = *(const f32x4*)(g + (lane + 64 * j) * 4);
    for (int row = gw; row < T_; row += NGW) {
        f32x4* xr = (f32x4*)(xo + (size_t)row * D_);
        f32x4 v[4]; float ss = 0.f;
#pragma unroll
        for (int j = 0; j < 4; ++j) {
            const int c = (lane + 64 * j) * 4;
            const uint2 x = *(const uint2*)(x2b + (size_t)row * 2048 + c);
            const uint2 p = *(const uint2*)(ys + (size_t)(row * 2) * D_ + c), q = *(const uint2*)(ys + (size_t)(row * 2 + 1) * D_ + c);
            v[j][0] = bflo(x.x) + bflo(p.x) + bflo(q.x); v[j][1] = bfhi(x.x) + bfhi(p.x) + bfhi(q.x);
            v[j][2] = bflo(x.y) + bflo(p.y) + bflo(q.y); v[j][3] = bfhi(x.y) + bfhi(p.y) + bfhi(q.y);
            ss += v[j][0] * v[j][0] + v[j][1] * v[j][1] + v[j][2] * v[j][2] + v[j][3] * v[j][3];
        }
        ss = wave_sum_l(ss, lane);
        const float rstd = rsqrtf(ss * (1.f / D_) + 1e-6f);
#pragma unroll
        for (int j = 0; j < 4; ++j) xr[lane + 64 * j] = v[j] * rstd * gg[j];
    }
}
#define XB_TMO      128
#define XB_XCNT(j)  (256  + 64 * (j))
#define XB_XSUB(j)  (1280 + 64 * (j))
#define XB_XGEN(j)  (2304 + 64 * (j))
#define XB_TOP      3328
#define XB_TOPGEN   3392
#define XCD_BAR_WORDS 3456
#define XB_SPIN_CAP (1u << 18)

__device__ __forceinline__ unsigned xb_ld(unsigned* p)              { return __hip_atomic_load(p, __ATOMIC_RELAXED, __HIP_MEMORY_SCOPE_AGENT); }
__device__ __forceinline__ unsigned xb_add(unsigned* p, unsigned v) { return __hip_atomic_fetch_add(p, v, __ATOMIC_RELAXED, __HIP_MEMORY_SCOPE_AGENT); }
__device__ __forceinline__ unsigned xb_xcc_id() { return (unsigned)__builtin_amdgcn_s_getreg((3 << 11) | 20) & 0xFu; }
#define XB_SPIN(cond, bar) do { unsigned _sp = 0; while (cond) { __builtin_amdgcn_s_sleep(1); \
    if ((++_sp & 255u) == 0u) { if (xb_ld(&(bar)[XB_TMO])) break; if (_sp > XB_SPIN_CAP) { atomicAdd(&(bar)[XB_TMO], 1u); break; } } } } while (0)

struct XcdBarrier {
    unsigned* bar; unsigned x;
    volatile LAS unsigned* st;
};

__device__ __forceinline__ XcdBarrier xcd_barrier_post(unsigned* bar, volatile LAS unsigned* st) {
    XcdBarrier b; b.bar = bar; b.x = xb_xcc_id(); b.st = st;
    if (threadIdx.x == 0) (void)xb_add(&bar[XB_XCNT(b.x)], 1u);
    return b;
}
__device__ __forceinline__ void xcd_barrier_complete(unsigned* bar, unsigned x, unsigned& nloc, unsigned& nx) {
    const unsigned G = gridDim.x * gridDim.y * gridDim.z;
    unsigned sum, cnt, mine, sp = 0u;
    for (;;) {
        sum = 0u; cnt = 0u; mine = 0u;
#pragma unroll
        for (unsigned j = 0; j < 16; ++j) { const unsigned c = xb_ld(&bar[XB_XCNT(j)]); sum += c; cnt += (c > 0u) ? 1u : 0u; mine = (j == x) ? c : mine; }
        if (sum == G) break;
        __builtin_amdgcn_s_sleep(1);
        if ((++sp & 255u) == 0u) { if (xb_ld(&bar[XB_TMO])) break; if (sp > XB_SPIN_CAP) { atomicAdd(&bar[XB_TMO], 1u); break; } }
    }
    nloc = mine > 0u ? mine : 1u; nx = cnt > 0u ? cnt : 1u;
}

__device__ __forceinline__ void xcd_barrier(const XcdBarrier& b) {
    asm volatile("s_waitcnt vmcnt(0)" ::: "memory");
    __syncthreads();
    if (threadIdx.x == 0) {
        unsigned* bar = b.bar;
        __builtin_amdgcn_s_waitcnt(0);
        unsigned nloc = b.st[0], nx = b.st[1];
        if (nloc == 0u) { xcd_barrier_complete(bar, b.x, nloc, nx); b.st[0] = nloc; b.st[1] = nx; }
        const unsigned old = xb_add(&bar[XB_XSUB(b.x)], 1u);
        const unsigned gen = old / nloc;
        if (old + 1u == (gen + 1u) * nloc) {
            __builtin_amdgcn_fence(__ATOMIC_RELEASE, "agent");
            asm volatile("s_waitcnt vmcnt(0)" ::: "memory");
            const unsigned og = xb_add(&bar[XB_TOP], 1u);
            const unsigned tg = og / nx;
            if (og + 1u == (tg + 1u) * nx) xb_add(&bar[XB_TOPGEN], 1u);
            else XB_SPIN(xb_ld(&bar[XB_TOPGEN]) == tg, bar);
            __builtin_amdgcn_fence(__ATOMIC_ACQUIRE, "agent");
            xb_add(&bar[XB_XGEN(b.x)], 1u);
            asm volatile("s_waitcnt vmcnt(0)" ::: "memory");
        } else {
            XB_SPIN(xb_ld(&bar[XB_XGEN(b.x)]) == gen, bar);
            __builtin_amdgcn_fence(__ATOMIC_ACQUIRE, "agent");
            asm volatile("s_waitcnt vmcnt(0)" ::: "memory");
        }
    }
    __syncthreads();
}
__global__ void __launch_bounds__(NWAVES * 64, 2) mk_fwd(Args args_unused) {
    __builtin_assume(__builtin_amdgcn_workitem_id_y() == 0); __builtin_assume(__builtin_amdgcn_workitem_id_z() == 0);
    const Args& args = *(const Args*)(const __attribute__((address_space(4))) void*)__builtin_amdgcn_kernarg_segment_ptr();
    extern __shared__ __attribute__((aligned(16))) unsigned char lds_raw[];
    LAS unsigned char* lds = (LAS unsigned char*)lds_raw;
    const int tid = threadIdx.x, lane = tid & 63, wave = __builtin_amdgcn_readfirstlane(tid >> 6);
    const int G = gridDim.x; const int bx = blockIdx.x; const int vcu = (G % 8 == 0) ? (bx % 8) * (G / 8) + bx / 8 : bx;
    unsigned char* ws = args.ws;
    const int lo = args.ph_lo, hi = args.ph_hi;
    volatile LAS unsigned* xst = (volatile LAS unsigned*)(lds + MISC_OFF + 3072);
    if (tid < 2) xst[tid] = 0u;
    __syncthreads();
    XcdBarrier xbar = xcd_barrier_post((unsigned*)(ws + WS_CTL + 4096), xst);
#ifndef REP_PHASE
#define REP_PHASE -1
#endif
#define IN(k) (lo <= (k) && (k) < hi)
#define REPS(k) for (int rp_ = 0; rp_ < ((REP_PHASE) == (k) ? 2 : 1); ++rp_)
#define GRID_SYNC(k) do { if (args.coop && IN(k) && IN((k) + 1)) { if ((k) == 0) cg::this_grid().sync(); else { xcd_barrier(xbar); if ((REP_PHASE) == 50) xcd_barrier(xbar); } } } while (0)
    bf16_t* wt = (bf16_t*)(ws + WS_WT);
#ifndef SKIP_P0
    if (IN(0)) REPS(0) { p0_prologue(args, lds, vcu, G, wave, lane, tid); __syncthreads(); }
#endif
    GRID_SYNC(0);
#ifndef SKIP_P1
    if (IN(1)) REPS(1) {
        if (rp_ == 0) for (int bh = bx; bh < B_ * 8; bh += G) { p1_cumsum((float*)(ws + WS_LOGF), (bf16_t*)(ws + WS_KAUG), bh, (LAS float*)lds, tid); }
        __syncthreads();
        {
            pg8::Gemm g{(const bf16_t*)(ws + WS_R1), wt + WT_IN, 1024, 1024, 1024}; pg8::StaticOrder S; S.init(T_, 5120, G, bx);
            EpiIn E{(bf16_t*)(ws + WS_FQ), (bf16_t*)(ws + WS_FK), (bf16_t*)(ws + WS_FV), (bf16_t*)(ws + WS_DQ), (bf16_t*)(ws + WS_DK), (bf16_t*)(ws + WS_DV), (bf16_t*)args.out, (const float*)(ws + WS_ROPE)};
            pg8::gemm_phase<EpiIn, pg8::StaticOrder, true>(lds, g, S, E);
        }
        {
            pg8::Gemm g{(const bf16_t*)(ws + WS_MEMN), wt + WT_CKV, 1024, 1024, 1024}; pg8::StaticOrder S; S.init(B_ * MEML, 512, G, bx);
            EpiBf E{(bf16_t*)(ws + WS_MKV), 512, 1.f};
            pg8::gemm_phase<EpiBf, pg8::StaticOrder, true>(lds, g, S, E);
        }
    }
#endif
    GRID_SYNC(1);
    if (IN(2)) REPS(2) {
        char* shm = (char*)lds_raw;
        const bf16_t *FQ = (const bf16_t*)(ws + WS_FQ), *FK = (const bf16_t*)(ws + WS_FK), *FV = (const bf16_t*)(ws + WS_FV), *DQ = (const bf16_t*)(ws + WS_DQ), *DK = (const bf16_t*)(ws + WS_DK), *DVp = (const bf16_t*)(ws + WS_DV);
        bf16_t *Yp = (bf16_t*)(ws + WS_Y), *ODp = (bf16_t*)(ws + WS_OD); const bf16_t* KA = (const bf16_t*)(ws + WS_KAUG);
        for (int it = vcu; it < 256; it += G) {
            attn_body::bf16x8 qrs[4]; bool primed = false;
#pragma nounroll
            for (int j = 0; j < 8; ++j) {
                const int item = it * 4 + (j >> 1); const int seq = item >> 3, s = item & 7;
                const int qb = (j & 1) ? 15 - s : s; const int NT = 4 * (qb + 1);
                const int b = seq >> 3, h = seq & 7; const size_t r0 = (size_t)b * S_;
                const int jn = j + 1; const int itemn = it * 4 + (jn >> 1); const int seqn = itemn >> 3, sn = itemn & 7;
                const int qbn = (jn & 1) ? 15 - sn : sn; const int bn = seqn >> 3, hn = seqn & 7; const size_t r0n = (size_t)bn * S_; const bool hasn = jn < 8;
                attn_body::attn_unit<true, true, 40>(FQ + (r0 + qb * 256) * 512 + h * 64, 512, FK + r0 * 512 + h * 64, 512, FV + r0 * 512 + h * 64, 512,
                                                     Yp + (r0 + qb * 256) * 1024 + h * 64, 1024, KA + ((size_t)seq * S_) * 4, NT, shm,
                                                     qrs, primed, j & 1, hasn ? FQ + (r0n + qbn * 256) * 512 + hn * 64 : nullptr, FK + r0n * 512 + hn * 64, KA + ((size_t)seqn * S_) * 4, 4 * (qbn + 1));
                primed = hasn;
            }
            primed = false;
#pragma nounroll
            for (int j = 0; j < 8; ++j) {
                const int item = it * 4 + (j >> 1); const int seq = item >> 3, s = item & 7;
                const int qb = (j & 1) ? 15 - s : s; const int NT = 4 * (qb + 1);
                const int b = seq >> 3, hh = seq & 7; const size_t r0 = (size_t)b * S_;
                const int jn = j + 1; const int itemn = it * 4 + (jn >> 1); const int seqn = itemn >> 3, sn = itemn & 7;
                const int qbn = (jn & 1) ? 15 - sn : sn; const int bn = seqn >> 3, hhn = seqn & 7; const size_t r0n = (size_t)bn * S_; const bool hasn = jn < 8;
                attn_body::attn_unit128<8>(DQ + (r0 + qb * 256) * 512 + hh * 64, 512, DK + r0 * 512 + hh * 64, 512, DVp + r0 * 512 + (hh >> 1) * 128, 512,
                                           ODp + (r0 + qb * 256) * 1024 + hh * 128, 1024, nullptr, NT, shm,
                                           qrs, primed, 0, hasn ? DQ + (r0n + qbn * 256) * 512 + hhn * 64 : nullptr, DK + r0n * 512 + hhn * 64, nullptr, 0);
                primed = hasn;
            }
        }
    }
    GRID_SYNC(2);
    if (IN(3)) {
#ifdef P3_STAGGER
        if (bx & 1) { for (int i_ = 0; i_ < P3_STAGGER; ++i_) __builtin_amdgcn_s_sleep(127); }
#endif
        for (int panel = vcu; panel < 256; panel += G) p3_chain(args, lds, lds_raw, panel, wave, lane, tid); }
    GRID_SYNC(3);
    if (IN(4)) REPS(4) {
        unsigned char* wsq = args.ws; asm volatile("" : "+s"(wsq));
        const unsigned* counts = (const unsigned*)(wsq + WS_CTL); LAS unsigned* tab = (LAS unsigned*)(lds + TAB_OFF);
        const int NTl = build_tile_table(counts, tab, tid);
        pg8::Gemm g{(const bf16_t*)(wsq + WS_R1), (const bf16_t*)(wsq + WS_WT) + WT_E1, 1024, 512, 512};
        GroupOrder<true> S{tab, NTl, G, vcu, (const int*)(wsq + WS_LTOK), counts};
        EpiE1 E{(unsigned char*)(wsq + WS_H), (const float*)(wsq + WS_LRS), counts};
        pg8::gemm_phase<EpiE1, GroupOrder<true>, true, true>(lds, g, S, E);
    }
    GRID_SYNC(4);
    if (IN(5)) REPS(5) {
        unsigned char* wsq = args.ws; asm volatile("" : "+s"(wsq));
        const unsigned* counts = (const unsigned*)(wsq + WS_CTL); LAS unsigned* tab = (LAS unsigned*)(lds + TAB_OFF);
        const int NTl = build_tile_table(counts, tab, tid);
        pg8::Gemm g{(const bf16_t*)(wsq + WS_H), (const bf16_t*)(wsq + WS_WT) + WT_E2, 256, 256, 256};
        GroupOrder<false> S{tab, NTl, G, vcu, (const int*)(wsq + WS_LTOK), counts};
        EpiE2 E{(bf16_t*)(wsq + WS_YS), (const int*)(wsq + WS_LTOK), (const float*)(wsq + WS_LW), counts};
        pg8::gemm_phase<EpiE2, GroupOrder<false>, true, true>(lds, g, S, E);
    }
    GRID_SYNC(5);
    if (IN(6)) { unsigned char* wsq = args.ws; asm volatile("" : "+s"(wsq)); p6_final(args, wsq, vcu * NWAVES + wave, G * NWAVES, lane); }
#undef IN
#undef GRID_SYNC
}
extern "C" void kernel_launch(void* const* d_in, const int* in_sizes, int n_in, void* d_out, int out_size, void* d_ws, size_t ws_size, hipStream_t stream) {
    static int grid = 0;
    if (grid == 0) {
        int dev = 0, cus = 0, per_cu = 0; (void)hipGetDevice(&dev); (void)hipDeviceGetAttribute(&cus, hipDeviceAttributeMultiprocessorCount, dev);
        (void)hipFuncSetAttribute((const void*)mk_fwd, hipFuncAttributeMaxDynamicSharedMemorySize, LDS_BYTES);
        if (hipOccupancyMaxActiveBlocksPerMultiprocessor(&per_cu, (const void*)mk_fwd, NWAVES * 64, LDS_BYTES) != hipSuccess || per_cu < 1) per_cu = 1;
        (void)hipGetLastError();
        if (cus <= 0) cus = 256;
        grid = cus * (per_cu > 1 ? 1 : per_cu);
        if (grid > 256) grid = 256;
    }
    unsigned char* ws = (unsigned char*)d_ws;
    (void)hipMemsetAsync(ws + WS_CTL, 0, 32768, stream);
    Args a{}; for (int i = 0; i < 28; ++i) a.in[i] = (const float*)d_in[i]; a.out = (float*)d_out; a.ws = ws; a.coop = 1; a.ph_lo = 0; a.ph_hi = 7; a.pad = 0;
    void* kargs[] = {&a};
    hipError_t e = hipLaunchCooperativeKernel((const void*)mk_fwd, dim3(grid), dim3(NWAVES * 64), kargs, LDS_BYTES, stream);
    if (e != hipSuccess) fprintf(stderr, "cooperative launch failed: %s (grid %d)\n", hipGetErrorString(e), grid);
}
```

```cpp
#include <hip/hip_runtime.h>
#ifndef REP_PHASE
#define REP_PHASE -1
#endif
#include <stdint.h>
#include <math.h>
#include <stdio.h>

typedef unsigned short bf16_t;
constexpr int T_ = 65536, D_ = 1024, S_ = 4096, B_ = 16, INW = 5128, MEML = 256;
constexpr float LOG2E = 1.4426950408889634f;
constexpr float C2 = 0.125f * LOG2E;
constexpr size_t MiB = 1u << 20;
constexpr size_t WS_CTL = 0;
constexpr size_t WS_LOGF = 2 * MiB;
constexpr size_t WS_KAUG = 4 * MiB;
constexpr size_t WS_ROPE = 8 * MiB;
constexpr size_t WS_MKV = 24 * MiB;
constexpr size_t WS_MEMN = 28 * MiB;
constexpr size_t WS_QC = 36 * MiB;
constexpr size_t WS_OC = 68 * MiB;
constexpr size_t WS_LTOK = 100 * MiB;
constexpr size_t WS_LW = 108 * MiB;
constexpr size_t WS_WT = 128 * MiB;
constexpr size_t WS_R1 = 240 * MiB;
constexpr size_t WS_FQ = 368 * MiB, WS_FK = 432 * MiB, WS_FV = 496 * MiB, WS_DQ = 560 * MiB, WS_DK = 624 * MiB, WS_DV = 688 * MiB;
constexpr size_t WS_Y = 752 * MiB;
constexpr size_t WS_OD = 880 * MiB;
constexpr size_t WS_YS = 368 * MiB;
constexpr size_t WS_H = 752 * MiB;
constexpr size_t WS_RAW = 752 * MiB;

__device__ __forceinline__ float bf2f(bf16_t h) { return __uint_as_float(((unsigned)h) << 16); }
__device__ __forceinline__ bf16_t f2bf(float f) { unsigned u = __float_as_uint(f); u += 0x7fffu + ((u >> 16) & 1u); return (bf16_t)(u >> 16); }
__device__ __forceinline__ float wave_sum(float v) {
#pragma unroll
    for (int o = 1; o < 64; o <<= 1) v += __shfl_xor(v, o);
    return v;
}
__device__ __forceinline__ float sigmoidf_(float x) { return 1.f / (1.f + __expf(-x)); }


#define GAS_ __attribute__((address_space(1)))
#define OPAQUE_GLOBAL(dst, src) GAS_ unsigned char* dst##_g = (GAS_ unsigned char*)(src); asm volatile("" : "+s"(dst##_g)); unsigned char* dst = (unsigned char*)dst##_g

#define dpp_add_(v, ctrl, row_mask) ((v) + __int_as_float(__builtin_amdgcn_update_dpp(0, __float_as_int(v), (ctrl), (row_mask), 0xf, false)))
__device__ __forceinline__ float wave_sum_dpp(float v) {
    v = dpp_add_(v, 0xB1, 0xf); v = dpp_add_(v, 0x4E, 0xf); v = dpp_add_(v, 0x141, 0xf); v = dpp_add_(v, 0x140, 0xf);
    v = dpp_add_(v, 0x142, 0xa); v = dpp_add_(v, 0x143, 0xc);
    return __int_as_float(__builtin_amdgcn_readlane(__float_as_int(v), 63));
}
namespace pg8 {
#define PG8_LAS __attribute__((address_space(3)))
typedef short bf16x8 __attribute__((ext_vector_type(8)));
typedef float f32x4 __attribute__((ext_vector_type(4)));
typedef unsigned u32x4 __attribute__((ext_vector_type(4)));
typedef int v4i __attribute__((ext_vector_type(4)));
typedef int v8i __attribute__((ext_vector_type(8)));
constexpr int BM = 256, BK = 64, HALF = 128, HTB = HALF * BK * 2  , STAGE_BYTES = 8 * HTB, NXCD = 8, WGM = 8;

__host__ __device__ __forceinline__ int lds_byte(int r, int c) { const int st = (r >> 4) * 2 + (c >> 5), rr = r & 15, cc = c & 31, ob = rr * 64 + cc * 2; return st * 1024 + (ob ^ (((ob >> 9) & 1) << 5)); }
__host__ __device__ __forceinline__ void stage_rc(int b, int& R, int& C) { const int st = b / 1024, sb = b % 1024, swz = sb ^ (((sb >> 9) & 1) << 5); R = (st >> 1) * 16 + swz / 64; C = (st & 1) * 32 + (swz % 64) / 2; }
__host__ __device__ __forceinline__ int perm32(int rho) { const int n = rho >> 4, i = rho & 15; return 8 * (i >> 2) + 4 * n + (i & 3); }

struct Unit { int pm, pn, e, rt; };
struct Gemm { const bf16_t* A; const bf16_t* Bt; int lda, ldb, K; };

struct StaticOrder {
    static constexpr bool GATHER = false;
    int nM, nN, nwg, G, c;
    __host__ __device__ void init(int M, int N, int G_, int c_) { nM = M / BM; nN = N / BM; nwg = nM * nN; G = G_; c = c_; }
    __host__ __device__ bool next(int i, Unit& u) const {
        const long L = (long)i * G + c; if (L >= nwg) return false;
        int wgid = (int)L; { const int q = nwg / NXCD, r = nwg % NXCD, xcd = wgid % NXCD, off = wgid / NXCD; wgid = (xcd < r ? xcd * (q + 1) : r * (q + 1) + (xcd - r) * q) + off; }
        const int nig = WGM * nN, gid = wgid / nig, fm = gid * WGM, gsz = (nM - fm) < WGM ? (nM - fm) : WGM;
        u.pm = fm + ((wgid % nig) % gsz); u.pn = (wgid % nig) / gsz; u.e = 0; u.rt = 0; return true;
    }
    __device__ __forceinline__ unsigned arow(const Unit&, int) const { return 0u; }
};
struct PanelOrder {
    static constexpr bool GATHER = false;
    int pm, nN;
    __device__ bool next(int i, Unit& u) const { if (i >= nN) return false; u.pm = pm; u.pn = i; u.e = 0; u.rt = 0; return true; }
    __device__ __forceinline__ unsigned arow(const Unit&, int) const { return 0u; }
};

__device__ __forceinline__ unsigned cvt_pk_bf16(float lo, float hi) { unsigned r; asm volatile("v_cvt_pk_bf16_f32 %0, %1, %2" : "=v"(r) : "v"(lo), "v"(hi)); return r; }

template <class Epi, class Sched, bool ALIGN_EPI, bool FP8 = false>
__device__ __forceinline__ void gemm_phase(PG8_LAS unsigned char* lds, const Gemm g, const Sched& S, const Epi& E) {
    int tid_ = threadIdx.x; asm volatile("" : "+v"(tid_));
    const int tid = tid_, wid = __builtin_amdgcn_readfirstlane(tid >> 6), lane = tid & 63, wr = wid >> 2, wc = wid & 3, fr = lane & 15, fq = lane >> 4;
    const int K = g.K, nt = K / BK;
    int Rr[2], Cc[2]; unsigned voffB[2];
#pragma unroll
    for (int i = 0; i < 2; ++i) { int R, C; stage_rc(tid * 16 + i * 8192, R, C); const int Rb = Epi::PERM ? ((R & ~31) + perm32(R & 31)) : R;
        Rr[i] = R; Cc[i] = C; voffB[i] = (unsigned)(Rb * g.ldb + C) * 2u; }
    const size_t kstep = (size_t)(BK * 2);
    const unsigned hstepA = (unsigned)HALF * (unsigned)g.lda * 2u;
    const size_t tstepA = (size_t)2 * hstepA;
    const size_t hstepB = (size_t)HALF * g.ldb * 2, tstepB = 2 * hstepB;
    const unsigned ldsw = (unsigned)wid * 1024u;
    const int aoff = lds_byte(wr * 64 + fr, fq * 8), boff = lds_byte(wc * 32 + fr, fq * 8);
#define PG8_SA(b, h) (((b) * 2 + (h)) * HTB)
#define PG8_SB(b, h) ((4 + (b) * 2 + (h)) * HTB)
#define PG8_GAS __attribute__((address_space(1)))
#define PG8_STAGE(bufoff, gbase, voff) do { _Pragma("unroll") for (int _i = 0; _i < 2; ++_i) \
        __builtin_amdgcn_global_load_lds((const unsigned*)((const char*)(gbase) + (voff)[_i]), (PG8_LAS unsigned*)(lds + (bufoff) + ldsw + _i * 8192), 16, 0, 0); } while (0)
#define PG8_LDA(dst, b, h) do { _Pragma("unroll") for (int m = 0; m < 4; ++m) { dst[m].lo = *(const PG8_LAS v4i*)(lds + PG8_SA(b, h) + aoff + m * 2048); dst[m].hi = *(const PG8_LAS v4i*)(lds + PG8_SA(b, h) + aoff + m * 2048 + 1024); } } while (0)
#define PG8_LDB(dst, b, h) do { _Pragma("unroll") for (int n = 0; n < 2; ++n) { dst[n].lo = *(const PG8_LAS v4i*)(lds + PG8_SB(b, h) + boff + n * 2048); dst[n].hi = *(const PG8_LAS v4i*)(lds + PG8_SB(b, h) + boff + n * 2048 + 1024); } } while (0)
#define PG8_MMA(ai, bj, At, Bt) do { __builtin_amdgcn_s_setprio(1); _Pragma("unroll") for (int m = 0; m < 4; ++m) _Pragma("unroll") for (int n = 0; n < 2; ++n) { \
        if constexpr (FP8) asm volatile("v_mfma_f32_16x16x128_f8f6f4 %0, %1, %2, %0" : "+v"(acc[ai][bj][m][n]) : "v"(Bt[n]), "v"(At[m])); \
        else { const v4i bl_ = Bt[n].lo, bh_ = Bt[n].hi, al_ = At[m].lo, ah_ = At[m].hi;     \
               acc[ai][bj][m][n] = __builtin_amdgcn_mfma_f32_16x16x32_bf16(__builtin_bit_cast(bf16x8, bl_), __builtin_bit_cast(bf16x8, al_), acc[ai][bj][m][n], 0, 0, 0); \
               acc[ai][bj][m][n] = __builtin_amdgcn_mfma_f32_16x16x32_bf16(__builtin_bit_cast(bf16x8, bh_), __builtin_bit_cast(bf16x8, ah_), acc[ai][bj][m][n], 0, 0, 0); } } __builtin_amdgcn_s_setprio(0); } while (0)
#define PG8_WAIT_V(n) asm volatile("s_waitcnt vmcnt(" #n ")" ::: "memory")
#define PG8_WAIT_L(n) asm volatile("s_waitcnt lgkmcnt(" #n ")" ::: "memory")
#define PG8_BAR __builtin_amdgcn_s_barrier()
#define PG8_SCHED __builtin_amdgcn_sched_barrier(0)
#define PG8_VOFF(u, v0, v1) do { _Pragma("unroll") for (int _i = 0; _i < 2; ++_i) { \
        if (Sched::GATHER) { v0[_i] = (S.arow(u, Rr[_i]) * (unsigned)g.lda + (unsigned)Cc[_i]) * 2u; v1[_i] = (S.arow(u, Rr[_i] + HALF) * (unsigned)g.lda + (unsigned)Cc[_i]) * 2u; } \
        else { v0[_i] = (unsigned)(Rr[_i] * g.lda + Cc[_i]) * 2u; v1[_i] = v0[_i] + hstepA; } } } while (0)
    Unit cur, nxt; int ui = 0;
    if (!S.next(0, cur)) return;
    unsigned pf_sink = 0u;
    f32x4 acc[2][2][4][2];
#pragma unroll
    for (int a = 0; a < 2; ++a)
#pragma unroll
        for (int b = 0; b < 2; ++b)
#pragma unroll
            for (int m = 0; m < 4; ++m)
#pragma unroll
                for (int n = 0; n < 2; ++n) acc[a][b][m][n] = (f32x4){0.f, 0.f, 0.f, 0.f};
    v8i At[4], B0[2], B1[2];
    unsigned cv0[2], cv1[2], nv0[2], nv1[2];
    PG8_VOFF(cur, cv0, cv1);
    const char* cA = (const char*)g.A + (Sched::GATHER ? (size_t)0 : (size_t)cur.pm * tstepA); const char* cB = (const char*)g.Bt + (size_t)cur.pn * tstepB;
    PG8_STAGE(PG8_SB(0, 0), cB, voffB); PG8_STAGE(PG8_SB(0, 1), cB + hstepB, voffB); PG8_STAGE(PG8_SA(0, 0), cA, cv0); PG8_STAGE(PG8_SA(0, 1), cA, cv1);
    if (wr == 1) PG8_BAR;
    PG8_WAIT_V(2); PG8_BAR;
    PG8_STAGE(PG8_SB(1, 0), cB + kstep, voffB); PG8_STAGE(PG8_SA(1, 0), cA + kstep, cv0); PG8_STAGE(PG8_SB(1, 1), cB + hstepB + kstep, voffB);
    PG8_WAIT_V(6); PG8_BAR;
    for (;;) {
        const bool has_next = S.next(ui + 1, nxt);
        unsigned long long tk0_ = 0ull; if constexpr (Epi::HAS_PROF) { if (E.prof) tk0_ = __builtin_amdgcn_s_memrealtime(); }
        const char* nA = has_next ? ((const char*)g.A + (Sched::GATHER ? (size_t)0 : (size_t)nxt.pm * tstepA)) : cA; const char* nB = has_next ? (const char*)g.Bt + (size_t)nxt.pn * tstepB : cB;
        if (has_next) { PG8_VOFF(nxt, nv0, nv1); } else {
#pragma unroll
            for (int i = 0; i < 2; ++i) { nv0[i] = cv0[i]; nv1[i] = cv1[i]; } }
#pragma nounroll
        for (int t = 0; t < nt; t += 2) {
            const bool last = (t == nt - 2);
            if constexpr (Epi::HAS_PF) { if (t == (nt > 6 ? nt - 6 : 0)) E.prefetch(cur, wr, wc, fr, fq, pf_sink, false); if (Epi::HAS_MID && t == (nt / 2 > 4 ? nt / 2 - 4 : 0)) E.prefetch(cur, wr, wc, fr, fq, pf_sink, true); }
            if constexpr (Epi::HAS_MID) { if (t == nt / 2) E.mid(acc, cur, wr, wc, fr, fq); }
            const char* a1 = cA + (size_t)(t + 1) * kstep;
            const char* a2 = last ? nA : cA + (size_t)(t + 2) * kstep; const char* b2 = last ? nB : cB + (size_t)(t + 2) * kstep;
            const char* a3 = a2 + kstep; const char* b3 = b2 + kstep;
            unsigned f0[2], f1[2];
#pragma unroll
            for (int i = 0; i < 2; ++i) { f0[i] = last ? nv0[i] : cv0[i]; f1[i] = last ? nv1[i] : cv1[i]; }
            PG8_LDB(B0, 0, 0); PG8_LDB(B1, 0, 1); PG8_SCHED; PG8_LDA(At, 0, 0); PG8_STAGE(PG8_SA(1, 1), a1, cv1);
            PG8_WAIT_V(8); PG8_WAIT_L(0); PG8_BAR; PG8_MMA(0, 0, At, B0); PG8_MMA(0, 1, At, B1); PG8_BAR; PG8_SCHED;
            PG8_LDA(At, 0, 1); PG8_STAGE(PG8_SB(0, 0), b2, voffB); PG8_STAGE(PG8_SB(0, 1), b2 + hstepB, voffB); PG8_STAGE(PG8_SA(0, 0), a2, f0);
            PG8_WAIT_V(8); PG8_WAIT_L(0); PG8_BAR; PG8_MMA(1, 0, At, B0); PG8_MMA(1, 1, At, B1); PG8_BAR; PG8_SCHED;
            PG8_LDB(B0, 1, 0); PG8_LDB(B1, 1, 1); PG8_SCHED; PG8_LDA(At, 1, 0); PG8_STAGE(PG8_SA(0, 1), a2, f1);
            PG8_WAIT_V(8); PG8_WAIT_L(0); PG8_BAR; PG8_MMA(0, 0, At, B0); PG8_MMA(0, 1, At, B1); PG8_BAR; PG8_SCHED;
            PG8_LDA(At, 1, 1); PG8_STAGE(PG8_SB(1, 0), b3, voffB); PG8_STAGE(PG8_SB(1, 1), b3 + hstepB, voffB); PG8_STAGE(PG8_SA(1, 0), a3, f0);
            PG8_WAIT_V(8); PG8_WAIT_L(0); PG8_BAR; PG8_MMA(1, 0, At, B0); PG8_MMA(1, 1, At, B1); PG8_BAR; PG8_SCHED;
        }
        if constexpr (ALIGN_EPI) { if (wr == 0) PG8_BAR; }
        if constexpr (Epi::HAS_PROF) { if (E.prof && threadIdx.x == 0) atomicAdd(E.prof + 256, __builtin_amdgcn_s_memrealtime() - tk0_); }
        if constexpr (FP8) asm volatile("s_nop 15\n\ts_nop 15" ::: "memory");
        E(acc, cur, wr, wc, fr, fq);
        if constexpr (Epi::HAS_PF) asm volatile("" :: "v"(pf_sink));
        if (!has_next) break;
#pragma unroll
        for (int a = 0; a < 2; ++a)
#pragma unroll
            for (int b = 0; b < 2; ++b)
#pragma unroll
                for (int m = 0; m < 4; ++m)
#pragma unroll
                    for (int n = 0; n < 2; ++n) acc[a][b][m][n] = (f32x4){0.f, 0.f, 0.f, 0.f};
        cur = nxt; cA = nA; cB = nB; ++ui;
#pragma unroll
        for (int i = 0; i < 2; ++i) { cv0[i] = nv0[i]; cv1[i] = nv1[i]; }
        if constexpr (ALIGN_EPI) { if (wr == 1) PG8_BAR; }
    }
    PG8_WAIT_V(0);
    if constexpr (!ALIGN_EPI) { if (wr == 0) PG8_BAR; }
    PG8_BAR;
#undef PG8_SA
#undef PG8_SB
#undef PG8_STAGE
#undef PG8_LDA
#undef PG8_LDB
#undef PG8_MMA
#undef PG8_WAIT_V
#undef PG8_WAIT_L
#undef PG8_BAR
#undef PG8_SCHED
#undef PG8_VOFF
}
}
namespace attn_body {
typedef unsigned short bf16;
using bf16x8=__attribute__((ext_vector_type(8)))short;
using s16x4=__attribute__((ext_vector_type(4)))short;
using f32x16=__attribute__((ext_vector_type(16)))float;
using u32x4=__attribute__((ext_vector_type(4)))unsigned;
constexpr int D=64;
constexpr int NW=8,QBLK=32,QB=QBLK*NW,KVBLK=64;
__device__ __forceinline__ int crow(int r,int hi){return (r&3)+8*(r>>2)+4*hi;}
#define SBAR() __builtin_amdgcn_sched_barrier(0)
__device__ __forceinline__ void cmask(f32x16&p0,f32x16&p1,int jb,int qrel,int hi){
  const float NEG=-INFINITY; int kb=64*jb+4*hi;
  #pragma unroll
  for(int r=0;r<16;++r){int kv=kb+(r&3)+8*(r>>2); if(kv>qrel)p0[r]=NEG; if(kv+32>qrel)p1[r]=NEG;}
}

constexpr int NSLOT=3, SLOTB=8192;
constexpr int LDS_K=0, LDS_V=NSLOT*SLOTB, LDS_WS=2*NSLOT*SLOTB, LDS_OST=LDS_WS+NW*64*4, LDS_AUG=LDS_OST+NW*4096, LDS_BYTES=LDS_AUG+65536;
constexpr float C2=0.125f*1.4426950408889634f;
__device__ __forceinline__ void glds16(const void*gsrc,unsigned lds_dst){unsigned keep;
  asm volatile("s_mov_b32 %0, m0\n\ts_mov_b32 m0, %2\n\ts_nop 0\n\tglobal_load_lds_dwordx4 %1, off\n\ts_mov_b32 m0, %0":"=&s"(keep):"v"(gsrc),"s"(lds_dst):"memory");}
__device__ __forceinline__ float max3f(float a,float b,float c){float r;asm("v_max3_f32 %0, %1, %2, %3":"=v"(r):"v"(a),"v"(b),"v"(c));return r;}
__device__ __forceinline__ float max2f(float a,float b){float r;asm("v_max_f32_e32 %0, %1, %2":"=v"(r):"v"(a),"v"(b));return r;}
__device__ __forceinline__ float fadd_s(float a,float b){float r;asm("v_add_f32_e32 %0, %1, %2":"=v"(r):"v"(a),"v"(b));return r;}
__device__ __forceinline__ float fsub_s(float a,float b){float r;asm("v_sub_f32_e32 %0, %1, %2":"=v"(r):"v"(a),"v"(b));return r;}
typedef float f32x2_t __attribute__((ext_vector_type(2))); typedef __bf16 bf16x2_t __attribute__((ext_vector_type(2)));
__device__ __forceinline__ unsigned cvtpk_s(float lo,float hi){f32x2_t v={lo,hi};bf16x2_t b=__builtin_convertvector(v,bf16x2_t);return __builtin_bit_cast(unsigned,b);}
#define WAIT_BAR(N) asm volatile("s_waitcnt vmcnt(" #N ") lgkmcnt(0)\n\ts_barrier":::"memory")

template<bool AUG> __device__ __forceinline__ void qkt(f32x16&p0,f32x16&p1,const char*Kslot,const bf16x8*qr,const f32x16&negm,int r32,int hi,bf16x8 ka0,bf16x8 ka1,bf16x8 qaug){
  const char*kb=Kslot+hi*1024+r32*16;
  #pragma unroll
  for(int d0=0;d0<4;++d0){
    const bf16x8 b0=*reinterpret_cast<const bf16x8*>(kb+d0*2048);
    const bf16x8 b1=*reinterpret_cast<const bf16x8*>(kb+d0*2048+512);
    if(d0==0){p0=__builtin_amdgcn_mfma_f32_32x32x16_bf16(b0,qr[0],negm,0,0,0);p1=__builtin_amdgcn_mfma_f32_32x32x16_bf16(b1,qr[0],negm,0,0,0);}
    else{p0=__builtin_amdgcn_mfma_f32_32x32x16_bf16(b0,qr[d0],p0,0,0,0);p1=__builtin_amdgcn_mfma_f32_32x32x16_bf16(b1,qr[d0],p1,0,0,0);}}
  if(AUG){p0=__builtin_amdgcn_mfma_f32_32x32x16_bf16(ka0,qaug,p0,0,0,0);p1=__builtin_amdgcn_mfma_f32_32x32x16_bf16(ka1,qaug,p1,0,0,0);}
}
typedef __attribute__((address_space(3))) const char* lds_cptr;
typedef short v4i16_t __attribute__((ext_vector_type(4)));
__device__ __forceinline__ void kload8(bf16x8*kf,lds_cptr kp){
  kf[0]=*(const __attribute__((address_space(3))) bf16x8*)(kp);      kf[1]=*(const __attribute__((address_space(3))) bf16x8*)(kp+512);
  kf[2]=*(const __attribute__((address_space(3))) bf16x8*)(kp+2048); kf[3]=*(const __attribute__((address_space(3))) bf16x8*)(kp+2560);
  kf[4]=*(const __attribute__((address_space(3))) bf16x8*)(kp+4096); kf[5]=*(const __attribute__((address_space(3))) bf16x8*)(kp+4608);
  kf[6]=*(const __attribute__((address_space(3))) bf16x8*)(kp+6144); kf[7]=*(const __attribute__((address_space(3))) bf16x8*)(kp+6656);
}
__device__ __forceinline__ void kload2(bf16x8*kf,lds_cptr kp,int j){ kf[2*j]=*(const __attribute__((address_space(3))) bf16x8*)(kp+j*2048); kf[2*j+1]=*(const __attribute__((address_space(3))) bf16x8*)(kp+j*2048+512); }
__device__ __forceinline__ s16x4 vtr(lds_cptr p){ return __builtin_bit_cast(s16x4,__builtin_amdgcn_ds_read_tr16_b64_v4i16((__attribute__((address_space(3))) v4i16_t*)p)); }
__device__ __forceinline__ float rowmax(const f32x16&p0,const f32x16&p1){
  float a=max3f(p0[0],p0[1],p1[0]),b=max3f(p0[2],p0[3],p1[1]);a=max3f(a,p1[2],p1[3]);
  #pragma unroll
  for(int r=4;r<16;r+=4){a=max3f(a,p0[r],p0[r+1]);b=max3f(b,p0[r+2],p0[r+3]);a=max3f(a,p1[r],p1[r+1]);b=max3f(b,p1[r+2],p1[r+3]);}
  const float m=max2f(a,b);
  auto rr=__builtin_amdgcn_permlane32_swap(__float_as_uint(m),__float_as_uint(m),false,false);
  return max2f(__uint_as_float(rr[0]),__uint_as_float(rr[1]));
}
__device__ __forceinline__ void pv(f32x16*o,int vb,bf16x8 pa0,bf16x8 pa1,bf16x8 pa2,bf16x8 pa3){
  #pragma unroll
  for(int d0=0;d0<2;++d0){s16x4 lo[4],hi[4];
    #pragma unroll
    for(int ks=0;ks<4;++ks){
      asm volatile("ds_read_b64_tr_b16 %0,%1 offset:%c2":"=&v"(lo[ks]):"v"(vb),"i"(d0*4096+ks*1024):"memory");
      asm volatile("ds_read_b64_tr_b16 %0,%1 offset:%c2":"=&v"(hi[ks]):"v"(vb),"i"(d0*4096+ks*1024+512):"memory");}
    asm volatile("s_waitcnt lgkmcnt(0)":::"memory");SBAR();
    #define PK(k) (bf16x8){lo[k][0],lo[k][1],lo[k][2],lo[k][3],hi[k][0],hi[k][1],hi[k][2],hi[k][3]}
    o[d0]=__builtin_amdgcn_mfma_f32_32x32x16_bf16(pa0,PK(0),o[d0],0,0,0);
    o[d0]=__builtin_amdgcn_mfma_f32_32x32x16_bf16(pa1,PK(1),o[d0],0,0,0);
    o[d0]=__builtin_amdgcn_mfma_f32_32x32x16_bf16(pa2,PK(2),o[d0],0,0,0);
    o[d0]=__builtin_amdgcn_mfma_f32_32x32x16_bf16(pa3,PK(3),o[d0],0,0,0);
    #undef PK
  }
}

#ifndef ATTN_STORE16
#define ATTN_STORE16(p,v) (*(u32x4*)(p)=(v))
#endif
template<bool CAUSAL,bool AUG,int THRL> __device__ __forceinline__ void attn_unit(const bf16*Qu,int ldq,const bf16*__restrict__ Kh,int ldk,const bf16*__restrict__ Vh,int ldv,bf16*Ou,int ldo,const bf16*__restrict__ aug,int NT,char*shm,bf16x8(&qr)[4],bool primed,int par,const bf16*Qn,const bf16*Kn,const bf16*augn,int NTn){
  int tid_=threadIdx.x; asm volatile("":"+v"(tid_));
  const int tid=tid_,lane=tid&63,r32=lane&31,hi=lane>>5; const int wid=__builtin_amdgcn_readfirstlane(tid>>6);
  const bf16*Qw=Qu+(long)(wid*QBLK)*ldq;
  const unsigned lds0=(unsigned)(uintptr_t)shm;
  float*wsf=(float*)(shm+LDS_WS)+wid*64;
  const bf16*ksrc=Kh+(long)lane*ldk+wid*8;
  const bf16*vsrc=Vh+(long)(16*(wid&3)+(lane>>2))*ldv+(wid>>2)*32+(lane&3)*8;
  const unsigned kdst=lds0+LDS_K+wid*1024, vdst=lds0+LDS_V+wid*1024;
  #define DMA_K(t,slot) glds16(ksrc+(long)(t)*KVBLK*ldk,(unsigned)__builtin_amdgcn_readfirstlane(kdst+(slot)))
  #define DMA_V(t,slot) glds16(vsrc+(long)(t)*KVBLK*ldv,(unsigned)__builtin_amdgcn_readfirstlane(vdst+(slot)))
  const int vb0=(int)(lds0+LDS_V)+((lane>>4)&1)*32+(lane&3)*8+(4*hi+((lane&15)>>2))*64;
  const char*Kbase=shm+LDS_K; bf16x8 kf[8];
  const lds_cptr shm3=(lds_cptr)shm; const lds_cptr kp0=shm3+LDS_K+hi*1024+r32*16; const lds_cptr vp0=shm3+LDS_V+((lane>>4)&1)*32+(lane&3)*8+(4*hi+((lane&15)>>2))*64;
  typedef __attribute__((address_space(3))) unsigned long long* lds_u64p; typedef __attribute__((address_space(3))) u32x4* lds_v4p;
  bf16x8 qaug=bf16x8{}; const lds_cptr augp=(lds_cptr)shm+LDS_AUG+par*32768+r32*8;
  u32x4 av_[4];
  if(AUG){
    if(!primed){
    #pragma unroll
    for(int k_=0;k_<4;++k_){ const int i=tid+512*k_; if(i<NT*32) av_[k_]=*(const u32x4*)(aug+(long)i*8); } }
    if(hi==0){qaug[0]=(short)0x3F80;qaug[1]=(short)0x3F80;qaug[2]=(short)0x3F80;} }
  #define KAUG(t,w) ({ bf16x8 r_=bf16x8{}; if(AUG){ const unsigned long long u_=*(const __attribute__((address_space(3))) unsigned long long*)(augp+(t)*512+(w)*256); const u32x4 q_={(unsigned)u_,(unsigned)(u_>>32),0u,0u}; r_=__builtin_bit_cast(bf16x8,q_);} r_; })
  if(!primed){
  DMA_K(0,0);DMA_V(0,0);DMA_K(1,SLOTB);
  #pragma unroll
  for(int d0=0;d0<4;++d0)qr[d0]=*reinterpret_cast<const bf16x8*>(&Qw[(long)r32*ldq+d0*16+hi*8]);
  } else { DMA_V(0,0); }
  float mhat=0.f,l_reg=0.f;float z_=0.f;asm volatile("":"+v"(z_));f32x16 o[2];f32x16 negm;
  #pragma unroll
  for(int r=0;r<16;++r){o[0][r]=z_;o[1][r]=z_;negm[r]=z_;}
  asm volatile("":"+v"(negm));
  const int qrel=wid*QBLK+r32;
  #define CMASK(P0,P1,t) do{ if(CAUSAL){int jb_=(t)-(NT-4); if(jb_>=0)cmask(P0,P1,jb_,qrel,hi);} }while(0)
  bool resc=false;
  #define START(P0,P1) do{ const float rm=rowmax(P0,P1); resc=false; \
    { const float dl=rm; mhat=fadd_s(mhat,dl); \
      _Pragma("unroll") for(int r=0;r<16;++r){P0[r]=fsub_s(P0[r],dl);P1[r]=fsub_s(P1[r],dl);} \
      _Pragma("unroll") for(int r=0;r<16;++r)negm[r]=-mhat; asm volatile("":"+v"(negm)); } \
    _Pragma("unroll") for(int r=0;r<16;++r)P0[r]=__builtin_amdgcn_exp2f(P0[r]); }while(0)
  #define RESC() do{ if(resc){ asm volatile("s_waitcnt lgkmcnt(0)":::"memory"); \
      _Pragma("unroll") for(int d_=0;d_<2;++d_) _Pragma("unroll") for(int r=0;r<16;++r)o[d_][r]*=wsf[crow(r,hi)]; } }while(0)
  f32x16 pA0,pA1,pB0,pB1;
  int sl_prev=0,sl_cur=0,sl_next=SLOTB;
  #define ROT() do{sl_prev=sl_cur;sl_cur=sl_next;sl_next=(sl_next==(NSLOT-1)*SLOTB)?0:sl_next+SLOTB;}while(0)
  if(!primed){
  DMA_K(2,2*SLOTB);
  if(AUG){ asm volatile("s_waitcnt vmcnt(0)":::"memory");
    #pragma unroll
    for(int k_=0;k_<4;++k_){ const int i=tid+512*k_; if(i<NT*32) *(lds_v4p)((lds_cptr)shm+LDS_AUG+par*32768+i*16)=av_[k_]; }
    WAIT_BAR(0); }
  else { WAIT_BAR(3); }
  } else { WAIT_BAR(1); }
  { const bf16x8 ka0_=KAUG(0,0),ka1_=KAUG(0,1); qkt<AUG>(pA0,pA1,Kbase,qr,negm,r32,hi,ka0_,ka1_,qaug); } asm volatile("s_nop 15\n\ts_nop 7":"+v"(pA0),"+v"(pA1));CMASK(pA0,pA1,0);
  START(pA0,pA1);
  _Pragma("unroll") for(int r=0;r<16;++r)pA1[r]=__builtin_amdgcn_exp2f(pA1[r]);
  WAIT_BAR(0);
  DMA_K(3,0);DMA_V(1,SLOTB);
  ROT();
  kload8(kf,kp0+sl_cur);
  WAIT_BAR(2);
  s16x4 vlo[8],vhi[8]; u32x4 pw0,pw1,pw2,pw3;
  #define PKW(P,B) cvtpk_s(P[B],P[B+1])
  #define PAF(k) __builtin_bit_cast(bf16x8,pw##k)
  #define VFR(i) (bf16x8){vlo[i][0],vlo[i][1],vlo[i][2],vlo[i][3],vhi[i][0],vhi[i][1],vhi[i][2],vhi[i][3]}
  #define PIN(x) asm volatile("":"+v"(x))
  #define MX3(a,b,c) __builtin_fmaxf(__builtin_fmaxf((a),(b)),(c))
  #define GAPA(MF,A0,A1,A2,A3,W0,W1,PW) do{ MF; sacc+=A0; sacc+=A1; sacc+=A2; sacc+=A3; PIN(sacc); W0; W1; PIN(PW); SBAR(); }while(0)
  #define EX(v) __builtin_amdgcn_exp2f(v)
  #define GAPB(MF,X,B) do{ MF; X[B]=EX(X[B]); X[B+1]=EX(X[B+1]); X[B+2]=EX(X[B+2]); X[B+3]=EX(X[B+3]); PIN(X); SBAR(); }while(0)
  #define VRD(i) do{ vlo[i]=vtr(vp_+(((i)>>2)*4096+((i)&3)*1024)); vhi[i]=vtr(vp_+(((i)>>2)*4096+((i)&3)*1024+512)); }while(0)
  #define KRD(G,j) do{ if(G){ kload2(kf,kp0+sl_next,j); SBAR(); } }while(0)
  #define STEP(C0,C1,P0,P1,t,GK,GV,GL) do{ SBAR(); \
    const lds_cptr vp_=vp0+sl_prev; bf16x8 ka0_=bf16x8{},ka1_=bf16x8{}; \
    VRD(0); SBAR(); float sacc=(P0[0]+P0[1]); \
    GAPA(C0=__builtin_amdgcn_mfma_f32_32x32x16_bf16(kf[0],qr[0],negm,0,0,0), P0[2],P0[3],P0[4],P0[5],     pw0[0]=PKW(P0,0), pw0[1]=PKW(P0,2), pw0); \
    VRD(4); SBAR(); GAPA(C1=__builtin_amdgcn_mfma_f32_32x32x16_bf16(kf[1],qr[0],negm,0,0,0), P0[6],P0[7],P0[8],P0[9],     pw0[2]=PKW(P0,4), pw0[3]=PKW(P0,6), pw0); \
    VRD(1); SBAR(); GAPA(C0=__builtin_amdgcn_mfma_f32_32x32x16_bf16(kf[2],qr[1],C0,0,0,0),   P0[10],P0[11],P0[12],P0[13], pw1[0]=PKW(P0,8), pw1[1]=PKW(P0,10), pw1); \
    VRD(5); SBAR(); GAPA(C1=__builtin_amdgcn_mfma_f32_32x32x16_bf16(kf[3],qr[1],C1,0,0,0),   P0[14],P0[15],P1[0],P1[1],   pw1[2]=PKW(P0,12),pw1[3]=PKW(P0,14), pw1); \
    VRD(2); SBAR(); GAPA(C0=__builtin_amdgcn_mfma_f32_32x32x16_bf16(kf[4],qr[2],C0,0,0,0),   P1[2],P1[3],P1[4],P1[5],     pw2[0]=PKW(P1,0), pw2[1]=PKW(P1,2), pw2); \
    VRD(6); SBAR(); GAPA(C1=__builtin_amdgcn_mfma_f32_32x32x16_bf16(kf[5],qr[2],C1,0,0,0),   P1[6],P1[7],P1[8],P1[9],     pw2[2]=PKW(P1,4), pw2[3]=PKW(P1,6), pw2); \
    if(AUG){ ka0_=KAUG(t,0); ka1_=KAUG(t,1); SBAR(); } \
    VRD(3); SBAR(); GAPA(C0=__builtin_amdgcn_mfma_f32_32x32x16_bf16(kf[6],qr[3],C0,0,0,0),   P1[10],P1[11],P1[12],P1[13], pw3[0]=PKW(P1,8), pw3[1]=PKW(P1,10), pw3); \
    VRD(7); SBAR(); GAPA(C1=__builtin_amdgcn_mfma_f32_32x32x16_bf16(kf[7],qr[3],C1,0,0,0),   P1[14],P1[15],0.f,0.f,       pw3[2]=PKW(P1,12),pw3[3]=PKW(P1,14), pw3); \
    if(AUG){ C0=__builtin_amdgcn_mfma_f32_32x32x16_bf16(ka0_,qaug,C0,0,0,0); C1=__builtin_amdgcn_mfma_f32_32x32x16_bf16(ka1_,qaug,C1,0,0,0); } \
    l_reg+=sacc; \
    if(GK){DMA_K((t)+3,sl_cur);} if(GV){DMA_V((t)+1,sl_next);} \
    CMASK(C0,C1,t); \
    { float a=MX3(C0[0],C0[1],C1[0]),b=MX3(C0[2],C0[3],C1[1]); a=MX3(a,C1[2],C1[3]); \
      _Pragma("unroll") for(int r=4;r<16;r+=4){a=MX3(a,C0[r],C0[r+1]);b=MX3(b,C0[r+2],C0[r+3]);a=MX3(a,C1[r],C1[r+1]);b=MX3(b,C1[r+2],C1[r+3]);} \
      float rm=__builtin_fmaxf(a,b); { auto rr=__builtin_amdgcn_permlane32_swap(__float_as_uint(rm),__float_as_uint(rm),false,false); rm=__builtin_fmaxf(__uint_as_float(rr[0]),__uint_as_float(rr[1])); } \
      resc=false; \
      if(__builtin_expect(__any(rm>(float)THRL),0)){ const float dl=__builtin_fmaxf(rm,0.f); mhat+=dl; \
        _Pragma("unroll") for(int r=0;r<16;++r){C0[r]-=dl;C1[r]-=dl;} \
        _Pragma("unroll") for(int r=0;r<16;++r)negm[r]=-mhat; asm volatile("":"+v"(negm)); \
        const float f=__builtin_amdgcn_exp2f(-dl); l_reg*=f; if(hi==0)wsf[r32]=f; resc=true; } } \
    SBAR(); \
    GAPB(o[0]=__builtin_amdgcn_mfma_f32_32x32x16_bf16(PAF(0),VFR(0),o[0],0,0,0), C0,0); \
    GAPB(o[1]=__builtin_amdgcn_mfma_f32_32x32x16_bf16(PAF(0),VFR(4),o[1],0,0,0), C0,4); \
    KRD(GL,0); GAPB(o[0]=__builtin_amdgcn_mfma_f32_32x32x16_bf16(PAF(1),VFR(1),o[0],0,0,0), C0,8); \
    KRD(GL,1); GAPB(o[1]=__builtin_amdgcn_mfma_f32_32x32x16_bf16(PAF(1),VFR(5),o[1],0,0,0), C0,12); \
    KRD(GL,2); GAPB(o[0]=__builtin_amdgcn_mfma_f32_32x32x16_bf16(PAF(2),VFR(2),o[0],0,0,0), C1,0); \
    KRD(GL,3); GAPB(o[1]=__builtin_amdgcn_mfma_f32_32x32x16_bf16(PAF(2),VFR(6),o[1],0,0,0), C1,4); \
    GAPB(o[0]=__builtin_amdgcn_mfma_f32_32x32x16_bf16(PAF(3),VFR(3),o[0],0,0,0), C1,8); \
    GAPB(o[1]=__builtin_amdgcn_mfma_f32_32x32x16_bf16(PAF(3),VFR(7),o[1],0,0,0), C1,12); \
    }while(0)
  int t=1;
  #undef CMASK
  #define CMASK(P0,P1,t) do{}while(0)
  for(;t+5<NT;t+=2){
    STEP(pB0,pB1,pA0,pA1,t,true,true,true);     WAIT_BAR(2); RESC(); ROT();
    STEP(pA0,pA1,pB0,pB1,t+1,true,true,true);   WAIT_BAR(2); RESC(); ROT();
  }
  #undef CMASK
  #define CMASK(P0,P1,t) do{ if(CAUSAL){int jb_=(t)-(NT-4); if(jb_>=0)cmask(P0,P1,jb_,qrel,hi);} }while(0)
  #define ENDW(tt) do{ if((tt)+3<NT){WAIT_BAR(2);} else if((tt)+2<NT){WAIT_BAR(1);} else {WAIT_BAR(0);} }while(0)
  for(;t+1<NT;t+=2){
    STEP(pB0,pB1,pA0,pA1,t,(t+3<NT),(t+1<NT),(t+1<NT));       ENDW(t);   RESC(); ROT();
    STEP(pA0,pA1,pB0,pB1,t+1,(t+4<NT),(t+2<NT),(t+2<NT));     ENDW(t+1); RESC(); ROT();
  }
  if(Qn){ const bf16*ksn=Kn+(long)lane*ldk+wid*8;
    glds16(ksn,(unsigned)__builtin_amdgcn_readfirstlane(kdst)); glds16(ksn+(long)KVBLK*ldk,(unsigned)__builtin_amdgcn_readfirstlane(kdst+SLOTB)); glds16(ksn+2L*KVBLK*ldk,(unsigned)__builtin_amdgcn_readfirstlane(kdst+2*SLOTB)); }
  STEP(pB0,pB1,pA0,pA1,NT-1,false,false,false); RESC();
  if(Qn){ const bf16*Qwn=Qn+(long)(wid*QBLK)*ldq;
    #pragma unroll
    for(int d0=0;d0<4;++d0)qr[d0]=*reinterpret_cast<const bf16x8*>(&Qwn[(long)r32*ldq+d0*16+hi*8]);
    if(AUG){
      #pragma unroll
      for(int k_=0;k_<4;++k_){ const int i=tid+512*k_; if(i<NTn*32) av_[k_]=*(const u32x4*)(augn+(long)i*8); } } }
  { float sacc=pB0[0]+pB0[1]; _Pragma("unroll") for(int r=2;r<16;++r)sacc+=pB0[r]; _Pragma("unroll") for(int r=0;r<16;++r)sacc+=pB1[r]; l_reg+=sacc;
    pw0=(u32x4){PKW(pB0,0),PKW(pB0,2),PKW(pB0,4),PKW(pB0,6)};pw1=(u32x4){PKW(pB0,8),PKW(pB0,10),PKW(pB0,12),PKW(pB0,14)};pw2=(u32x4){PKW(pB1,0),PKW(pB1,2),PKW(pB1,4),PKW(pB1,6)};pw3=(u32x4){PKW(pB1,8),PKW(pB1,10),PKW(pB1,12),PKW(pB1,14)};
    SBAR(); pv(o,vb0+sl_cur,PAF(0),PAF(1),PAF(2),PAF(3)); }
  #undef PKW
  #undef PAF
  #undef VFR
  #undef PIN
  #undef MX3
  #undef GAPA
  #undef GAPB
  #undef EX
  #undef VRD
  #undef KRD
  #undef STEP
  #undef ENDW
  {auto rr=__builtin_amdgcn_permlane32_swap(__float_as_uint(l_reg),__float_as_uint(l_reg),false,false);l_reg=__uint_as_float(rr[0])+__uint_as_float(rr[1]);}
  if(hi==0)wsf[32+r32]=l_reg;asm volatile("s_waitcnt lgkmcnt(0)":::"memory");
  float rli[16];
  #pragma unroll
  for(int r=0;r<16;++r)rli[r]=__builtin_amdgcn_rcpf(wsf[32+crow(r,hi)]);
  bf16*Ow=Ou+(long)(wid*QBLK)*ldo;
  { bf16*stg=(bf16*)(shm+LDS_OST)+wid*2048;
    #pragma unroll
    for(int r=0;r<16;++r){const int orow=crow(r,hi);
      #pragma unroll
      for(int d0=0;d0<2;++d0)stg[orow*64+d0*32+r32]=f2bf(o[d0][r]*rli[r]);}
    asm volatile("s_waitcnt lgkmcnt(0)":::"memory");
    #pragma unroll
    for(int i=0;i<4;++i){const int row=i*8+(lane>>3),ch=lane&7; const u32x4 v=*(const u32x4*)(stg+row*64+ch*8); ATTN_STORE16(Ow+(long)row*ldo+ch*8,v);} }
  if(AUG&&Qn){
    #pragma unroll
    for(int k_=0;k_<4;++k_){ const int i=tid+512*k_; if(i<NTn*32) *(lds_v4p)((lds_cptr)shm+LDS_AUG+(par^1)*32768+i*16)=av_[k_]; } }
  asm volatile("s_waitcnt lgkmcnt(0)\n\ts_barrier":::"memory");
  #undef DMA_K
  #undef DMA_V
  #undef KAUG
  #undef CMASK
  #undef START
  #undef RESC
  #undef ROT
}
template<int THRL> __device__ __forceinline__ void attn_unit128(const bf16*Qu,int ldq,const bf16*__restrict__ Kh,int ldk,const bf16*__restrict__ Vh,int ldv,bf16*Ou,int ldo,const bf16*__restrict__ aug,int NT,char*shm,bf16x8(&qr)[4],bool primed,int par,const bf16*Qn,const bf16*Kn,const bf16*augn,int NTn){
  u32x4 av_[4]; (void)av_;
  constexpr bool CAUSAL=true, AUG=false; constexpr int LDS_WS=LDS_V+3*16384, LDS_OST=LDS_WS+NW*64*4;
  int tid_=threadIdx.x; asm volatile("":"+v"(tid_));
  const int tid=tid_,lane=tid&63,r32=lane&31,hi=lane>>5; const int wid=__builtin_amdgcn_readfirstlane(tid>>6);
  const bf16*Qw=Qu+(long)(wid*QBLK)*ldq;
  const unsigned lds0=(unsigned)(uintptr_t)shm;
  float*wsf=(float*)(shm+LDS_WS)+wid*64;
  const bf16*ksrc=Kh+(long)lane*ldk+wid*8;
  const bf16*vsrc=Vh+(long)(16*(wid&3)+(lane>>2))*ldv+(wid>>2)*32+(lane&3)*8;
  const unsigned kdst=lds0+LDS_K+wid*1024, vdst=lds0+LDS_V+wid*1024;
  #define DMA_K(t,slot) glds16(ksrc+(long)(t)*KVBLK*ldk,(unsigned)__builtin_amdgcn_readfirstlane(kdst+(slot)))
  #define DMA_V(t,slot) do{ glds16(vsrc+(long)(t)*KVBLK*ldv,(unsigned)__builtin_amdgcn_readfirstlane(vdst+2*(slot))); glds16(vsrc+(long)(t)*KVBLK*ldv+64,(unsigned)__builtin_amdgcn_readfirstlane(vdst+2*(slot)+8192)); }while(0)
  const int vb0=(int)(lds0+LDS_V)+((lane>>4)&1)*32+(lane&3)*8+(4*hi+((lane&15)>>2))*64;
  const char*Kbase=shm+LDS_K; bf16x8 kf[8];
  const lds_cptr shm3=(lds_cptr)shm; const lds_cptr kp0=shm3+LDS_K+hi*1024+r32*16; const lds_cptr vp0=shm3+LDS_V+((lane>>4)&1)*32+(lane&3)*8+(4*hi+((lane&15)>>2))*64;
  typedef __attribute__((address_space(3))) unsigned long long* lds_u64p; typedef __attribute__((address_space(3))) u32x4* lds_v4p;
  bf16x8 qaug=bf16x8{}; const lds_cptr augp=(lds_cptr)shm+LDS_AUG+par*32768+r32*8;
  if(AUG){ for(int i=tid;i<NT*32;i+=512){ const u32x4 v=*(const u32x4*)(aug+(long)i*8); *(lds_v4p)((lds_cptr)shm+LDS_AUG+i*16)=v; }
    asm volatile("s_waitcnt vmcnt(0)":::"memory");
    if(hi==0){qaug[0]=(short)0x3F80;qaug[1]=(short)0x3F80;qaug[2]=(short)0x3F80;} }
  #define KAUG(t,w) ({ bf16x8 r_=bf16x8{}; if(AUG){ const unsigned long long u_=*(const __attribute__((address_space(3))) unsigned long long*)(augp+(t)*512+(w)*256); const u32x4 q_={(unsigned)u_,(unsigned)(u_>>32),0u,0u}; r_=__builtin_bit_cast(bf16x8,q_);} r_; })
  if(!primed){
  DMA_K(0,0);DMA_V(0,0);DMA_K(1,SLOTB);
  #pragma unroll
  for(int d0=0;d0<4;++d0)qr[d0]=*reinterpret_cast<const bf16x8*>(&Qw[(long)r32*ldq+d0*16+hi*8]);
  } else { DMA_V(0,0); }
  float mhat=0.f,l_reg=0.f;float z_=0.f;asm volatile("":"+v"(z_));f32x16 o[4];f32x16 negm;
  #pragma unroll
  for(int r=0;r<16;++r){o[0][r]=z_;o[1][r]=z_;o[2][r]=z_;o[3][r]=z_;negm[r]=z_;}
  asm volatile("":"+v"(negm));
  const int qrel=wid*QBLK+r32;
  #define CMASK(P0,P1,t) do{ if(CAUSAL){int jb_=(t)-(NT-4); if(jb_>=0)cmask(P0,P1,jb_,qrel,hi);} }while(0)
  bool resc=false;
  #define START(P0,P1) do{ const float rm=rowmax(P0,P1); resc=false; \
    { const float dl=rm; mhat=fadd_s(mhat,dl); \
      _Pragma("unroll") for(int r=0;r<16;++r){P0[r]=fsub_s(P0[r],dl);P1[r]=fsub_s(P1[r],dl);} \
      _Pragma("unroll") for(int r=0;r<16;++r)negm[r]=-mhat; asm volatile("":"+v"(negm)); } \
    _Pragma("unroll") for(int r=0;r<16;++r)P0[r]=__builtin_amdgcn_exp2f(P0[r]); }while(0)
  #define RESC() do{ if(resc){ asm volatile("s_waitcnt lgkmcnt(0)":::"memory"); \
      _Pragma("unroll") for(int d_=0;d_<4;++d_) _Pragma("unroll") for(int r=0;r<16;++r)o[d_][r]*=wsf[crow(r,hi)]; } }while(0)
  f32x16 pA0,pA1,pB0,pB1;
  int sl_prev=0,sl_cur=0,sl_next=SLOTB;
  #define ROT() do{sl_prev=sl_cur;sl_cur=sl_next;sl_next=(sl_next==(NSLOT-1)*SLOTB)?0:sl_next+SLOTB;}while(0)
  if(!primed){
  DMA_K(2,2*SLOTB);
  WAIT_BAR(4);
  } else { WAIT_BAR(2); }
  { const bf16x8 ka0_=KAUG(0,0),ka1_=KAUG(0,1); qkt<AUG>(pA0,pA1,Kbase,qr,negm,r32,hi,ka0_,ka1_,qaug); } asm volatile("s_nop 15\n\ts_nop 7":"+v"(pA0),"+v"(pA1));CMASK(pA0,pA1,0);
  START(pA0,pA1);
  _Pragma("unroll") for(int r=0;r<16;++r)pA1[r]=__builtin_amdgcn_exp2f(pA1[r]);
  WAIT_BAR(0);
  DMA_K(3,0);DMA_V(1,SLOTB);
  ROT();
  kload8(kf,kp0+sl_cur);
  WAIT_BAR(3);
  s16x4 vlo[8],vhi[8],wlo[8],whi[8]; u32x4 pw0,pw1,pw2,pw3;
  #define PKW(P,B) cvtpk_s(P[B],P[B+1])
  #define PAF(k) __builtin_bit_cast(bf16x8,pw##k)
  #define VFR(i) (bf16x8){vlo[i][0],vlo[i][1],vlo[i][2],vlo[i][3],vhi[i][0],vhi[i][1],vhi[i][2],vhi[i][3]}
  #define WFR(i) (bf16x8){wlo[i][0],wlo[i][1],wlo[i][2],wlo[i][3],whi[i][0],whi[i][1],whi[i][2],whi[i][3]}
  #define PIN(x) asm volatile("":"+v"(x))
  #define MX3(a,b,c) __builtin_fmaxf(__builtin_fmaxf((a),(b)),(c))
  #define GAPA(MF,A0,A1,A2,A3,W0,W1,PW) do{ MF; sacc+=A0; sacc+=A1; sacc+=A2; sacc+=A3; PIN(sacc); W0; W1; PIN(PW); SBAR(); }while(0)
  #define EX(v) __builtin_amdgcn_exp2f(v)
  #define GAPB(MF,X,B) do{ MF; X[B]=EX(X[B]); X[B+1]=EX(X[B+1]); PIN(X); SBAR(); }while(0)
  #define VRD(i) do{ vlo[i]=vtr(vp_+(((i)>>2)*4096+((i)&3)*1024)); vhi[i]=vtr(vp_+(((i)>>2)*4096+((i)&3)*1024+512)); }while(0)
  #define WRD(i) do{ wlo[i]=vtr(vp_+(8192+((i)>>2)*4096+((i)&3)*1024)); whi[i]=vtr(vp_+(8192+((i)>>2)*4096+((i)&3)*1024+512)); SBAR(); }while(0)
  #define KRD(G,j) do{ if(G){ kload2(kf,kp0+sl_next,j); SBAR(); } }while(0)
  #define STEP(C0,C1,P0,P1,t,GK,GV,GL) do{ SBAR(); \
    const lds_cptr vp_=vp0+2*sl_prev; bf16x8 ka0_=bf16x8{},ka1_=bf16x8{}; \
    VRD(0); SBAR(); float sacc=(P0[0]+P0[1]); \
    GAPA(C0=__builtin_amdgcn_mfma_f32_32x32x16_bf16(kf[0],qr[0],negm,0,0,0), P0[2],P0[3],P0[4],P0[5],     pw0[0]=PKW(P0,0), pw0[1]=PKW(P0,2), pw0); \
    VRD(4); SBAR(); GAPA(C1=__builtin_amdgcn_mfma_f32_32x32x16_bf16(kf[1],qr[0],negm,0,0,0), P0[6],P0[7],P0[8],P0[9],     pw0[2]=PKW(P0,4), pw0[3]=PKW(P0,6), pw0); \
    VRD(1); SBAR(); GAPA(C0=__builtin_amdgcn_mfma_f32_32x32x16_bf16(kf[2],qr[1],C0,0,0,0),   P0[10],P0[11],P0[12],P0[13], pw1[0]=PKW(P0,8), pw1[1]=PKW(P0,10), pw1); \
    VRD(5); SBAR(); GAPA(C1=__builtin_amdgcn_mfma_f32_32x32x16_bf16(kf[3],qr[1],C1,0,0,0),   P0[14],P0[15],P1[0],P1[1],   pw1[2]=PKW(P0,12),pw1[3]=PKW(P0,14), pw1); \
    VRD(2); SBAR(); GAPA(C0=__builtin_amdgcn_mfma_f32_32x32x16_bf16(kf[4],qr[2],C0,0,0,0),   P1[2],P1[3],P1[4],P1[5],     pw2[0]=PKW(P1,0), pw2[1]=PKW(P1,2), pw2); \
    VRD(6); SBAR(); GAPA(C1=__builtin_amdgcn_mfma_f32_32x32x16_bf16(kf[5],qr[2],C1,0,0,0),   P1[6],P1[7],P1[8],P1[9],     pw2[2]=PKW(P1,4), pw2[3]=PKW(P1,6), pw2); \
    if(AUG){ ka0_=KAUG(t,0); ka1_=KAUG(t,1); SBAR(); } \
    VRD(3); SBAR(); GAPA(C0=__builtin_amdgcn_mfma_f32_32x32x16_bf16(kf[6],qr[3],C0,0,0,0),   P1[10],P1[11],P1[12],P1[13], pw3[0]=PKW(P1,8), pw3[1]=PKW(P1,10), pw3); \
    VRD(7); SBAR(); GAPA(C1=__builtin_amdgcn_mfma_f32_32x32x16_bf16(kf[7],qr[3],C1,0,0,0),   P1[14],P1[15],0.f,0.f,       pw3[2]=PKW(P1,12),pw3[3]=PKW(P1,14), pw3); \
    if(AUG){ C0=__builtin_amdgcn_mfma_f32_32x32x16_bf16(ka0_,qaug,C0,0,0,0); C1=__builtin_amdgcn_mfma_f32_32x32x16_bf16(ka1_,qaug,C1,0,0,0); } \
    l_reg+=sacc; \
    if(GK){DMA_K((t)+3,sl_cur);} if(GV){DMA_V((t)+1,sl_next);} \
    CMASK(C0,C1,t); \
    { float a=MX3(C0[0],C0[1],C1[0]),b=MX3(C0[2],C0[3],C1[1]); a=MX3(a,C1[2],C1[3]); \
      _Pragma("unroll") for(int r=4;r<16;r+=4){a=MX3(a,C0[r],C0[r+1]);b=MX3(b,C0[r+2],C0[r+3]);a=MX3(a,C1[r],C1[r+1]);b=MX3(b,C1[r+2],C1[r+3]);} \
      float rm=__builtin_fmaxf(a,b); { auto rr=__builtin_amdgcn_permlane32_swap(__float_as_uint(rm),__float_as_uint(rm),false,false); rm=__builtin_fmaxf(__uint_as_float(rr[0]),__uint_as_float(rr[1])); } \
      resc=false; \
      if(__builtin_expect(__any(rm>(float)THRL),0)){ const float dl=__builtin_fmaxf(rm,0.f); mhat+=dl; \
        _Pragma("unroll") for(int r=0;r<16;++r){C0[r]-=dl;C1[r]-=dl;} \
        _Pragma("unroll") for(int r=0;r<16;++r)negm[r]=-mhat; asm volatile("":"+v"(negm)); \
        const float f=__builtin_amdgcn_exp2f(-dl); l_reg*=f; if(hi==0)wsf[r32]=f; resc=true; } } \
    SBAR(); \
    WRD(0); GAPB(o[0]=__builtin_amdgcn_mfma_f32_32x32x16_bf16(PAF(0),VFR(0),o[0],0,0,0), C0,0); \
    WRD(4); GAPB(o[1]=__builtin_amdgcn_mfma_f32_32x32x16_bf16(PAF(0),VFR(4),o[1],0,0,0), C0,2); \
    WRD(1); GAPB(o[0]=__builtin_amdgcn_mfma_f32_32x32x16_bf16(PAF(1),VFR(1),o[0],0,0,0), C0,4); \
    WRD(5); GAPB(o[1]=__builtin_amdgcn_mfma_f32_32x32x16_bf16(PAF(1),VFR(5),o[1],0,0,0), C0,6); \
    WRD(2); GAPB(o[0]=__builtin_amdgcn_mfma_f32_32x32x16_bf16(PAF(2),VFR(2),o[0],0,0,0), C0,8); \
    WRD(6); GAPB(o[1]=__builtin_amdgcn_mfma_f32_32x32x16_bf16(PAF(2),VFR(6),o[1],0,0,0), C0,10); \
    WRD(3); GAPB(o[0]=__builtin_amdgcn_mfma_f32_32x32x16_bf16(PAF(3),VFR(3),o[0],0,0,0), C0,12); \
    WRD(7); GAPB(o[1]=__builtin_amdgcn_mfma_f32_32x32x16_bf16(PAF(3),VFR(7),o[1],0,0,0), C0,14); \
    GAPB(o[2]=__builtin_amdgcn_mfma_f32_32x32x16_bf16(PAF(0),WFR(0),o[2],0,0,0), C1,0); \
    GAPB(o[3]=__builtin_amdgcn_mfma_f32_32x32x16_bf16(PAF(0),WFR(4),o[3],0,0,0), C1,2); \
    KRD(GL,0); GAPB(o[2]=__builtin_amdgcn_mfma_f32_32x32x16_bf16(PAF(1),WFR(1),o[2],0,0,0), C1,4); \
    KRD(GL,1); GAPB(o[3]=__builtin_amdgcn_mfma_f32_32x32x16_bf16(PAF(1),WFR(5),o[3],0,0,0), C1,6); \
    KRD(GL,2); GAPB(o[2]=__builtin_amdgcn_mfma_f32_32x32x16_bf16(PAF(2),WFR(2),o[2],0,0,0), C1,8); \
    KRD(GL,3); GAPB(o[3]=__builtin_amdgcn_mfma_f32_32x32x16_bf16(PAF(2),WFR(6),o[3],0,0,0), C1,10); \
    GAPB(o[2]=__builtin_amdgcn_mfma_f32_32x32x16_bf16(PAF(3),WFR(3),o[2],0,0,0), C1,12); \
    GAPB(o[3]=__builtin_amdgcn_mfma_f32_32x32x16_bf16(PAF(3),WFR(7),o[3],0,0,0), C1,14); \
    }while(0)
  int t=1;
  #undef CMASK
  #define CMASK(P0,P1,t) do{}while(0)
  for(;t+5<NT;t+=2){
    STEP(pB0,pB1,pA0,pA1,t,true,true,true);     WAIT_BAR(3); RESC(); ROT();
    STEP(pA0,pA1,pB0,pB1,t+1,true,true,true);   WAIT_BAR(3); RESC(); ROT();
  }
  #undef CMASK
  #define CMASK(P0,P1,t) do{ if(CAUSAL){int jb_=(t)-(NT-4); if(jb_>=0)cmask(P0,P1,jb_,qrel,hi);} }while(0)
  #define ENDW(tt) do{ if((tt)+3<NT){WAIT_BAR(3);} else if((tt)+2<NT){WAIT_BAR(2);} else {WAIT_BAR(0);} }while(0)
  for(;t+1<NT;t+=2){
    STEP(pB0,pB1,pA0,pA1,t,(t+3<NT),(t+1<NT),(t+1<NT));       ENDW(t);   RESC(); ROT();
    STEP(pA0,pA1,pB0,pB1,t+1,(t+4<NT),(t+2<NT),(t+2<NT));     ENDW(t+1); RESC(); ROT();
  }
  if(Qn){ const bf16*ksn=Kn+(long)lane*ldk+wid*8;
    glds16(ksn,(unsigned)__builtin_amdgcn_readfirstlane(kdst)); glds16(ksn+(long)KVBLK*ldk,(unsigned)__builtin_amdgcn_readfirstlane(kdst+SLOTB)); glds16(ksn+2L*KVBLK*ldk,(unsigned)__builtin_amdgcn_readfirstlane(kdst+2*SLOTB)); }
  STEP(pB0,pB1,pA0,pA1,NT-1,false,false,false); RESC();
  if(Qn){ const bf16*Qwn=Qn+(long)(wid*QBLK)*ldq;
    #pragma unroll
    for(int d0=0;d0<4;++d0)qr[d0]=*reinterpret_cast<const bf16x8*>(&Qwn[(long)r32*ldq+d0*16+hi*8]);
    if(AUG){
      #pragma unroll
      for(int k_=0;k_<4;++k_){ const int i=tid+512*k_; if(i<NTn*32) av_[k_]=*(const u32x4*)(augn+(long)i*8); } } }
  { float sacc=pB0[0]+pB0[1]; _Pragma("unroll") for(int r=2;r<16;++r)sacc+=pB0[r]; _Pragma("unroll") for(int r=0;r<16;++r)sacc+=pB1[r]; l_reg+=sacc;
    pw0=(u32x4){PKW(pB0,0),PKW(pB0,2),PKW(pB0,4),PKW(pB0,6)};pw1=(u32x4){PKW(pB0,8),PKW(pB0,10),PKW(pB0,12),PKW(pB0,14)};pw2=(u32x4){PKW(pB1,0),PKW(pB1,2),PKW(pB1,4),PKW(pB1,6)};pw3=(u32x4){PKW(pB1,8),PKW(pB1,10),PKW(pB1,12),PKW(pB1,14)};
    SBAR(); pv(o,vb0+2*sl_cur,PAF(0),PAF(1),PAF(2),PAF(3)); pv(o+2,vb0+2*sl_cur+8192,PAF(0),PAF(1),PAF(2),PAF(3)); }
  #undef PKW
  #undef PAF
  #undef VFR
  #undef WFR
  #undef WRD
  #undef PIN
  #undef MX3
  #undef GAPA
  #undef GAPB
  #undef EX
  #undef VRD
  #undef KRD
  #undef STEP
  #undef ENDW
  {auto rr=__builtin_amdgcn_permlane32_swap(__float_as_uint(l_reg),__float_as_uint(l_reg),false,false);l_reg=__uint_as_float(rr[0])+__uint_as_float(rr[1]);}
  if(hi==0)wsf[32+r32]=l_reg;asm volatile("s_waitcnt lgkmcnt(0)":::"memory");
  float rli[16];
  #pragma unroll
  for(int r=0;r<16;++r)rli[r]=__builtin_amdgcn_rcpf(wsf[32+crow(r,hi)]);
  bf16*Ow=Ou+(long)(wid*QBLK)*ldo;
  { bf16*stg=(bf16*)(shm+LDS_OST)+wid*4096;
    #pragma unroll
    for(int r=0;r<16;++r){const int orow=crow(r,hi);
      #pragma unroll
      for(int d0=0;d0<4;++d0)stg[orow*128+d0*32+r32]=f2bf(o[d0][r]*rli[r]);}
    asm volatile("s_waitcnt lgkmcnt(0)":::"memory");
    #pragma unroll
    for(int i=0;i<8;++i){const int row=i*4+(lane>>4),ch=lane&15; const u32x4 v=*(const u32x4*)(stg+row*128+ch*8); ATTN_STORE16(Ow+(long)row*ldo+ch*8,v);} }
  asm volatile("s_waitcnt lgkmcnt(0)\n\ts_barrier":::"memory");
  #undef DMA_K
  #undef DMA_V
  #undef KAUG
  #undef CMASK
  #undef START
  #undef RESC
  #undef ROT
}

__device__ __forceinline__ void cross_panel(const bf16*Qp,int ldq,const bf16*__restrict__ Kp,int ldk,const bf16*__restrict__ Vp,int ldv,bf16*Op,int ldo,char*shm){
  int tid_=threadIdx.x; asm volatile("":"+v"(tid_));
  const int tid=tid_,lane=tid&63,r32=lane&31,hi=lane>>5; const int wid=__builtin_amdgcn_readfirstlane(tid>>6);
  const unsigned lds0=(unsigned)(uintptr_t)shm;
  float*wsf=(float*)(shm+147456)+wid*64;
  bf16*stg=(bf16*)(shm+131072)+wid*1024;
  const bf16*ksrc0=Kp+(long)lane*ldk+wid*8;
  const bf16*vsrc0=Vp+(long)(16*(wid&3)+(lane>>2))*ldv+(wid>>2)*32+(lane&3)*8;
  const int vlane=((lane>>4)&1)*32+(lane&3)*8+(4*hi+((lane&15)>>2))*64;
  #define XDMA(h_,b_) do{ _Pragma("unroll") for(int t_=0;t_<4;++t_){ \
      glds16(ksrc0+(h_)*64+(long)t_*64*ldk,(unsigned)__builtin_amdgcn_readfirstlane(lds0+(b_)*65536+t_*8192+wid*1024)); \
      glds16(vsrc0+(h_)*64+(long)t_*64*ldv,(unsigned)__builtin_amdgcn_readfirstlane(lds0+(b_)*65536+32768+t_*8192+wid*1024)); } }while(0)
  XDMA(0,0);
  float z_=0.f;asm volatile("":"+v"(z_));
  #pragma nounroll
  for(int h=0;h<4;++h){ const int b=h&1;
    bf16x8 qr[4]; const bf16*Qw=Qp+(long)(wid*QBLK)*ldq+h*64;
    #pragma unroll
    for(int d0=0;d0<4;++d0)qr[d0]=*reinterpret_cast<const bf16x8*>(&Qw[(long)r32*ldq+d0*16+hi*8]);
    asm volatile("s_waitcnt vmcnt(0) lgkmcnt(0)\n\ts_barrier":::"memory");
    if(h<3)XDMA(h+1,b^1);
    f32x16 o[2],zero; float mrow=-INFINITY,l=0.f;
    #pragma unroll
    for(int r=0;r<16;++r){o[0][r]=z_;o[1][r]=z_;zero[r]=z_;}
    #pragma unroll
    for(int t=0;t<4;++t){
      f32x16 p0,p1;
      qkt<false>(p0,p1,shm+b*65536+t*8192,qr,zero,r32,hi,bf16x8{},bf16x8{},bf16x8{});
      asm volatile("s_nop 15\n\ts_nop 7":"+v"(p0),"+v"(p1));
      const float rm=rowmax(p0,p1); const float mn=__builtin_fmaxf(mrow,rm); const float alpha=__builtin_amdgcn_exp2f(mrow-mn); mrow=mn;
      float rs=0.f;
      #pragma unroll
      for(int r=0;r<16;++r){p0[r]=__builtin_amdgcn_exp2f(p0[r]-mn);p1[r]=__builtin_amdgcn_exp2f(p1[r]-mn);rs+=p0[r]+p1[r];}
      l=l*alpha+rs;
      if(t>0){ if(hi==0)wsf[r32]=alpha; asm volatile("s_waitcnt lgkmcnt(0)":::"memory");
        #pragma unroll
        for(int d_=0;d_<2;++d_)
          #pragma unroll
          for(int r=0;r<16;++r)o[d_][r]*=wsf[crow(r,hi)];
        asm volatile("s_waitcnt lgkmcnt(0)":::"memory"); }
      const u32x4 pw0={cvtpk_s(p0[0],p0[1]),cvtpk_s(p0[2],p0[3]),cvtpk_s(p0[4],p0[5]),cvtpk_s(p0[6],p0[7])},pw1={cvtpk_s(p0[8],p0[9]),cvtpk_s(p0[10],p0[11]),cvtpk_s(p0[12],p0[13]),cvtpk_s(p0[14],p0[15])};
      const u32x4 pw2={cvtpk_s(p1[0],p1[1]),cvtpk_s(p1[2],p1[3]),cvtpk_s(p1[4],p1[5]),cvtpk_s(p1[6],p1[7])},pw3={cvtpk_s(p1[8],p1[9]),cvtpk_s(p1[10],p1[11]),cvtpk_s(p1[12],p1[13]),cvtpk_s(p1[14],p1[15])};
      SBAR(); pv(o,(int)(lds0+b*65536+32768+t*8192)+vlane,__builtin_bit_cast(bf16x8,pw0),__builtin_bit_cast(bf16x8,pw1),__builtin_bit_cast(bf16x8,pw2),__builtin_bit_cast(bf16x8,pw3));
    }
    {auto rr=__builtin_amdgcn_permlane32_swap(__float_as_uint(l),__float_as_uint(l),false,false);l=__uint_as_float(rr[0])+__uint_as_float(rr[1]);}
    if(hi==0)wsf[32+r32]=l;asm volatile("s_waitcnt lgkmcnt(0)":::"memory");
    float rli[16];
    #pragma unroll
    for(int r=0;r<16;++r)rli[r]=__builtin_amdgcn_rcpf(wsf[32+crow(r,hi)]);
    bf16*Ow=Op+(long)(wid*QBLK)*ldo+h*64;
    #pragma unroll
    for(int d0=0;d0<2;++d0){
      #pragma unroll
      for(int r=0;r<16;++r)stg[crow(r,hi)*32+r32]=f2bf(o[d0][r]*rli[r]);
      asm volatile("s_waitcnt lgkmcnt(0)":::"memory");
      #pragma unroll
      for(int i=0;i<2;++i){const int row=i*16+(lane>>2),ch=lane&3; const u32x4 v=*(const u32x4*)(stg+row*32+ch*8); *(u32x4*)(Ow+(long)row*ldo+d0*32+ch*8)=v;}
      asm volatile("s_waitcnt lgkmcnt(0)":::"memory");
    }
  }
  asm volatile("s_waitcnt lgkmcnt(0)\n\ts_barrier":::"memory");
  #undef XDMA
}
constexpr int ATTN_LDS_BYTES=LDS_BYTES;
#undef SBAR
#undef WAIT_BAR
}
#include <hip/hip_cooperative_groups.h>
namespace cg = cooperative_groups;
#define LAS __attribute__((address_space(3)))
typedef float f32x4 __attribute__((ext_vector_type(4)));
typedef unsigned u32x4 __attribute__((ext_vector_type(4)));
constexpr int NWAVES = 8;
constexpr int RING_BYTES = 131072;
constexpr int STAT_OFF = RING_BYTES;
constexpr int MISC_OFF = STAT_OFF + 16384;
constexpr int LDS_BYTES = 151552;
constexpr size_t WT_IN = 0;
constexpr size_t WT_A = WT_IN + (size_t)5120 * 1024;
constexpr size_t WT_B = WT_A + (size_t)1024 * 512;
constexpr size_t WT_O = WT_B + (size_t)1024 * 512;
constexpr size_t WT_CQ = WT_O + (size_t)1024 * 1024;
constexpr size_t WT_CKV = WT_CQ + (size_t)256 * 1024;
constexpr size_t WT_CO = WT_CKV + (size_t)512 * 1024;
constexpr size_t WT_E1 = WT_CO + (size_t)1024 * 256;
constexpr size_t WT_E2 = WT_E1 + (size_t)32 * 1024 * 1024;
constexpr size_t WT_END = WT_E2 + (size_t)32 * 1024 * 512;
static_assert(WT_END * 2 <= 112 * MiB, "weights fit");

constexpr size_t WS_WG8 = 126 * MiB;
constexpr size_t WS_XN8 = 880 * MiB;
constexpr float WSCALE = 32.f;
struct Args {
    const float* in[28]; float* out; unsigned char* ws; int ph_lo, ph_hi, coop, pad;
};

__device__ __forceinline__ int wcol_in(int n) {
    const int tile = n >> 8, p = n & 255;
    if (tile < 6) return n;
    if (tile < 10) { const int base = tile < 8 ? 1544 : 2056, tl = (tile - 6) & 1; return base + (tl * 4 + ((p & 127) >> 5)) * 64 + (p >> 7) * 32 + (p & 31); }
    if (tile < 12) return 2568 + (n - 2560);
    return 3080 + (n - 3072);
}
__device__ __forceinline__ void p0_transpose_item(const float* W, int ldw, int sc, bf16_t* WT, int K, int n0, int k0, LAS float* scr, int lane, const float* gk = nullptr) {
#pragma unroll
    for (int i = 0; i < 32; ++i) { const int kk = 2 * i + (lane >> 5); const float gv = gk ? gk[k0 + kk] : 1.f; scr[kk * 33 + (lane & 31)] = W[(size_t)(k0 + kk) * ldw + sc + (lane & 31)] * gv; }
    asm volatile("s_waitcnt lgkmcnt(0)" ::: "memory");
    const int c = lane & 7;
#pragma unroll
    for (int j = 0; j < 4; ++j) { const int n = (lane >> 3) + 8 * j; const LAS float* s = scr + (8 * c) * 33 + n;
        u32x4 o; o.x = pg8::cvt_pk_bf16(s[0 * 33], s[1 * 33]); o.y = pg8::cvt_pk_bf16(s[2 * 33], s[3 * 33]); o.z = pg8::cvt_pk_bf16(s[4 * 33], s[5 * 33]); o.w = pg8::cvt_pk_bf16(s[6 * 33], s[7 * 33]);
        *(u32x4*)(WT + (size_t)(n0 + n) * K + k0 + 8 * c) = o; }
    asm volatile("s_waitcnt lgkmcnt(0)" ::: "memory");
}
__device__ __forceinline__ void p0_transpose_item_f8(const float* W, int ldw, int sc, unsigned char* WT8, int Kb, int n0, int k0, LAS float* scr, int lane, const float* gk, float scale) {
#pragma unroll
    for (int i = 0; i < 32; ++i) { const int kk = 2 * i + (lane >> 5); const float gv = (gk ? gk[k0 + kk] : 1.f) * scale; scr[kk * 33 + (lane & 31)] = W[(size_t)(k0 + kk) * ldw + sc + (lane & 31)] * gv; }
    asm volatile("s_waitcnt lgkmcnt(0)" ::: "memory");
    const int c = lane & 7;
#pragma unroll
    for (int j = 0; j < 4; ++j) { const int n = (lane >> 3) + 8 * j; const LAS float* s = scr + (8 * c) * 33 + n;
        unsigned w0 = 0u, w1 = 0u;
        w0 = __builtin_amdgcn_cvt_pk_fp8_f32(s[0 * 33], s[1 * 33], w0, false); w0 = __builtin_amdgcn_cvt_pk_fp8_f32(s[2 * 33], s[3 * 33], w0, true);
        w1 = __builtin_amdgcn_cvt_pk_fp8_f32(s[4 * 33], s[5 * 33], w1, false); w1 = __builtin_amdgcn_cvt_pk_fp8_f32(s[6 * 33], s[7 * 33], w1, true);
        *(uint2*)(WT8 + (size_t)(n0 + n) * Kb + k0 + 8 * c) = make_uint2(w0, w1); }
    asm volatile("s_waitcnt lgkmcnt(0)" ::: "memory");
}
__device__ __forceinline__ bool p0_job_plain(int& r, const float* W, int Kd, int Nd, bf16_t* WT, LAS float* scr, int lane, const float* gk = nullptr, int ldt = 0) {
    const int nblk = Nd / 32, items = (Kd / 64) * nblk;
    if (r >= items) { r -= items; return false; }
    const int kb = r / nblk, nb = r % nblk;
    p0_transpose_item(W, Nd, nb * 32, WT, ldt ? ldt : Kd, nb * 32, kb * 64, scr, lane, gk); return true;
}

template <bool E1MAP> __device__ __forceinline__ void p0_slab_f8(const float* W, int ldw, int c0, int k0, unsigned char* WT8, int Kb, int up, const float* gk, float scale, LAS float* scr, int tid) {
    const int col = (tid & 63) * 4;
    f32x4 v[16];
#pragma unroll
    for (int i = 0; i < 16; ++i) v[i] = *(const f32x4*)(W + (size_t)(k0 + (tid >> 6) + 8 * i) * ldw + c0 + col);
#pragma unroll
    for (int i = 0; i < 16; ++i) { const int r = (tid >> 6) + 8 * i; const float s = (gk ? gk[k0 + r] : 1.f) * scale; LAS float* d = scr + r * 257 + col;
        d[0] = v[i][0] * s; d[1] = v[i][1] * s; d[2] = v[i][2] * s; d[3] = v[i][3] * s; }
    asm volatile("s_waitcnt lgkmcnt(0)" ::: "memory");
    __syncthreads();
#pragma unroll
    for (int j = 0; j < 8; ++j) { const int idx = tid + 512 * j; const int kc = idx & 15, n = idx >> 4; const LAS float* s = scr + (8 * kc) * 257 + n;
        unsigned w0 = 0u, w1 = 0u;
        w0 = __builtin_amdgcn_cvt_pk_fp8_f32(s[0 * 257], s[1 * 257], w0, false); w0 = __builtin_amdgcn_cvt_pk_fp8_f32(s[2 * 257], s[3 * 257], w0, true);
        w1 = __builtin_amdgcn_cvt_pk_fp8_f32(s[4 * 257], s[5 * 257], w1, false); w1 = __builtin_amdgcn_cvt_pk_fp8_f32(s[6 * 257], s[7 * 257], w1, true);
        const int c = c0 + n; const int row = E1MAP ? ((c >> 7) * 256 + (c & 127) + 128 * up) : c;
        *(uint2*)(WT8 + (size_t)row * Kb + k0 + 8 * kc) = make_uint2(w0, w1); }
    asm volatile("s_waitcnt lgkmcnt(0)" ::: "memory");
    __syncthreads();
}
template <bool WIN> __device__ __forceinline__ void p0_slab_bf16(const float* W, int ldw, int c0, int k0, bf16_t* WT, int Kd, const float* gk, LAS float* scr, int tid) {
    const int col = (tid & 63) * 4; const int scol = WIN ? wcol_in(c0 + col) : c0 + col;
    f32x4 v[16];
#pragma unroll
    for (int i = 0; i < 16; ++i) v[i] = *(const f32x4*)(W + (size_t)(k0 + (tid >> 6) + 8 * i) * ldw + scol);
#pragma unroll
    for (int i = 0; i < 16; ++i) { const int r = (tid >> 6) + 8 * i; const float s = gk ? gk[k0 + r] : 1.f; LAS float* d = scr + r * 257 + col;
        d[0] = v[i][0] * s; d[1] = v[i][1] * s; d[2] = v[i][2] * s; d[3] = v[i][3] * s; }
    asm volatile("s_waitcnt lgkmcnt(0)" ::: "memory");
    __syncthreads();
#pragma unroll
    for (int j = 0; j < 8; ++j) { const int idx = tid + 512 * j; const int kc = idx & 15, n = idx >> 4; const LAS float* s = scr + (8 * kc) * 257 + n;
        u32x4 o; o.x = pg8::cvt_pk_bf16(s[0 * 257], s[1 * 257]); o.y = pg8::cvt_pk_bf16(s[2 * 257], s[3 * 257]); o.z = pg8::cvt_pk_bf16(s[4 * 257], s[5 * 257]); o.w = pg8::cvt_pk_bf16(s[6 * 257], s[7 * 257]);
        *(u32x4*)(WT + (size_t)(c0 + n) * Kd + k0 + 8 * kc) = o; }
    asm volatile("s_waitcnt lgkmcnt(0)" ::: "memory");
    __syncthreads();
}
struct SlabItem { const float* W; int ldw, c0, k0; unsigned char* WT8; int Kb, up; const float* gk; bool e1; };
__device__ __forceinline__ SlabItem slab_item(const Args& a, bf16_t* wt, int it) {
    SlabItem s;
    if (it < 1024) { const int e = it >> 5, q = it & 31, up = q >> 4, ks = (q >> 1) & 7, cs = q & 1;
        s.W = (up ? a.in[25] : a.in[24]) + (size_t)e * 1024 * 512; s.ldw = 512; s.c0 = cs * 256; s.k0 = ks * 128; s.WT8 = (unsigned char*)(wt + WT_E1) + (size_t)e * 1024 * 1024; s.Kb = 1024; s.up = up; s.gk = a.in[19]; s.e1 = true; }
    else { const int r2 = it - 1024, e = r2 >> 4, q = r2 & 15, ks = q >> 2, cs = q & 3;
        s.W = a.in[26] + (size_t)e * 512 * 1024; s.ldw = 1024; s.c0 = cs * 256; s.k0 = ks * 128; s.WT8 = (unsigned char*)(wt + WT_E2) + (size_t)e * 1024 * 512; s.Kb = 512; s.up = 0; s.gk = nullptr; s.e1 = false; }
    return s;
}
__device__ __forceinline__ void slab_load(const SlabItem& s, f32x4 (&v)[16], int tid) {
    const int col = (tid & 63) * 4;
#pragma unroll
    for (int i = 0; i < 16; ++i) v[i] = *(const f32x4*)(s.W + (size_t)(s.k0 + (tid >> 6) + 8 * i) * s.ldw + s.c0 + col);
}
__device__ __forceinline__ void slab_store_f8(const SlabItem& s, const f32x4 (&v)[16], LAS float* scr, int tid) {
    const int col = (tid & 63) * 4;
#pragma unroll
    for (int i = 0; i < 16; ++i) { const int r = (tid >> 6) + 8 * i; const float sc = (s.gk ? s.gk[s.k0 + r] : 1.f) * WSCALE; LAS float* d = scr + r * 257 + col;
        d[0] = v[i][0] * sc; d[1] = v[i][1] * sc; d[2] = v[i][2] * sc; d[3] = v[i][3] * sc; }
    asm volatile("s_waitcnt lgkmcnt(0)" ::: "memory");
    __syncthreads();
#pragma unroll
    for (int j = 0; j < 8; ++j) { const int idx = tid + 512 * j; const int kc = idx & 15, n = idx >> 4; const LAS float* q = scr + (8 * kc) * 257 + n;
        unsigned w0 = 0u, w1 = 0u;
        w0 = __builtin_amdgcn_cvt_pk_fp8_f32(q[0 * 257], q[1 * 257], w0, false); w0 = __builtin_amdgcn_cvt_pk_fp8_f32(q[2 * 257], q[3 * 257], w0, true);
        w1 = __builtin_amdgcn_cvt_pk_fp8_f32(q[4 * 257], q[5 * 257], w1, false); w1 = __builtin_amdgcn_cvt_pk_fp8_f32(q[6 * 257], q[7 * 257], w1, true);
        const int c = s.c0 + n; const int row = s.e1 ? ((c >> 7) * 256 + (c & 127) + 128 * s.up) : c;
        *(uint2*)(s.WT8 + (size_t)row * s.Kb + s.k0 + 8 * kc) = make_uint2(w0, w1); }
    asm volatile("s_waitcnt lgkmcnt(0)" ::: "memory");
    __syncthreads();
}
__device__ __forceinline__ void p0_prologue(const Args& a, LAS unsigned char* lds, int vcu, int G, int wave, int lane, int tid) {
    unsigned char* ws = a.ws;
    bf16_t* wt = (bf16_t*)(ws + WS_WT);
    LAS float* scr = (LAS float*)(lds + wave * 16384);
    const int gw = vcu * NWAVES + wave, NGW = G * NWAVES;
    constexpr int I_IN = 16 * 160, I_A = 8 * 32, I_O = 16 * 32, I_CQ = 16 * 8, I_CKV = 16 * 16, I_CO = 4 * 32, I_E1 = 16 * 32, I_E2 = 8 * 32;
    constexpr int NITEMS = I_IN + 2 * I_A + I_O + I_CQ + I_CKV + I_CO;
    if ((REP_PHASE) >= 60 && (REP_PHASE) < 70) { __syncthreads(); if (tid == 0) ((unsigned long long*)(ws + WS_CTL + 65536))[(16 + 0) * 256 + blockIdx.x] = __builtin_amdgcn_s_memrealtime(); }
    {
        f32x4 va[16], vb[16];
        int it = vcu; SlabItem cur = slab_item(a, wt, it < 1536 ? it : 0);
        if (it < 1536) slab_load(cur, va, tid);
        for (; it < 1536; it += G) {
            const int itn = it + G; const bool hn = itn < 1536; SlabItem nxt = slab_item(a, wt, hn ? itn : 0);
            if (hn) slab_load(nxt, vb, tid);
            slab_store_f8(cur, va, (LAS float*)lds, tid);
#pragma unroll
            for (int i = 0; i < 16; ++i) va[i] = vb[i];
            cur = nxt;
        }
    }
    if ((REP_PHASE) >= 60 && (REP_PHASE) < 70) { __syncthreads(); if (tid == 0) ((unsigned long long*)(ws + WS_CTL + 65536))[(16 + 1) * 256 + blockIdx.x] = __builtin_amdgcn_s_memrealtime(); }
    for (int it = vcu; it < 256; it += G) {
        int r = it; LAS float* sl = (LAS float*)lds;
        if (r < 160) { p0_slab_bf16<true>(a.in[4], INW, (r % 20) * 256, (r / 20) * 128, wt + WT_IN, 1024, nullptr, sl, tid); continue; } r -= 160;
        if (r < 16) { p0_slab_bf16<false>(a.in[6], 1024, (r & 3) * 256, (r >> 2) * 128, wt + WT_A, 512, nullptr, sl, tid); continue; } r -= 16;
        if (r < 16) { p0_slab_bf16<false>(a.in[7], 1024, (r & 3) * 256, (r >> 2) * 128, wt + WT_B, 512, nullptr, sl, tid); continue; } r -= 16;
        if (r < 32) { p0_slab_bf16<false>(a.in[8], 1024, (r & 3) * 256, (r >> 2) * 128, wt + WT_O, 1024, nullptr, sl, tid); continue; } r -= 32;
        if (r < 8) { p0_slab_bf16<false>(a.in[16], 256, 0, r * 128, wt + WT_CQ, 1024, a.in[14], sl, tid); continue; } r -= 8;
        if (r < 16) { p0_slab_bf16<false>(a.in[17], 512, (r & 1) * 256, (r >> 1) * 128, wt + WT_CKV, 1024, nullptr, sl, tid); continue; } r -= 16;
        p0_slab_bf16<false>(a.in[18], 1024, (r & 3) * 256, (r >> 2) * 128, wt + WT_CO, 256, nullptr, sl, tid);
    }
    if ((REP_PHASE) >= 60 && (REP_PHASE) < 70) { __syncthreads(); if (tid == 0) ((unsigned long long*)(ws + WS_CTL + 65536))[(16 + 2) * 256 + blockIdx.x] = __builtin_amdgcn_s_memrealtime(); }
    {
        const float* w_in = a.in[4]; const float* x = a.in[0]; const float* g = a.in[3]; const float* bfg = a.in[5];
        bf16_t* xn = (bf16_t*)(ws + WS_R1); float* logf = (float*)(ws + WS_LOGF); unsigned char* xn8 = ws + WS_XN8;
        float wf[16][8]; f32x4 gg[4];
#pragma unroll
        for (int j = 0; j < 4; ++j) { const int c = (lane + 64 * j) * 4; gg[j] = *(const f32x4*)(g + c);
#pragma unroll
            for (int q = 0; q < 4; ++q) { const f32x4 w0 = *(const f32x4*)(w_in + (size_t)(c + q) * INW + 1536), w1 = *(const f32x4*)(w_in + (size_t)(c + q) * INW + 1540);
                wf[j * 4 + q][0] = w0[0]; wf[j * 4 + q][1] = w0[1]; wf[j * 4 + q][2] = w0[2]; wf[j * 4 + q][3] = w0[3]; wf[j * 4 + q][4] = w1[0]; wf[j * 4 + q][5] = w1[1]; wf[j * 4 + q][6] = w1[2]; wf[j * 4 + q][7] = w1[3]; } }
        float bb[8];
#pragma unroll
        for (int h = 0; h < 8; ++h) bb[h] = bfg[h];
        const int hsel = ((lane >> 5) & 1) * 4 + ((lane >> 4) & 1) * 2 + ((lane >> 3) & 1);
        for (int rq_ = 0; rq_ < ((REP_PHASE) == 31 ? 2 : 1); ++rq_)
        for (int base = gw; base < T_; base += 4 * NGW) {
            f32x4 v[4][4];
#pragma unroll
            for (int q4 = 0; q4 < 4; ++q4) { const int row = base + q4 * NGW; if (row < T_) { const f32x4* xr = (const f32x4*)(x + (size_t)row * D_);
#pragma unroll
                for (int j = 0; j < 4; ++j) v[q4][j] = xr[lane + 64 * j]; } }
#pragma unroll
            for (int q4 = 0; q4 < 4; ++q4) { const int row = base + q4 * NGW; if (row < T_) {
                float ss = 0.f;
#pragma unroll
                for (int j = 0; j < 4; ++j) ss += v[q4][j][0] * v[q4][j][0] + v[q4][j][1] * v[q4][j][1] + v[q4][j][2] * v[q4][j][2] + v[q4][j][3] * v[q4][j][3];
                ss = wave_sum_dpp(ss);
                const float rstd = rsqrtf(ss * (1.f / D_) + 1e-6f);
                float fl[8];
#pragma unroll
                for (int h = 0; h < 8; ++h) fl[h] = 0.f;
#pragma unroll
                for (int j = 0; j < 4; ++j) {
                    const int c = (lane + 64 * j) * 4;
                    const f32x4 o = v[q4][j] * rstd * gg[j];
                    uint2 pk; pk.x = pg8::cvt_pk_bf16(o[0], o[1]); pk.y = pg8::cvt_pk_bf16(o[2], o[3]);
                    *(uint2*)(xn + (size_t)row * D_ + c) = pk;
#pragma unroll
                    for (int q = 0; q < 4; ++q)
#pragma unroll
                        for (int h = 0; h < 8; ++h) fl[h] += o[q] * wf[j * 4 + q][h];
                }
                float zsel = 0.f;
#pragma unroll
                for (int h = 0; h < 8; ++h) { const float t = wave_sum_dpp(fl[h]) + bb[h]; zsel = (lane == h) ? t : zsel; }
                const float ls = fminf(zsel, 0.f) - log1pf(__expf(-fabsf(zsel)));
                const int b = row / S_, s = row % S_;
                if (lane < 8) logf[((size_t)b * 8 + lane) * S_ + s] = ls;
            } }
        }
    }
    if ((REP_PHASE) >= 60 && (REP_PHASE) < 70) { __syncthreads(); if (tid == 0) ((unsigned long long*)(ws + WS_CTL + 65536))[(16 + 3) * 256 + blockIdx.x] = __builtin_amdgcn_s_memrealtime(); }
    {
        const float* x = a.in[1]; const float* g = a.in[15]; bf16_t* mn = (bf16_t*)(ws + WS_MEMN);
        for (int row = gw; row < B_ * MEML; row += NGW) {
            const f32x4* xr = (const f32x4*)(x + (size_t)row * D_);
            f32x4 v[4]; float ss = 0.f;
#pragma unroll
            for (int j = 0; j < 4; ++j) { v[j] = xr[lane + 64 * j]; ss += v[j][0] * v[j][0] + v[j][1] * v[j][1] + v[j][2] * v[j][2] + v[j][3] * v[j][3]; }
            ss = wave_sum(ss);
            const float rstd = rsqrtf(ss * (1.f / D_) + 1e-6f);
#pragma unroll
            for (int j = 0; j < 4; ++j) { const int c = (lane + 64 * j) * 4; const f32x4 o = v[j] * rstd * *(const f32x4*)(g + c);
                uint2 pk; pk.x = pg8::cvt_pk_bf16(o[0], o[1]); pk.y = pg8::cvt_pk_bf16(o[2], o[3]); *(uint2*)(mn + (size_t)row * D_ + c) = pk; }
        }
    }
    if ((REP_PHASE) >= 60 && (REP_PHASE) < 70) { __syncthreads(); if (tid == 0) ((unsigned long long*)(ws + WS_CTL + 65536))[(16 + 4) * 256 + blockIdx.x] = __builtin_amdgcn_s_memrealtime(); }
    {
        bf16_t* wrh = (bf16_t*)(ws + (size_t)116 * MiB); bf16_t* wrl = wrh + 48 * 1024;
        const int gt = gw * 64 + lane, NGT = NGW * 64;
        for (int i = gt; i < 48 * 1024; i += NGT) { const int o = i >> 10, k = i & 1023;
            const float w = (o < 4 ? a.in[20][k * 4 + o] : (o < 36 ? a.in[22][k * 32 + o - 4] : 0.f)) * a.in[19][k];
            const bf16_t h = f2bf(w); wrh[i] = h; wrl[i] = f2bf(w - bf2f(h)); }
    }
    if ((REP_PHASE) >= 60 && (REP_PHASE) < 70) { __syncthreads(); if (tid == 0) ((unsigned long long*)(ws + WS_CTL + 65536))[(16 + 5) * 256 + blockIdx.x] = __builtin_amdgcn_s_memrealtime(); }
    {
        const int* pos = (const int*)a.in[2]; float* tab = (float*)(ws + WS_ROPE);
        const int gt = gw * 64 + lane, NGT = NGW * 64;
        for (int i = gt; i < T_ * 32; i += NGT) {
            const int f = i & 31, r = i >> 5;
            const float inv = exp2f(-(float)f * (2.0f / 64.0f) * 13.287712379549449f);
            const float ang = (float)pos[r] * inv;
            float sn, cs; sincosf(ang, &sn, &cs);
            *(float2*)(tab + (size_t)i * 2) = make_float2(cs, sn);
        }
    }
    if ((REP_PHASE) >= 60 && (REP_PHASE) < 70) { __syncthreads(); if (tid == 0) ((unsigned long long*)(ws + WS_CTL + 65536))[(16 + 6) * 256 + blockIdx.x] = __builtin_amdgcn_s_memrealtime(); }
}

__device__ __forceinline__ void p1_cumsum(float* c, bf16_t* kaug, int bh, LAS float* part, int tid) {
    float* p = c + (size_t)bh * S_ + tid * 8;
    float v[8]; float s = 0.f;
    const f32x4 a0 = *(const f32x4*)p, a1 = *(const f32x4*)(p + 4);
    const float in[8] = {a0[0], a0[1], a0[2], a0[3], a1[0], a1[1], a1[2], a1[3]};
#pragma unroll
    for (int i = 0; i < 8; ++i) { s += in[i]; v[i] = s; }
    part[tid] = s; __syncthreads();
    float pre = 0.f;
    for (int i = 0; i < tid; ++i) pre += part[i];
    __syncthreads();
#pragma unroll
    for (int i = 0; i < 8; ++i) {
        const float cv = v[i] + pre; p[i] = cv;
        const float bia = -cv * LOG2E;
        const bf16_t h0 = f2bf(bia); const float r1 = bia - bf2f(h0); const bf16_t h1 = f2bf(r1); const float r2 = r1 - bf2f(h1); const bf16_t h2 = f2bf(r2);
        uint2 pk; pk.x = (unsigned)h0 | ((unsigned)h1 << 16); pk.y = (unsigned)h2;
        *(uint2*)(kaug + ((size_t)bh * S_ + tid * 8 + i) * 4) = pk;
    }
}

struct EpiIn {
    static constexpr bool PERM = true, HAS_MID = false, HAS_PF = false, HAS_PROF = false;
    bf16_t *fq, *fk, *fv, *dq, *dk, *dv, *sig; const float* rope;
    __device__ __forceinline__ void operator()(const f32x4 (&acc)[2][2][4][2], const pg8::Unit& u, int wr, int wc, int fr_, int fq_) const {
        int fr = fr_; asm volatile("" : "+v"(fr));
        const int row0 = u.pm * 256 + wr * 64 + fr; const int pn = u.pn;
        if (pn >= 6 && pn < 10) {
            bf16_t* base = pn < 8 ? dq : dk; const float sc = pn < 8 ? C2 : 1.f; const int tl = (pn - 6) & 1;
            const int colL = (tl * 4 + wc) * 64 + 8 * fq_;
#pragma unroll
            for (int ai = 0; ai < 2; ++ai)
#pragma unroll
                for (int m = 0; m < 4; ++m) {
                    const int row = row0 + ai * 128 + m * 16;
                    const f32x4* tb = (const f32x4*)(rope + ((size_t)row * 32 + 8 * fq_) * 2);
                    const f32x4 t0 = tb[0], t1 = tb[1], t2 = tb[2], t3 = tb[3];
                    const float cs[8] = {t0[0], t0[2], t1[0], t1[2], t2[0], t2[2], t3[0], t3[2]}, sn[8] = {t0[1], t0[3], t1[1], t1[3], t2[1], t2[3], t3[1], t3[3]};
                    const float x1[8] = {acc[ai][0][m][0][0], acc[ai][0][m][0][1], acc[ai][0][m][0][2], acc[ai][0][m][0][3], acc[ai][0][m][1][0], acc[ai][0][m][1][1], acc[ai][0][m][1][2], acc[ai][0][m][1][3]};
                    const float x2[8] = {acc[ai][1][m][0][0], acc[ai][1][m][0][1], acc[ai][1][m][0][2], acc[ai][1][m][0][3], acc[ai][1][m][1][0], acc[ai][1][m][1][1], acc[ai][1][m][1][2], acc[ai][1][m][1][3]};
                    float o1[8], o2[8];
#pragma unroll
                    for (int j = 0; j < 8; ++j) { o1[j] = (x1[j] * cs[j] - x2[j] * sn[j]) * sc; o2[j] = (x2[j] * cs[j] + x1[j] * sn[j]) * sc; }
                    u32x4 w1, w2;
                    w1.x = pg8::cvt_pk_bf16(o1[0], o1[1]); w1.y = pg8::cvt_pk_bf16(o1[2], o1[3]); w1.z = pg8::cvt_pk_bf16(o1[4], o1[5]); w1.w = pg8::cvt_pk_bf16(o1[6], o1[7]);
                    w2.x = pg8::cvt_pk_bf16(o2[0], o2[1]); w2.y = pg8::cvt_pk_bf16(o2[2], o2[3]); w2.z = pg8::cvt_pk_bf16(o2[4], o2[5]); w2.w = pg8::cvt_pk_bf16(o2[6], o2[7]);
                    bf16_t* rp = base + (size_t)row * 512 + colL;
                    *(u32x4*)rp = w1; *(u32x4*)(rp + 32) = w2;
                }
        } else {
            bf16_t* base; int ld, colt; float sc = 1.f; bool sg = false;
            if (pn < 2) { base = fq; ld = 512; colt = pn * 256; sc = C2; }
            else if (pn < 4) { base = fk; ld = 512; colt = (pn - 2) * 256; }
            else if (pn < 6) { base = fv; ld = 512; colt = (pn - 4) * 256; }
            else if (pn < 12) { base = dv; ld = 512; colt = (pn - 10) * 256; }
            else { base = sig; ld = 2048; colt = (pn - 12) * 256; sg = true; }
            const int col0 = colt + wc * 32 + 8 * fq_;
#pragma unroll
            for (int ai = 0; ai < 2; ++ai)
#pragma unroll
                for (int m = 0; m < 4; ++m) { bf16_t* rowp = base + (size_t)(row0 + ai * 128 + m * 16) * ld + col0;
#pragma unroll
                    for (int bj = 0; bj < 2; ++bj) { f32x4 v0 = acc[ai][bj][m][0], v1 = acc[ai][bj][m][1];
                        if (sg) {
#pragma unroll
                            for (int q = 0; q < 4; ++q) { v0[q] = __builtin_amdgcn_rcpf(1.f + __expf(-v0[q])); v1[q] = __builtin_amdgcn_rcpf(1.f + __expf(-v1[q])); } }
                        else { v0 = v0 * sc; v1 = v1 * sc; }
                        u32x4 w; w.x = pg8::cvt_pk_bf16(v0[0], v0[1]); w.y = pg8::cvt_pk_bf16(v0[2], v0[3]); w.z = pg8::cvt_pk_bf16(v1[0], v1[1]); w.w = pg8::cvt_pk_bf16(v1[2], v1[3]);
                        *(u32x4*)(rowp + bj * 128) = w; } }
        }
    }
};
struct EpiGate8 {
    static constexpr bool PERM = true, HAS_MID = false, HAS_PF = false, HAS_PROF = false;
    bf16_t* sig;
    __device__ __forceinline__ void operator()(const f32x4 (&acc)[2][2][4][2], const pg8::Unit& u, int wr, int wc, int fr_, int fq_) const {
        int fr = fr_; asm volatile("" : "+v"(fr));
        const int row0 = u.pm * 256 + wr * 64 + fr; const int col0 = u.pn * 256 + wc * 32 + 8 * fq_;
#pragma unroll
        for (int ai = 0; ai < 2; ++ai)
#pragma unroll
            for (int m = 0; m < 4; ++m) { bf16_t* rowp = sig + (size_t)(row0 + ai * 128 + m * 16) * 2048 + col0;
#pragma unroll
                for (int bj = 0; bj < 2; ++bj) { f32x4 v0 = acc[ai][bj][m][0], v1 = acc[ai][bj][m][1];
#pragma unroll
                    for (int q = 0; q < 4; ++q) { v0[q] = __builtin_amdgcn_rcpf(1.f + __expf(v0[q] * (-1.f / WSCALE))); v1[q] = __builtin_amdgcn_rcpf(1.f + __expf(v1[q] * (-1.f / WSCALE))); }
                    u32x4 w; w.x = pg8::cvt_pk_bf16(v0[0], v0[1]); w.y = pg8::cvt_pk_bf16(v0[2], v0[3]); w.z = pg8::cvt_pk_bf16(v1[0], v1[1]); w.w = pg8::cvt_pk_bf16(v1[2], v1[3]);
                    *(u32x4*)(rowp + bj * 128) = w; } }
    }
};
struct EpiBf {
    static constexpr bool PERM = true, HAS_MID = false, HAS_PF = false, HAS_PROF = false;
    bf16_t* O; int ldc; float sc;
    __device__ __forceinline__ void operator()(const f32x4 (&acc)[2][2][4][2], const pg8::Unit& u, int wr, int wc, int fr_, int fq_) const {
        int fr = fr_; asm volatile("" : "+v"(fr));
        const int row0 = u.pm * 256 + wr * 64 + fr; const int col0 = u.pn * 256 + wc * 32 + 8 * fq_;
#pragma unroll
        for (int ai = 0; ai < 2; ++ai)
#pragma unroll
            for (int m = 0; m < 4; ++m) { bf16_t* rowp = O + (size_t)(row0 + ai * 128 + m * 16) * ldc + col0;
#pragma unroll
                for (int bj = 0; bj < 2; ++bj) { const f32x4 v0 = acc[ai][bj][m][0] * sc, v1 = acc[ai][bj][m][1] * sc;
                    u32x4 w; w.x = pg8::cvt_pk_bf16(v0[0], v0[1]); w.y = pg8::cvt_pk_bf16(v0[2], v0[3]); w.z = pg8::cvt_pk_bf16(v1[0], v1[1]); w.w = pg8::cvt_pk_bf16(v1[2], v1[3]);
                    *(u32x4*)(rowp + bj * 128) = w; } }
    }
};

constexpr size_t WS_RT = 116 * MiB;
constexpr size_t WS_LRS = 118 * MiB;
__device__ __forceinline__ float shx(float v, int mask, int lane) { return __int_as_float(__builtin_amdgcn_ds_bpermute((lane ^ mask) << 2, __float_as_int(v))); }
__device__ __forceinline__ float wave_sum_l(float v, int lane) {
#pragma unroll
    for (int o = 1; o < 64; o <<= 1) v += shx(v, o, lane);
    return v;
}
__device__ __forceinline__ void wg_fence() {
    asm volatile("s_waitcnt vmcnt(0) lgkmcnt(0)" ::: "memory");
    __builtin_amdgcn_fence(__ATOMIC_ACQUIRE, "agent");
    __syncthreads();
}
__device__ __forceinline__ float bflo(unsigned w) { return __uint_as_float(w << 16); }
__device__ __forceinline__ float bfhi(unsigned w) { return __uint_as_float(w & 0xffff0000u); }
#define EPI_FENCE() asm volatile("" ::: "memory")
__device__ __forceinline__ void pf_touch(const void* p, unsigned& sink) { asm volatile("global_load_dword %0, %1, off" : "+v"(sink) : "v"(p) : "memory"); }
template <bool SECOND> struct EpiGate {
    static constexpr bool PERM = true, HAS_MID = false, HAS_PF = false, HAS_PROF = false;
    const bf16_t* sig; bf16_t* merged;
    __device__ __forceinline__ void operator()(const f32x4 (&acc)[2][2][4][2], const pg8::Unit& u, int wr, int wc, int fr_, int fq_) const {
        int fr = fr_; asm volatile("" : "+v"(fr));
        const int row0 = u.pm * 256 + wr * 64 + fr; const int col0 = u.pn * 256 + wc * 32 + 8 * fq_;
        u32x4 sgb[4][2], mob[4][2];
#define EG_LOAD(g, s) do { const size_t row_ = (size_t)(row0 + ((g) >> 2) * 128 + ((g) & 3) * 16); _Pragma("unroll") for (int bj = 0; bj < 2; ++bj) { \
            sgb[s][bj] = *(const u32x4*)(sig + row_ * 2048 + (SECOND ? 1024 : 0) + col0 + bj * 128); if (SECOND) mob[s][bj] = *(const u32x4*)(merged + row_ * 1024 + col0 + bj * 128); } } while (0)
        EG_LOAD(0, 0); EG_LOAD(1, 1); EG_LOAD(2, 2);
#pragma unroll
        for (int g = 0; g < 8; ++g) {
            const int s = g & 3, ai = g >> 2, m = g & 3;
            if (g + 3 < 8) EG_LOAD(g + 3, (g + 3) & 3);
            EPI_FENCE();
            const size_t row = (size_t)(row0 + ai * 128 + m * 16);
#pragma unroll
            for (int bj = 0; bj < 2; ++bj) {
                const f32x4 v0 = acc[ai][bj][m][0], v1 = acc[ai][bj][m][1];
                float r[8] = {v0[0], v0[1], v0[2], v0[3], v1[0], v1[1], v1[2], v1[3]};
                const unsigned sw[4] = {sgb[s][bj].x, sgb[s][bj].y, sgb[s][bj].z, sgb[s][bj].w};
#pragma unroll
                for (int q = 0; q < 4; ++q) { r[2 * q] *= bflo(sw[q]); r[2 * q + 1] *= bfhi(sw[q]); }
                if (SECOND) { const unsigned mw[4] = {mob[s][bj].x, mob[s][bj].y, mob[s][bj].z, mob[s][bj].w};
#pragma unroll
                    for (int q = 0; q < 4; ++q) { r[2 * q] += bflo(mw[q]); r[2 * q + 1] += bfhi(mw[q]); } }
                u32x4 w; w.x = pg8::cvt_pk_bf16(r[0], r[1]); w.y = pg8::cvt_pk_bf16(r[2], r[3]); w.z = pg8::cvt_pk_bf16(r[4], r[5]); w.w = pg8::cvt_pk_bf16(r[6], r[7]);
                *(u32x4*)(merged + row * 1024 + col0 + bj * 128) = w; }
            EPI_FENCE();
        }
#undef EG_LOAD
    }
};
template <bool BASE_BF16, bool Q8 = BASE_BF16> struct EpiRes {
    static constexpr bool PERM = true, HAS_MID = false, HAS_PF = false, HAS_PROF = true;
    const void* base; bf16_t* xo; LAS float* stats; unsigned char* q8;
    unsigned long long* prof;
    __device__ __forceinline__ void operator()(const f32x4 (&acc)[2][2][4][2], const pg8::Unit& u, int wr, int wc, int fr_, int fq_) const {
        const unsigned long long t0_ = prof ? __builtin_amdgcn_s_memrealtime() : 0ull;
        int fr = fr_; asm volatile("" : "+v"(fr));
        const int col0 = u.pn * 256 + wc * 32 + 8 * fq_; const int rl0 = wr * 64 + fr;
        f32x4 fb[4][2][2]; u32x4 hb[4][2];
#define ER_LOAD(g, s) do { const size_t row_ = (size_t)(u.pm * 256 + rl0 + ((g) >> 2) * 128 + ((g) & 3) * 16); _Pragma("unroll") for (int bj = 0; bj < 2; ++bj) { \
            if (BASE_BF16) hb[s][bj] = *(const u32x4*)((const bf16_t*)base + row_ * 2048 + col0 + bj * 128); \
            else { const float* p_ = (const float*)base + row_ * 1024 + col0 + bj * 128; fb[s][bj][0] = *(const f32x4*)p_; fb[s][bj][1] = *(const f32x4*)(p_ + 4); } } } while (0)
        ER_LOAD(0, 0); ER_LOAD(1, 1); ER_LOAD(2, 2);
#pragma unroll
        for (int g = 0; g < 8; ++g) {
            const int s = g & 3, ai = g >> 2, m = g & 3;
            if (g + 3 < 8) ER_LOAD(g + 3, (g + 3) & 3);
            EPI_FENCE();
            const int rl = rl0 + ai * 128 + m * 16; const size_t row = (size_t)(u.pm * 256 + rl); float ss = 0.f;
#pragma unroll
            for (int bj = 0; bj < 2; ++bj) {
                f32x4 o0, o1;
                if (BASE_BF16) { const u32x4 h = hb[s][bj]; o0 = (f32x4){bflo(h.x), bfhi(h.x), bflo(h.y), bfhi(h.y)}; o1 = (f32x4){bflo(h.z), bfhi(h.z), bflo(h.w), bfhi(h.w)}; }
                else { o0 = fb[s][bj][0]; o1 = fb[s][bj][1]; }
                o0 = o0 + acc[ai][bj][m][0]; o1 = o1 + acc[ai][bj][m][1];
                ss += (o0[0] * o0[0] + o0[1] * o0[1]) + (o0[2] * o0[2] + o0[3] * o0[3]) + (o1[0] * o1[0] + o1[1] * o1[1]) + (o1[2] * o1[2] + o1[3] * o1[3]);
                u32x4 w; w.x = pg8::cvt_pk_bf16(o0[0], o0[1]); w.y = pg8::cvt_pk_bf16(o0[2], o0[3]); w.z = pg8::cvt_pk_bf16(o1[0], o1[1]); w.w = pg8::cvt_pk_bf16(o1[2], o1[3]);
                *(u32x4*)(xo + row * 2048 + col0 + bj * 128) = w;
                if constexpr (Q8) { unsigned q0 = 0u, q1 = 0u;
#define CL8(v) __builtin_amdgcn_fmed3f((v), -448.f, 448.f)
                    q0 = __builtin_amdgcn_cvt_pk_fp8_f32(CL8(o0[0]), CL8(o0[1]), q0, false); q0 = __builtin_amdgcn_cvt_pk_fp8_f32(CL8(o0[2]), CL8(o0[3]), q0, true);
                    q1 = __builtin_amdgcn_cvt_pk_fp8_f32(CL8(o1[0]), CL8(o1[1]), q1, false); q1 = __builtin_amdgcn_cvt_pk_fp8_f32(CL8(o1[2]), CL8(o1[3]), q1, true);
                    *(uint2*)(q8 + row * 2048 + col0 + bj * 128) = make_uint2(q0, q1); } }
            ss += shx(ss, 16, fq_ * 16 + fr); ss += shx(ss, 32, fq_ * 16 + fr);
            if (fq_ == 0) stats[(u.pn * 256 + rl) * 4 + wc] = ss;
            EPI_FENCE();
        }
#undef ER_LOAD
        if (prof && threadIdx.x == 0) atomicAdd(prof, __builtin_amdgcn_s_memrealtime() - t0_);
    }
};
__device__ __forceinline__ float row_rstd(const LAS float* stats, int rl, float eps) {
    float s = 0.f;
#pragma unroll
    for (int pn = 0; pn < 4; ++pn) { const f32x4 v = *(const LAS f32x4*)(stats + (pn * 256 + rl) * 4); s += (v[0] + v[1]) + (v[2] + v[3]); }
    return rsqrtf(s * (1.f / 1024.f) + eps);
}
struct EpiQ {
    static constexpr bool PERM = true, HAS_MID = false, HAS_PF = false, HAS_PROF = false;
    bf16_t* O; int ldc; float sc; const LAS float* stats;
    __device__ __forceinline__ void operator()(const f32x4 (&acc)[2][2][4][2], const pg8::Unit& u, int wr, int wc, int fr_, int fq_) const {
        int fr = fr_; asm volatile("" : "+v"(fr));
        const int col0 = u.pn * 256 + wc * 32 + 8 * fq_;
#pragma unroll
        for (int ai = 0; ai < 2; ++ai)
#pragma unroll
            for (int m = 0; m < 4; ++m) { const int rl = ai * 128 + wr * 64 + m * 16 + fr; const float rs = row_rstd(stats, rl, 1e-6f) * sc;
                bf16_t* rowp = O + (size_t)(u.pm * 256 + rl) * ldc + col0;
#pragma unroll
                for (int bj = 0; bj < 2; ++bj) { const f32x4 v0 = acc[ai][bj][m][0] * rs, v1 = acc[ai][bj][m][1] * rs;
                    u32x4 w; w.x = pg8::cvt_pk_bf16(v0[0], v0[1]); w.y = pg8::cvt_pk_bf16(v0[2], v0[3]); w.z = pg8::cvt_pk_bf16(v1[0], v1[1]); w.w = pg8::cvt_pk_bf16(v1[2], v1[3]);
                    *(u32x4*)(rowp + bj * 128) = w; } }
    }
};
__device__ __forceinline__ void c0_diffcomb(const Args& a, unsigned char* ws, int panel, int wave, int lane_) {
    int lane = lane_; asm volatile("" : "+v"(lane));
    const bf16_t* od = (const bf16_t*)(ws + WS_OD); bf16_t* y = (bf16_t*)(ws + WS_Y);
    const float lam = __expf(wave_sum_l(a.in[9][lane] * a.in[10][lane], lane)) - __expf(wave_sum_l(a.in[11][lane] * a.in[12][lane], lane)) + 0.2f;
    const int h = lane >> 4, d0 = (lane & 15) * 8;
    float gs[8];
#pragma unroll
    for (int i = 0; i < 8; ++i) gs[i] = a.in[13][d0 + i] * 0.8f;
#pragma unroll 1
    for (int r0 = 0; r0 < 32; r0 += 16) {
        u32x4 pav[16], pbv[16];
#pragma unroll
        for (int r = 0; r < 16; ++r) { const size_t row = (size_t)panel * 256 + wave * 32 + r0 + r;
            pav[r] = *(const u32x4*)(od + row * 1024 + (h * 2 + 0) * 128 + d0); pbv[r] = *(const u32x4*)(od + row * 1024 + (h * 2 + 1) * 128 + d0); }
#pragma unroll
        for (int r = 0; r < 16; ++r) { const size_t row = (size_t)panel * 256 + wave * 32 + r0 + r;
            const unsigned aw[4] = {pav[r].x, pav[r].y, pav[r].z, pav[r].w}, bw[4] = {pbv[r].x, pbv[r].y, pbv[r].z, pbv[r].w};
            float v[8]; float ss = 0.f;
#pragma unroll
            for (int q = 0; q < 4; ++q) { v[2 * q] = bflo(aw[q]) - lam * bflo(bw[q]); v[2 * q + 1] = bfhi(aw[q]) - lam * bfhi(bw[q]); }
#pragma unroll
            for (int i = 0; i < 8; ++i) ss += v[i] * v[i];
            ss += shx(ss, 1, lane); ss += shx(ss, 2, lane); ss += shx(ss, 4, lane); ss += shx(ss, 8, lane);
            const float rstd = rsqrtf(ss * (1.f / 128.f) + 1e-5f);
            u32x4 w; w.x = pg8::cvt_pk_bf16(v[0] * rstd * gs[0], v[1] * rstd * gs[1]); w.y = pg8::cvt_pk_bf16(v[2] * rstd * gs[2], v[3] * rstd * gs[3]);
            w.z = pg8::cvt_pk_bf16(v[4] * rstd * gs[4], v[5] * rstd * gs[5]); w.w = pg8::cvt_pk_bf16(v[6] * rstd * gs[6], v[7] * rstd * gs[7]);
            *(u32x4*)(y + row * 1024 + 512 + h * 128 + d0) = w;
        }
    }
}
typedef short bf16x8_t __attribute__((ext_vector_type(8)));
__device__ __forceinline__ void c6_route(const Args& a, unsigned char* ws, LAS unsigned char* lds, const LAS float* stats, int panel, int wave, int lane_, int tid_) {
    int lane = lane_, tid = tid_; asm volatile("" : "+v"(lane), "+v"(tid));
    const bf16_t* x2b = (const bf16_t*)a.out + 1024;
    const bf16_t* wrh = (const bf16_t*)(ws + WS_RT); const bf16_t* wrl = wrh + 48 * 1024;
    LAS float* lg = (LAS float*)(lds + wave * 6144);
    LAS unsigned* hist = (LAS unsigned*)(lds + 49152);
    const int fr = lane & 15, fq = lane >> 4;
    f32x4 acc[2][3];
#pragma unroll
    for (int rb = 0; rb < 2; ++rb)
#pragma unroll
        for (int ob = 0; ob < 3; ++ob) acc[rb][ob] = (f32x4){0.f, 0.f, 0.f, 0.f};
    const size_t rowb = (size_t)panel * 256 + wave * 32;
    constexpr int WP = 1040, WHL = 48 * WP;
#pragma unroll 1
    for (int c = 0; c < 2; ++c) {
        u32x4 wv[12];
#pragma unroll
        for (int i = 0; i < 12; ++i) { const int p = tid + 512 * i; const int hl = p >= 3072 ? 1 : 0, q = p - hl * 3072; const int row = q >> 6, pc = q & 63;
            wv[i] = *(const u32x4*)((hl ? wrl : wrh) + (size_t)row * 1024 + c * 512 + pc * 8); }
        bf16x8_t xv[2][16];
#pragma unroll
        for (int rb = 0; rb < 2; ++rb)
#pragma unroll
            for (int s = 0; s < 16; ++s) xv[rb][s] = *(const bf16x8_t*)(x2b + (rowb + rb * 16 + fr) * 2048 + c * 512 + s * 32 + 8 * fq);
        if (c > 0) __syncthreads();
#pragma unroll
        for (int i = 0; i < 12; ++i) { const int p = tid + 512 * i; const int hl = p >= 3072 ? 1 : 0, q = p - hl * 3072; const int row = q >> 6, pc = q & 63;
            *(LAS u32x4*)(lds + hl * WHL + row * WP + pc * 16) = wv[i]; }
        asm volatile("s_waitcnt lgkmcnt(0)" ::: "memory");
        __syncthreads();
#pragma unroll
        for (int s = 0; s < 16; ++s) {
#pragma unroll
            for (int ob = 0; ob < 3; ++ob) {
                const bf16x8_t wh = *(const LAS bf16x8_t*)(lds + (ob * 16 + fr) * WP + (s * 32 + 8 * fq) * 2), wl = *(const LAS bf16x8_t*)(lds + WHL + (ob * 16 + fr) * WP + (s * 32 + 8 * fq) * 2);
#pragma unroll
                for (int rb = 0; rb < 2; ++rb) {
                    acc[rb][ob] = __builtin_amdgcn_mfma_f32_16x16x32_bf16(wh, xv[rb][s], acc[rb][ob], 0, 0, 0);
                    acc[rb][ob] = __builtin_amdgcn_mfma_f32_16x16x32_bf16(wl, xv[rb][s], acc[rb][ob], 0, 0, 0);
                }
            }
        }
    }
    asm volatile("s_waitcnt lgkmcnt(0)" ::: "memory");
    __syncthreads();
    if (tid < 64) hist[tid] = 0u;
#pragma unroll
    for (int rb = 0; rb < 2; ++rb) { const float rs = row_rstd(stats, wave * 32 + rb * 16 + fr, 1e-6f);
#pragma unroll
        for (int ob = 0; ob < 3; ++ob) *(LAS f32x4*)(lg + (rb * 16 + fr) * 48 + ob * 16 + 4 * fq) = acc[rb][ob] * rs; }
    asm volatile("s_waitcnt lgkmcnt(0)" ::: "memory");
    __syncthreads();
    int ex0 = 0, ex1 = 0; float w0 = 0.f, w1 = 0.f; unsigned rk0 = 0, rk1 = 0;
    if (lane < 32) {
        const LAS float* lr = lg + lane * 48;
        float l4[4], le[32];
#pragma unroll
        for (int i = 0; i < 4; ++i) l4[i] = lr[i] + a.in[21][i];
#pragma unroll
        for (int i = 0; i < 32; ++i) le[i] = lr[4 + i] + a.in[23][i];
        int gs = 0; float gm = l4[0];
#pragma unroll
        for (int i = 1; i < 4; ++i) if (l4[i] > gm) { gm = l4[i]; gs = i; }
        float gsum = 0.f;
#pragma unroll
        for (int i = 0; i < 4; ++i) gsum += __expf(l4[i] - gm);
        const float gw = 1.f / gsum;
        float sl[8];
#pragma unroll
        for (int e = 0; e < 8; ++e) { sl[e] = le[e];
#pragma unroll
            for (int gq = 1; gq < 4; ++gq) if (gs == gq) sl[e] = le[gq * 8 + e]; }
        int i0 = 0; float v0 = sl[0];
#pragma unroll
        for (int e = 1; e < 8; ++e) if (sl[e] > v0) { v0 = sl[e]; i0 = e; }
        int i1 = -1; float v1 = -INFINITY;
#pragma unroll
        for (int e = 0; e < 8; ++e) if (e != i0 && sl[e] > v1) { v1 = sl[e]; i1 = e; }
        const float e1 = __expf(v1 - v0); w0 = gw / (1.f + e1); w1 = gw * e1 / (1.f + e1);
        ex0 = gs * 8 + i0; ex1 = gs * 8 + i1;
        rk0 = __hip_atomic_fetch_add(hist + ex0, 1u, __ATOMIC_RELAXED, __HIP_MEMORY_SCOPE_WORKGROUP); rk1 = __hip_atomic_fetch_add(hist + ex1, 1u, __ATOMIC_RELAXED, __HIP_MEMORY_SCOPE_WORKGROUP);
    }
    asm volatile("s_waitcnt lgkmcnt(0)" ::: "memory");
    __syncthreads();
    if (tid < 32) { const unsigned c = hist[tid]; hist[32 + tid] = c ? atomicAdd((unsigned*)(ws + WS_CTL) + tid, c) : 0u; }
    asm volatile("s_waitcnt vmcnt(0) lgkmcnt(0)" ::: "memory");
    __syncthreads();
    if (lane < 32) {
        int* ltok = (int*)(ws + WS_LTOK); float* lwp = (float*)(ws + WS_LW); float* lrs = (float*)(ws + WS_LRS);
        const int row = (int)rowb + lane; const float rs2 = row_rstd(stats, wave * 32 + lane, 1e-6f);
        const size_t p0 = (size_t)ex0 * T_ + hist[32 + ex0] + rk0, p1 = (size_t)ex1 * T_ + hist[32 + ex1] + rk1;
        ltok[p0] = row * 2 + 0; lwp[p0] = w0; lrs[p0] = rs2; ltok[p1] = row * 2 + 1; lwp[p1] = w1; lrs[p1] = rs2;
    }
    __syncthreads();
}
__device__ __forceinline__ void p3_chain(const Args& a, LAS unsigned char* lds, unsigned char* lds_raw, int panel, int wave, int lane, int tid) {
    OPAQUE_GLOBAL(ws, a.ws);
    bf16_t* wt = (bf16_t*)(ws + WS_WT);
    LAS float* stats = (LAS float*)(lds + STAT_OFF);
    bf16_t* R1 = (bf16_t*)(ws + WS_R1); const bf16_t* Yp = (const bf16_t*)(ws + WS_Y);
    bf16_t* QC = (bf16_t*)(ws + WS_QC); bf16_t* OC = (bf16_t*)(ws + WS_OC); const bf16_t* MKV = (const bf16_t*)(ws + WS_MKV);
    bf16_t* XB = (bf16_t*)a.out;
    pg8::PanelOrder S4{panel, 4}, S1{panel, 1};
#ifndef REP_PHASE
#define REP_PHASE -1
#endif
#define RP3(k) for (int rp3_ = 0; rp3_ < ((REP_PHASE) == (k) ? 2 : 1); ++rp3_)
#define P3STAMP(i) do { if ((REP_PHASE) >= 90 && (REP_PHASE) < 100 && tid == 0) ((unsigned long long*)(ws + WS_CTL + 65536))[(16 + (i)) * 256 + blockIdx.x] = __builtin_amdgcn_s_memrealtime(); } while (0)
    P3STAMP(0);
    RP3(40) { c0_diffcomb(a, ws, panel, wave, lane);
    wg_fence(); }
    P3STAMP(1);
    RP3(41) {
    { pg8::Gemm g{Yp, wt + WT_A, 1024, 512, 512}; EpiGate<false> E{(const bf16_t*)a.out, R1}; pg8::gemm_phase<EpiGate<false>, pg8::PanelOrder, true>(lds, g, S4, E); }
    { pg8::Gemm g{Yp + 512, wt + WT_B, 1024, 512, 512}; EpiGate<true> E{(const bf16_t*)a.out, R1}; pg8::gemm_phase<EpiGate<true>, pg8::PanelOrder, true>(lds, g, S4, E); }
    wg_fence(); }
    P3STAMP(2);
    RP3(42) {
    { pg8::Gemm g{R1, wt + WT_O, 1024, 1024, 1024}; EpiRes<false> E{(const void*)a.in[0], XB, stats, nullptr, ((REP_PHASE) == 97 || (REP_PHASE) == 89) ? (unsigned long long*)(ws + WS_CTL + 65536) + 30 * 256 + blockIdx.x : nullptr}; pg8::gemm_phase<EpiRes<false>, pg8::PanelOrder, true>(lds, g, S4, E); }
    wg_fence(); }
    P3STAMP(3);
    RP3(43) {
    { pg8::Gemm g{XB, wt + WT_CQ, 2048, 1024, 1024}; EpiQ E{QC, 256, C2, stats}; pg8::gemm_phase<EpiQ, pg8::PanelOrder, true>(lds, g, S1, E); }
    wg_fence(); }
    P3STAMP(4);
    RP3(44) {
    { const int b = panel >> 4; const size_t r0 = (size_t)panel * 256;
      attn_body::cross_panel(QC + r0 * 256, 256, MKV + (size_t)b * 256 * 512, 512, MKV + (size_t)b * 256 * 512 + 256, 512, OC + r0 * 256, 256, (char*)lds_raw); }
    wg_fence(); }
    P3STAMP(5);
    RP3(45) {
    { pg8::Gemm g{OC, wt + WT_CO, 256, 256, 256}; EpiRes<true> E{(const void*)XB, XB + 1024, stats, (unsigned char*)R1, ((REP_PHASE) == 98 || (REP_PHASE) == 99) ? (unsigned long long*)(ws + WS_CTL + 65536) + 30 * 256 + blockIdx.x : nullptr};   pg8::gemm_phase<EpiRes<true>, pg8::PanelOrder, true>(lds, g, S4, E); }
    wg_fence(); }
    P3STAMP(6);
    c6_route(a, ws, lds, stats, panel, wave, lane, tid);
    P3STAMP(7);
}
constexpr int TAB_OFF = MISC_OFF;
template <bool GATHER_> struct GroupOrder {
    static constexpr bool GATHER = GATHER_;
    const LAS unsigned* tab; int NTl, G, c; const int* ltok; const unsigned* counts;
    __device__ bool next(int i, pg8::Unit& u) const {
        const int L = i * G + c; if (L >= NTl * 4) return false;
        const int ct = L & 3, t = L >> 2;     const unsigned w = (unsigned)__builtin_amdgcn_readfirstlane((int)tab[t]);
        u.e = (int)(w & 31u); u.rt = (int)((w >> 5) & 0x7ffu); u.pm = (int)(w >> 16); u.pn = u.e * 4 + ct; return true;
    }
    __device__ __forceinline__ unsigned arow(const pg8::Unit& u, int r) const {
        const unsigned idx = (unsigned)(u.rt * 256 + r); const unsigned cnt = counts[u.e];
        return idx < cnt ? (unsigned)(ltok[(size_t)u.e * T_ + idx] >> 1) : 0u;
    }
};
__device__ __forceinline__ int build_tile_table(const unsigned* counts, LAS unsigned* tab, int tid) {
    if (tid == 0) {
        unsigned nt = 0;
        for (int e = 0; e < 32; ++e) { const unsigned ntl = (counts[e] + 255u) >> 8;
            for (unsigned rt = 0; rt < ntl; ++rt) { tab[nt] = (unsigned)e | (rt << 5) | (nt << 16); ++nt; } }
        tab[600] = nt;
    }
    asm volatile("s_waitcnt vmcnt(0) lgkmcnt(0)" ::: "memory");
    __syncthreads();
    return __builtin_amdgcn_readfirstlane((int)tab[600]);
}
struct EpiE1 {
    static constexpr bool PERM = true, HAS_MID = false, HAS_PF = false, HAS_PROF = false;
    unsigned char* H; const float* lrs; const unsigned* counts;
    __device__ __forceinline__ void operator()(const f32x4 (&acc)[2][2][4][2], const pg8::Unit& u, int wr, int wc, int fr_, int fq_) const {
        int fr = fr_; asm volatile("" : "+v"(fr));
        const int row0 = u.pm * 256 + wr * 64 + fr; const int col0 = (u.pn & 3) * 128 + wc * 32 + 8 * fq_;
        const unsigned cnt = counts[u.e]; float rs[8];
#pragma unroll
        for (int g = 0; g < 8; ++g) { const unsigned idx = (unsigned)(u.rt * 256 + (g >> 2) * 128 + wr * 64 + (g & 3) * 16 + fr); rs[g] = idx < cnt ? lrs[(size_t)u.e * T_ + idx] * (1.f / WSCALE) : 0.f; }
#pragma unroll
        for (int ai = 0; ai < 2; ++ai)
#pragma unroll
            for (int m = 0; m < 4; ++m) { const float s = rs[ai * 4 + m];
                const f32x4 g0 = acc[ai][0][m][0] * s, g1 = acc[ai][0][m][1] * s, u0 = acc[ai][1][m][0] * s, u1 = acc[ai][1][m][1] * s;
                float r[8];
#pragma unroll
                for (int q = 0; q < 4; ++q) { r[q] = g0[q] * __builtin_amdgcn_rcpf(1.f + __expf(-g0[q])) * u0[q]; r[4 + q] = g1[q] * __builtin_amdgcn_rcpf(1.f + __expf(-g1[q])) * u1[q]; }
                unsigned q0 = 0u, q1 = 0u;
                q0 = __builtin_amdgcn_cvt_pk_fp8_f32(CL8(r[0]), CL8(r[1]), q0, false); q0 = __builtin_amdgcn_cvt_pk_fp8_f32(CL8(r[2]), CL8(r[3]), q0, true);
                q1 = __builtin_amdgcn_cvt_pk_fp8_f32(CL8(r[4]), CL8(r[5]), q1, false); q1 = __builtin_amdgcn_cvt_pk_fp8_f32(CL8(r[6]), CL8(r[7]), q1, true);
                *(uint2*)(H + (size_t)(row0 + ai * 128 + m * 16) * 512 + col0) = make_uint2(q0, q1); }
    }
};
struct EpiE2 {
    static constexpr bool PERM = true, HAS_MID = false, HAS_PF = false, HAS_PROF = true;
    bf16_t* ys; const int* ltok; const float* lw; const unsigned* counts;
    unsigned long long* prof;
    __device__ __forceinline__ void operator()(const f32x4 (&acc)[2][2][4][2], const pg8::Unit& u, int wr, int wc, int fr_, int fq_) const {
        const unsigned long long t0_ = prof ? __builtin_amdgcn_s_memrealtime() : 0ull;
        int fr = fr_; asm volatile("" : "+v"(fr));
        const unsigned cnt = counts[u.e]; const int col0 = (u.pn & 3) * 256 + wc * 32 + 8 * fq_;
        int tk[8]; float wg[8];
#pragma unroll
        for (int g = 0; g < 8; ++g) { const unsigned idx = (unsigned)(u.rt * 256 + (g >> 2) * 128 + wr * 64 + (g & 3) * 16 + fr); const size_t li = (size_t)u.e * T_ + idx;
            tk[g] = idx < cnt ? ltok[li] : -1; wg[g] = idx < cnt ? lw[li] * (1.f / WSCALE) : 0.f; }
#pragma unroll
        for (int ai = 0; ai < 2; ++ai)
#pragma unroll
            for (int m = 0; m < 4; ++m) {
                const int tok2 = tk[ai * 4 + m]; const float wgt = wg[ai * 4 + m];
                if (tok2 >= 0) {
                    bf16_t* rowp = ys + (size_t)tok2 * 1024 + col0;
#pragma unroll
                    for (int bj = 0; bj < 2; ++bj) { const f32x4 v0 = acc[ai][bj][m][0] * wgt, v1 = acc[ai][bj][m][1] * wgt;
                        u32x4 w; w.x = pg8::cvt_pk_bf16(v0[0], v0[1]); w.y = pg8::cvt_pk_bf16(v0[2], v0[3]); w.z = pg8::cvt_pk_bf16(v1[0], v1[1]); w.w = pg8::cvt_pk_bf16(v1[2], v1[3]);
                        *(u32x4*)(rowp + bj * 128) = w; }
                }
            }
        if (prof && threadIdx.x == 0) atomicAdd(prof, __builtin_amdgcn_s_memrealtime() - t0_);
    }
};
__device__ __forceinline__ void p6_final(const Args& a, unsigned char* ws, int gw, int NGW, int lane_) {
    int lane = lane_; asm volatile("" : "+v"(lane));
    float* xo = a.out; const bf16_t* x2b = (const bf16_t*)a.out + 1024; const bf16_t* ys = (const bf16_t*)(ws + WS_YS); const float* g = a.in[27];
    f32x4 gg[4];
#pragma unroll
    for (int j = 0; j < 4; ++j) gg[j] = *(const f32x4*)(g + (lane + 64 * j) * 4);
    for (int base = gw; base < T_; base += 4 * NGW) {
        uint2 xq[4][4], pq[4][4], qq[4][4];
#pragma unroll
        for (int r4 = 0; r4 < 4; ++r4) { const int row = base + r4 * NGW; if (row < T_) {
#pragma unroll
            for (int j = 0; j < 4; ++j) { const int c = (lane + 64 * j) * 4;
                xq[r4][j] = *(const uint2*)(x2b + (size_t)row * 2048 + c);
                pq[r4][j] = *(const uint2*)(ys + (size_t)(row * 2) * D_ + c); qq[r4][j] = *(const uint2*)(ys + (size_t)(row * 2 + 1) * D_ + c); } } }
#pragma unroll
        for (int r4 = 0; r4 < 4; ++r4) { const int row = base + r4 * NGW; if (row < T_) {
            f32x4* xr = (f32x4*)(xo + (size_t)row * D_);
            f32x4 v[4]; float ss = 0.f;
#pragma unroll
            for (int j = 0; j < 4; ++j) { const uint2 x = xq[r4][j], p = pq[r4][j], q2 = qq[r4][j];
                v[j][0] = bflo(x.x) + bflo(p.x) + bflo(q2.x); v[j][1] = bfhi(x.x) + bfhi(p.x) + bfhi(q2.x);
                v[j][2] = bflo(x.y) + bflo(p.y) + bflo(q2.y); v[j][3] = bfhi(x.y) + bfhi(p.y) + bfhi(q2.y);
                ss += v[j][0] * v[j][0] + v[j][1] * v[j][1] + v[j][2] * v[j][2] + v[j][3] * v[j][3]; }
            ss = wave_sum_l(ss, lane);
            const float rstd = rsqrtf(ss * (1.f / D_) + 1e-6f);
#pragma unroll
            for (int j = 0; j < 4; ++j) xr[lane + 64 * j] = v[j] * rstd * gg[j];
        } }
    }
}
#define XB_TMO      128
#define XB_XCNT(j)  (256  + 64 * (j))
#define XB_XSUB(j)  (1280 + 64 * (j))
#define XB_XGEN(j)  (2304 + 64 * (j))
#define XB_TOP      3328
#define XB_TOPGEN   3392
#define XCD_BAR_WORDS 3456
#define XB_SPIN_CAP (1u << 18)

__device__ __forceinline__ unsigned xb_ld(unsigned* p)              { return __hip_atomic_load(p, __ATOMIC_RELAXED, __HIP_MEMORY_SCOPE_AGENT); }
__device__ __forceinline__ unsigned xb_add(unsigned* p, unsigned v) { return __hip_atomic_fetch_add(p, v, __ATOMIC_RELAXED, __HIP_MEMORY_SCOPE_AGENT); }
__device__ __forceinline__ unsigned xb_xcc_id() { return (unsigned)__builtin_amdgcn_s_getreg((3 << 11) | 20) & 0xFu; }
#define XB_SPIN(cond, bar) do { unsigned _sp = 0; while (cond) { __builtin_amdgcn_s_sleep(1); \
    if ((++_sp & 255u) == 0u) { if (xb_ld(&(bar)[XB_TMO])) break; if (_sp > XB_SPIN_CAP) { atomicAdd(&(bar)[XB_TMO], 1u); break; } } } } while (0)

struct XcdBarrier {
    unsigned* bar; unsigned x;
    volatile LAS unsigned* st;
};

__device__ __forceinline__ XcdBarrier xcd_barrier_post(unsigned* bar, volatile LAS unsigned* st) {
    XcdBarrier b; b.bar = bar; b.x = xb_xcc_id(); b.st = st;
    if (threadIdx.x == 0) (void)xb_add(&bar[XB_XCNT(b.x)], 1u);
    return b;
}
__device__ __forceinline__ void xcd_barrier_complete(unsigned* bar, unsigned x, unsigned& nloc, unsigned& nx) {
    const unsigned G = gridDim.x * gridDim.y * gridDim.z;
    unsigned sum, cnt, mine, sp = 0u;
    for (;;) {
        sum = 0u; cnt = 0u; mine = 0u;
#pragma unroll
        for (unsigned j = 0; j < 16; ++j) { const unsigned c = xb_ld(&bar[XB_XCNT(j)]); sum += c; cnt += (c > 0u) ? 1u : 0u; mine = (j == x) ? c : mine; }
        if (sum == G) break;
        __builtin_amdgcn_s_sleep(1);
        if ((++sp & 255u) == 0u) { if (xb_ld(&bar[XB_TMO])) break; if (sp > XB_SPIN_CAP) { atomicAdd(&bar[XB_TMO], 1u); break; } }
    }
    nloc = mine > 0u ? mine : 1u; nx = cnt > 0u ? cnt : 1u;
}

__device__ __forceinline__ void xcd_barrier(const XcdBarrier& b) {
    asm volatile("s_waitcnt vmcnt(0)" ::: "memory");
    __syncthreads();
    if (threadIdx.x == 0) {
        unsigned* bar = b.bar;
        __builtin_amdgcn_s_waitcnt(0);
        unsigned nloc = b.st[0], nx = b.st[1];
        if (nloc == 0u) { xcd_barrier_complete(bar, b.x, nloc, nx); b.st[0] = nloc; b.st[1] = nx; }
        const unsigned old = xb_add(&bar[XB_XSUB(b.x)], 1u);
        const unsigned gen = old / nloc;
        if (old + 1u == (gen + 1u) * nloc) {
            __builtin_amdgcn_fence(__ATOMIC_RELEASE, "agent");
            asm volatile("s_waitcnt vmcnt(0)" ::: "memory");
            const unsigned og = xb_add(&bar[XB_TOP], 1u);
            const unsigned tg = og / nx;
            if (og + 1u == (tg + 1u) * nx) xb_add(&bar[XB_TOPGEN], 1u);
            else XB_SPIN(xb_ld(&bar[XB_TOPGEN]) == tg, bar);
            __builtin_amdgcn_fence(__ATOMIC_ACQUIRE, "agent");
            xb_add(&bar[XB_XGEN(b.x)], 1u);
            asm volatile("s_waitcnt vmcnt(0)" ::: "memory");
        } else {
            XB_SPIN(xb_ld(&bar[XB_XGEN(b.x)]) == gen, bar);
            __builtin_amdgcn_fence(__ATOMIC_ACQUIRE, "agent");
            asm volatile("s_waitcnt vmcnt(0)" ::: "memory");
        }
    }
    __syncthreads();
}
__global__ void __launch_bounds__(NWAVES * 64, 2) mk_fwd(Args args_unused) {
    __builtin_assume(__builtin_amdgcn_workitem_id_y() == 0); __builtin_assume(__builtin_amdgcn_workitem_id_z() == 0);
    const Args& args = *(const Args*)(const __attribute__((address_space(4))) void*)__builtin_amdgcn_kernarg_segment_ptr();
    extern __shared__ __attribute__((aligned(16))) unsigned char lds_raw[];
    LAS unsigned char* lds = (LAS unsigned char*)lds_raw;
    const int tid = threadIdx.x, lane = tid & 63, wave = __builtin_amdgcn_readfirstlane(tid >> 6);
    const int G = gridDim.x; const int bx = blockIdx.x; const int vcu = (G % 8 == 0) ? (bx % 8) * (G / 8) + bx / 8 : bx;
    unsigned char* ws = args.ws;
    const int lo = args.ph_lo, hi = args.ph_hi;
    volatile LAS unsigned* xst = (volatile LAS unsigned*)(lds + MISC_OFF + 3072);
    if (tid < 2) xst[tid] = 0u;
    __syncthreads();
    XcdBarrier xbar = xcd_barrier_post((unsigned*)(ws + WS_CTL + 4096), xst);
#ifndef REP_PHASE
#define REP_PHASE -1
#endif
#define IN(k) (lo <= (k) && (k) < hi)
#define REPS(k) for (int rp_ = 0; rp_ < ((REP_PHASE) == (k) ? 2 : 1); ++rp_)
#define PROBE_ON ((REP_PHASE) >= 60 && (REP_PHASE) < 100)
#define STAMP(k) do { if (PROBE_ON) { __syncthreads(); if (tid == 0) ((unsigned long long*)(ws + WS_CTL + 65536))[((k) + 1) * 256 + bx] = __builtin_amdgcn_s_memrealtime(); } } while (0)
#define GRID_SYNC(k) do { STAMP(k); if (args.coop && IN(k) && IN((k) + 1)) { if ((k) == 0) cg::this_grid().sync(); else { xcd_barrier(xbar); if ((REP_PHASE) == 50) xcd_barrier(xbar); } } } while (0)
    bf16_t* wt = (bf16_t*)(ws + WS_WT);
#ifndef SKIP_P0
    if (PROBE_ON && tid == 0) ((unsigned long long*)(ws + WS_CTL + 65536))[bx] = __builtin_amdgcn_s_memrealtime();
    if (PROBE_ON && tid == 0) { ((unsigned long long*)(ws + WS_CTL + 65536))[30 * 256 + bx] = 0ull; ((unsigned long long*)(ws + WS_CTL + 65536))[31 * 256 + bx] = 0ull; }
    if (IN(0)) REPS(0) { p0_prologue(args, lds, vcu, G, wave, lane, tid); __syncthreads(); }
#endif
    GRID_SYNC(0);
#ifndef SKIP_P1
    if (IN(1)) REPS(1) {
        if (rp_ == 0) for (int bh = bx; bh < B_ * 8; bh += G) { p1_cumsum((float*)(ws + WS_LOGF), (bf16_t*)(ws + WS_KAUG), bh, (LAS float*)lds, tid); }
        __syncthreads();
        {
            pg8::Gemm g{(const bf16_t*)(ws + WS_R1), wt + WT_IN, 1024, 1024, 1024}; pg8::StaticOrder S; S.init(T_, 5120, G, bx);
            EpiIn E{(bf16_t*)(ws + WS_FQ), (bf16_t*)(ws + WS_FK), (bf16_t*)(ws + WS_FV), (bf16_t*)(ws + WS_DQ), (bf16_t*)(ws + WS_DK), (bf16_t*)(ws + WS_DV), (bf16_t*)args.out, (const float*)(ws + WS_ROPE)};
            pg8::gemm_phase<EpiIn, pg8::StaticOrder, true>(lds, g, S, E);
        }
        {
            pg8::Gemm g{(const bf16_t*)(ws + WS_MEMN), wt + WT_CKV, 1024, 1024, 1024}; pg8::StaticOrder S; S.init(B_ * MEML, 512, G, bx);
            EpiBf E{(bf16_t*)(ws + WS_MKV), 512, 1.f};
            pg8::gemm_phase<EpiBf, pg8::StaticOrder, true>(lds, g, S, E);
        }
    }
#endif
    GRID_SYNC(1);
    if (IN(2)) REPS(2) {
        char* shm = (char*)lds_raw;
        const bf16_t *FQ = (const bf16_t*)(ws + WS_FQ), *FK = (const bf16_t*)(ws + WS_FK), *FV = (const bf16_t*)(ws + WS_FV), *DQ = (const bf16_t*)(ws + WS_DQ), *DK = (const bf16_t*)(ws + WS_DK), *DVp = (const bf16_t*)(ws + WS_DV);
        bf16_t *Yp = (bf16_t*)(ws + WS_Y), *ODp = (bf16_t*)(ws + WS_OD); const bf16_t* KA = (const bf16_t*)(ws + WS_KAUG);
        for (int it = vcu; it < 256; it += G) {
            attn_body::bf16x8 qrs[4]; bool primed = false;
#pragma nounroll
            for (int j = 0; j < 8; ++j) {
                const int item = it * 4 + (j >> 1); const int seq = item >> 3, s = item & 7;
                const int qb = (j & 1) ? 15 - s : s; const int NT = 4 * (qb + 1);
                const int b = seq >> 3, h = seq & 7; const size_t r0 = (size_t)b * S_;
                const int jn = j + 1; const int itemn = it * 4 + (jn >> 1); const int seqn = itemn >> 3, sn = itemn & 7;
                const int qbn = (jn & 1) ? 15 - sn : sn; const int bn = seqn >> 3, hn = seqn & 7; const size_t r0n = (size_t)bn * S_; const bool hasn = jn < 8;
                attn_body::attn_unit<true, true, 40>(FQ + (r0 + qb * 256) * 512 + h * 64, 512, FK + r0 * 512 + h * 64, 512, FV + r0 * 512 + h * 64, 512,
                                                     Yp + (r0 + qb * 256) * 1024 + h * 64, 1024, KA + ((size_t)seq * S_) * 4, NT, shm,
                                                     qrs, primed, j & 1, hasn ? FQ + (r0n + qbn * 256) * 512 + hn * 64 : nullptr, FK + r0n * 512 + hn * 64, KA + ((size_t)seqn * S_) * 4, 4 * (qbn + 1));
                primed = hasn;
            }
            primed = false;
#pragma nounroll
            for (int j = 0; j < 8; ++j) {
                const int item = it * 4 + (j >> 1); const int seq = item >> 3, s = item & 7;
                const int qb = (j & 1) ? 15 - s : s; const int NT = 4 * (qb + 1);
                const int b = seq >> 3, hh = seq & 7; const size_t r0 = (size_t)b * S_;
                const int jn = j + 1; const int itemn = it * 4 + (jn >> 1); const int seqn = itemn >> 3, sn = itemn & 7;
                const int qbn = (jn & 1) ? 15 - sn : sn; const int bn = seqn >> 3, hhn = seqn & 7; const size_t r0n = (size_t)bn * S_; const bool hasn = jn < 8;
                attn_body::attn_unit128<8>(DQ + (r0 + qb * 256) * 512 + hh * 64, 512, DK + r0 * 512 + hh * 64, 512, DVp + r0 * 512 + (hh >> 1) * 128, 512,
                                           ODp + (r0 + qb * 256) * 1024 + hh * 128, 1024, nullptr, NT, shm,
                                           qrs, primed, 0, hasn ? DQ + (r0n + qbn * 256) * 512 + hhn * 64 : nullptr, DK + r0n * 512 + hhn * 64, nullptr, 0);
                primed = hasn;
            }
        }
    }
    GRID_SYNC(2);
    if (IN(3)) {
#ifdef P3_STAGGER
        if (bx & 1) { for (int i_ = 0; i_ < P3_STAGGER; ++i_) __builtin_amdgcn_s_sleep(127); }
#endif
        for (int panel = vcu; panel < 256; panel += G) p3_chain(args, lds, lds_raw, panel, wave, lane, tid); }
    GRID_SYNC(3);
    if (IN(4)) REPS(4) {
        OPAQUE_GLOBAL(wsq, args.ws);
        const unsigned* counts = (const unsigned*)(wsq + WS_CTL); LAS unsigned* tab = (LAS unsigned*)(lds + TAB_OFF);
        const int NTl = build_tile_table(counts, tab, tid);
        pg8::Gemm g{(const bf16_t*)(wsq + WS_R1), (const bf16_t*)(wsq + WS_WT) + WT_E1, 1024, 512, 512};
        GroupOrder<true> S{tab, NTl, G, vcu, (const int*)(wsq + WS_LTOK), counts};
        EpiE1 E{(unsigned char*)(wsq + WS_H), (const float*)(wsq + WS_LRS), counts};
        pg8::gemm_phase<EpiE1, GroupOrder<true>, true, true>(lds, g, S, E);
    }
    GRID_SYNC(4);
    if (IN(5)) REPS(5) {
        OPAQUE_GLOBAL(wsq, args.ws);
        const unsigned* counts = (const unsigned*)(wsq + WS_CTL); LAS unsigned* tab = (LAS unsigned*)(lds + TAB_OFF);
        const int NTl = build_tile_table(counts, tab, tid);
        pg8::Gemm g{(const bf16_t*)(wsq + WS_H), (const bf16_t*)(wsq + WS_WT) + WT_E2, 256, 256, 256};
        GroupOrder<false> S{tab, NTl, G, vcu, (const int*)(wsq + WS_LTOK), counts};
        EpiE2 E{(bf16_t*)(wsq + WS_YS), (const int*)(wsq + WS_LTOK), (const float*)(wsq + WS_LW), counts, ((REP_PHASE) == 78 || (REP_PHASE) == 79) ? (unsigned long long*)(wsq + WS_CTL + 65536) + 30 * 256 + blockIdx.x : nullptr};
        pg8::gemm_phase<EpiE2, GroupOrder<false>, true, true>(lds, g, S, E);
    }
    GRID_SYNC(5);
    if (IN(6)) { OPAQUE_GLOBAL(wsq, args.ws); p6_final(args, wsq, vcu * NWAVES + wave, G * NWAVES, lane); }
    if (PROBE_ON) {
        STAMP(6); xcd_barrier(xbar);
        if (bx == 0 && tid == 0) {
            const unsigned long long* ts = (const unsigned long long*)(ws + WS_CTL + 65536);
            const int ph = ((REP_PHASE) - 70) % 10; const bool dur = (REP_PHASE) >= 80;
            unsigned long long mx = 0ull, mn = ~0ull, pmx = 0ull;
            for (int i = 0; i < G; ++i) { const unsigned long long v = __hip_atomic_load(ts + (ph + 1) * 256 + i, __ATOMIC_RELAXED, __HIP_MEMORY_SCOPE_AGENT), p = __hip_atomic_load(ts + ph * 256 + i, __ATOMIC_RELAXED, __HIP_MEMORY_SCOPE_AGENT);
                mx = v > mx ? v : mx; mn = v < mn ? v : mn; pmx = p > pmx ? p : pmx; }
            unsigned long long wait = dur ? 4ull * (mx - pmx) : 10ull * (mx - mn);
            if ((REP_PHASE) == 78 || (REP_PHASE) == 79) { unsigned long long acc_ = 0ull; const int rw = (REP_PHASE) == 78 ? 30 : 31; for (int i = 0; i < G; ++i) acc_ += __hip_atomic_load(ts + rw * 256 + i, __ATOMIC_RELAXED, __HIP_MEMORY_SCOPE_AGENT); wait = 4ull * (acc_ / (unsigned long long)G); }
            else if ((REP_PHASE) >= 60 && (REP_PHASE) < 70) { const int si = (REP_PHASE) - 60; unsigned long long acc_ = 0ull;
                for (int i = 0; i < G; ++i) acc_ += __hip_atomic_load(ts + (17 + si) * 256 + i, __ATOMIC_RELAXED, __HIP_MEMORY_SCOPE_AGENT) - __hip_atomic_load(ts + (16 + si) * 256 + i, __ATOMIC_RELAXED, __HIP_MEMORY_SCOPE_AGENT);
                wait = 4ull * (acc_ / (unsigned long long)G); }
            else if ((REP_PHASE) == 99 || (REP_PHASE) == 89) { unsigned long long acc_ = 0ull; for (int i = 0; i < G; ++i) acc_ += __hip_atomic_load(ts + 31 * 256 + i, __ATOMIC_RELAXED, __HIP_MEMORY_SCOPE_AGENT); wait = 4ull * (acc_ / (unsigned long long)G); }
            else if ((REP_PHASE) == 97 || (REP_PHASE) == 98) { unsigned long long acc_ = 0ull; for (int i = 0; i < G; ++i) acc_ += __hip_atomic_load(ts + 30 * 256 + i, __ATOMIC_RELAXED, __HIP_MEMORY_SCOPE_AGENT); wait = 4ull * (acc_ / (unsigned long long)G); }
            else if ((REP_PHASE) >= 90) { const int si = (REP_PHASE) - 90; unsigned long long acc_ = 0ull;
                for (int i = 0; i < G; ++i) acc_ += __hip_atomic_load(ts + (17 + si) * 256 + i, __ATOMIC_RELAXED, __HIP_MEMORY_SCOPE_AGENT) - __hip_atomic_load(ts + (16 + si) * 256 + i, __ATOMIC_RELAXED, __HIP_MEMORY_SCOPE_AGENT);
                wait = 4ull * (acc_ / (unsigned long long)G); }
            const unsigned long long t0 = __builtin_amdgcn_s_memrealtime();
            while (__builtin_amdgcn_s_memrealtime() - t0 < wait) __builtin_amdgcn_s_sleep(8);
        }
    }
#undef IN
#undef GRID_SYNC
}
extern "C" void kernel_launch(void* const* d_in, const int* in_sizes, int n_in, void* d_out, int out_size, void* d_ws, size_t ws_size, hipStream_t stream) {
    static int grid = 0;
    if (grid == 0) {
        int dev = 0, cus = 0, per_cu = 0; (void)hipGetDevice(&dev); (void)hipDeviceGetAttribute(&cus, hipDeviceAttributeMultiprocessorCount, dev);
        (void)hipFuncSetAttribute((const void*)mk_fwd, hipFuncAttributeMaxDynamicSharedMemorySize, LDS_BYTES);
        if (hipOccupancyMaxActiveBlocksPerMultiprocessor(&per_cu, (const void*)mk_fwd, NWAVES * 64, LDS_BYTES) != hipSuccess || per_cu < 1) per_cu = 1;
        (void)hipGetLastError();
        if (cus <= 0) cus = 256;
        grid = cus * (per_cu > 1 ? 1 : per_cu);
        if (grid > 256) grid = 256;
    }
    unsigned char* ws = (unsigned char*)d_ws;
    (void)hipMemsetAsync(ws + WS_CTL, 0, 32768, stream);
    Args a{}; for (int i = 0; i < 28; ++i) a.in[i] = (const float*)d_in[i]; a.out = (float*)d_out; a.ws = ws; a.coop = 1; a.ph_lo = 0; a.ph_hi = 7; a.pad = 0;
    void* kargs[] = {&a};
    hipError_t e = hipLaunchCooperativeKernel((const void*)mk_fwd, dim3(grid), dim3(NWAVES * 64), kargs, LDS_BYTES, stream);
    if (e != hipSuccess) fprintf(stderr, "cooperative launch failed: %s (grid %d)\n", hipGetErrorString(e), grid);
}
```

```cpp
#include <hip/hip_runtime.h>
#ifndef REP_PHASE
#define REP_PHASE -1
#endif
#include <stdint.h>
#include <math.h>
#include <stdio.h>

typedef unsigned short bf16_t;
constexpr int T_ = 65536, D_ = 1024, S_ = 4096, B_ = 16, INW = 5128, MEML = 256;
constexpr float LOG2E = 1.4426950408889634f;
constexpr float C2 = 0.125f * LOG2E;
constexpr size_t MiB = 1u << 20;
constexpr size_t WS_CTL = 0;
constexpr size_t WS_LOGF = 2 * MiB;
constexpr size_t WS_KAUG = 4 * MiB;
constexpr size_t WS_ROPE = 8 * MiB;
constexpr size_t WS_MKV = 24 * MiB;
constexpr size_t WS_MEMN = 28 * MiB;
constexpr size_t WS_QC = 36 * MiB;
constexpr size_t WS_OC = 68 * MiB;
constexpr size_t WS_LTOK = 100 * MiB;
constexpr size_t WS_LW = 108 * MiB;
constexpr size_t WS_WT = 128 * MiB;
constexpr size_t WS_R1 = 240 * MiB;
constexpr size_t WS_FQ = 368 * MiB, WS_FK = 432 * MiB, WS_FV = 496 * MiB, WS_DQ = 560 * MiB, WS_DK = 624 * MiB, WS_DV = 688 * MiB;
constexpr size_t WS_Y = 752 * MiB;
constexpr size_t WS_OD = 880 * MiB;
constexpr size_t WS_YS = 368 * MiB;
constexpr size_t WS_H = 752 * MiB;
constexpr size_t WS_RAW = 752 * MiB;

__device__ __forceinline__ float bf2f(bf16_t h) { return __uint_as_float(((unsigned)h) << 16); }
__device__ __forceinline__ bf16_t f2bf(float f) { unsigned u = __float_as_uint(f); u += 0x7fffu + ((u >> 16) & 1u); return (bf16_t)(u >> 16); }
__device__ __forceinline__ float wave_sum(float v) {
#pragma unroll
    for (int o = 1; o < 64; o <<= 1) v += __shfl_xor(v, o);
    return v;
}
__device__ __forceinline__ float sigmoidf_(float x) { return 1.f / (1.f + __expf(-x)); }


#define GAS_ __attribute__((address_space(1)))
#define OPAQUE_GLOBAL(dst, src) GAS_ unsigned char* dst##_g = (GAS_ unsigned char*)(src); asm volatile("" : "+s"(dst##_g)); unsigned char* dst = (unsigned char*)dst##_g

#define dpp_add_(v, ctrl, row_mask) ((v) + __int_as_float(__builtin_amdgcn_update_dpp(0, __float_as_int(v), (ctrl), (row_mask), 0xf, false)))
__device__ __forceinline__ float wave_sum_dpp(float v) {
    v = dpp_add_(v, 0xB1, 0xf); v = dpp_add_(v, 0x4E, 0xf); v = dpp_add_(v, 0x141, 0xf); v = dpp_add_(v, 0x140, 0xf);
    v = dpp_add_(v, 0x142, 0xa); v = dpp_add_(v, 0x143, 0xc);
    return __int_as_float(__builtin_amdgcn_readlane(__float_as_int(v), 63));
}
namespace pg8 {
#define PG8_LAS __attribute__((address_space(3)))
typedef short bf16x8 __attribute__((ext_vector_type(8)));
typedef float f32x4 __attribute__((ext_vector_type(4)));
typedef unsigned u32x4 __attribute__((ext_vector_type(4)));
typedef int v4i __attribute__((ext_vector_type(4)));
typedef int v8i __attribute__((ext_vector_type(8)));
constexpr int BM = 256, BK = 64, HALF = 128, HTB = HALF * BK * 2  , STAGE_BYTES = 8 * HTB, NXCD = 8, WGM = 8;

__host__ __device__ __forceinline__ int lds_byte(int r, int c) { const int st = (r >> 4) * 2 + (c >> 5), rr = r & 15, cc = c & 31, ob = rr * 64 + cc * 2; return st * 1024 + (ob ^ (((ob >> 9) & 1) << 5)); }
__host__ __device__ __forceinline__ void stage_rc(int b, int& R, int& C) { const int st = b / 1024, sb = b % 1024, swz = sb ^ (((sb >> 9) & 1) << 5); R = (st >> 1) * 16 + swz / 64; C = (st & 1) * 32 + (swz % 64) / 2; }
__host__ __device__ __forceinline__ int perm32(int rho) { const int n = rho >> 4, i = rho & 15; return 8 * (i >> 2) + 4 * n + (i & 3); }

struct Unit { int pm, pn, e, rt, i; };
struct Gemm { const bf16_t* A; const bf16_t* Bt; int lda, ldb, K; };

struct StaticOrder {
    static constexpr bool GATHER = false;
    int nM, nN, nwg, G, c, mode;
    __host__ __device__ void init(int M, int N, int G_, int c_) { nM = M / BM; nN = N / BM; nwg = nM * nN; G = G_; c = c_; mode = 0; }
    __host__ __device__ bool next(int i, Unit& u) const {
        const long L = (long)i * G + c; if (L >= nwg) return false;
        int wgid = (int)L; { const int q = nwg / NXCD, r = nwg % NXCD, xcd = wgid % NXCD, off = wgid / NXCD; wgid = (xcd < r ? xcd * (q + 1) : r * (q + 1) + (xcd - r) * q) + off; }
        const int nig = WGM * nN, gid = wgid / nig, fm = gid * WGM, gsz = (nM - fm) < WGM ? (nM - fm) : WGM;
        u.pm = fm + ((wgid % nig) % gsz); u.pn = (wgid % nig) / gsz; u.e = 0; u.rt = 0; u.i = i;
        if (mode == 1) u.pn += 6; else if (mode == 2) u.pn += (u.pn < 6) ? 0 : 6;
        return true;
    }
    __device__ __forceinline__ unsigned arow(const Unit&, int) const { return 0u; }
};
struct PanelOrder {
    static constexpr bool GATHER = false;
    int pm, nN, rot;
    __device__ bool next(int i, Unit& u) const { if (i >= nN) return false; u.pm = pm; u.pn = (i + rot) & (nN - 1); u.e = 0; u.rt = 0; u.i = i; return true; }
    __device__ __forceinline__ unsigned arow(const Unit&, int) const { return 0u; }
};

__device__ __forceinline__ unsigned cvt_pk_bf16(float lo, float hi) { unsigned r; asm volatile("v_cvt_pk_bf16_f32 %0, %1, %2" : "=v"(r) : "v"(lo), "v"(hi)); return r; }

template <class Epi, class Sched, bool ALIGN_EPI, bool FP8 = false>
__device__ __forceinline__ void gemm_phase(PG8_LAS unsigned char* lds, const Gemm g, const Sched& S, const Epi& E) {
    int tid_ = threadIdx.x; asm volatile("" : "+v"(tid_));
    const int tid = tid_, wid = __builtin_amdgcn_readfirstlane(tid >> 6), lane = tid & 63, wr = wid >> 2, wc = wid & 3, fr = lane & 15, fq = lane >> 4;
    const int K = g.K, nt = K / BK;
    int Rr[2], Cc[2]; unsigned voffB[2];
#pragma unroll
    for (int i = 0; i < 2; ++i) { int R, C; stage_rc(tid * 16 + i * 8192, R, C); const int Rb = Epi::PERM ? ((R & ~31) + perm32(R & 31)) : R;
        Rr[i] = R; Cc[i] = C; voffB[i] = (unsigned)(Rb * g.ldb + C) * 2u; }
    const size_t kstep = (size_t)(BK * 2);
    const unsigned hstepA = (unsigned)HALF * (unsigned)g.lda * 2u;
    const size_t tstepA = (size_t)2 * hstepA;
    const size_t hstepB = (size_t)HALF * g.ldb * 2, tstepB = 2 * hstepB;
    const unsigned ldsw = (unsigned)wid * 1024u;
    const int aoff = lds_byte(wr * 64 + fr, fq * 8), boff = lds_byte(wc * 32 + fr, fq * 8);
#define PG8_SA(b, h) (((b) * 2 + (h)) * HTB)
#define PG8_SB(b, h) ((4 + (b) * 2 + (h)) * HTB)
#define PG8_GAS __attribute__((address_space(1)))
#define PG8_STAGE(bufoff, gbase, voff) do { _Pragma("unroll") for (int _i = 0; _i < 2; ++_i) \
        __builtin_amdgcn_global_load_lds((const unsigned*)((const char*)(gbase) + (voff)[_i]), (PG8_LAS unsigned*)(lds + (bufoff) + ldsw + _i * 8192), 16, 0, 0); } while (0)
#define PG8_LDA(dst, b, h) do { _Pragma("unroll") for (int m = 0; m < 4; ++m) { dst[m].lo = *(const PG8_LAS v4i*)(lds + PG8_SA(b, h) + aoff + m * 2048); dst[m].hi = *(const PG8_LAS v4i*)(lds + PG8_SA(b, h) + aoff + m * 2048 + 1024); } } while (0)
#define PG8_LDB(dst, b, h) do { _Pragma("unroll") for (int n = 0; n < 2; ++n) { dst[n].lo = *(const PG8_LAS v4i*)(lds + PG8_SB(b, h) + boff + n * 2048); dst[n].hi = *(const PG8_LAS v4i*)(lds + PG8_SB(b, h) + boff + n * 2048 + 1024); } } while (0)
#define PG8_MMA(ai, bj, At, Bt) do { __builtin_amdgcn_s_setprio(1); _Pragma("unroll") for (int m = 0; m < 4; ++m) _Pragma("unroll") for (int n = 0; n < 2; ++n) { \
        if constexpr (FP8) asm volatile("v_mfma_f32_16x16x128_f8f6f4 %0, %1, %2, %0" : "+v"(acc[ai][bj][m][n]) : "v"(Bt[n]), "v"(At[m])); \
        else { const v4i bl_ = Bt[n].lo, bh_ = Bt[n].hi, al_ = At[m].lo, ah_ = At[m].hi;     \
               acc[ai][bj][m][n] = __builtin_amdgcn_mfma_f32_16x16x32_bf16(__builtin_bit_cast(bf16x8, bl_), __builtin_bit_cast(bf16x8, al_), acc[ai][bj][m][n], 0, 0, 0); \
               acc[ai][bj][m][n] = __builtin_amdgcn_mfma_f32_16x16x32_bf16(__builtin_bit_cast(bf16x8, bh_), __builtin_bit_cast(bf16x8, ah_), acc[ai][bj][m][n], 0, 0, 0); } } __builtin_amdgcn_s_setprio(0); } while (0)
#define PG8_WAIT_V(n) asm volatile("s_waitcnt vmcnt(" #n ")" ::: "memory")
#define PG8_WAIT_L(n) asm volatile("s_waitcnt lgkmcnt(" #n ")" ::: "memory")
#define PG8_BAR __builtin_amdgcn_s_barrier()
#define PG8_SCHED __builtin_amdgcn_sched_barrier(0)
#define PG8_VOFF(u, v0, v1) do { _Pragma("unroll") for (int _i = 0; _i < 2; ++_i) { \
        if (Sched::GATHER) { v0[_i] = (S.arow(u, Rr[_i]) * (unsigned)g.lda + (unsigned)Cc[_i]) * 2u; v1[_i] = (S.arow(u, Rr[_i] + HALF) * (unsigned)g.lda + (unsigned)Cc[_i]) * 2u; } \
        else { v0[_i] = (unsigned)(Rr[_i] * g.lda + Cc[_i]) * 2u; v1[_i] = v0[_i] + hstepA; } } } while (0)
    Unit cur, nxt; int ui = 0;
    if (!S.next(0, cur)) return;
    unsigned pf_sink = 0u;
    f32x4 acc[2][2][4][2];
#pragma unroll
    for (int a = 0; a < 2; ++a)
#pragma unroll
        for (int b = 0; b < 2; ++b)
#pragma unroll
            for (int m = 0; m < 4; ++m)
#pragma unroll
                for (int n = 0; n < 2; ++n) acc[a][b][m][n] = (f32x4){0.f, 0.f, 0.f, 0.f};
    v8i At[4], B0[2], B1[2];
    unsigned cv0[2], cv1[2], nv0[2], nv1[2];
    PG8_VOFF(cur, cv0, cv1);
    const char* cA = (const char*)g.A + (Sched::GATHER ? (size_t)0 : (size_t)cur.pm * tstepA); const char* cB = (const char*)g.Bt + (size_t)cur.pn * tstepB;
    PG8_STAGE(PG8_SB(0, 0), cB, voffB); PG8_STAGE(PG8_SB(0, 1), cB + hstepB, voffB); PG8_STAGE(PG8_SA(0, 0), cA, cv0); PG8_STAGE(PG8_SA(0, 1), cA, cv1);
    if (wr == 1) PG8_BAR;
    PG8_WAIT_V(2); PG8_BAR;
    PG8_STAGE(PG8_SB(1, 0), cB + kstep, voffB); PG8_STAGE(PG8_SA(1, 0), cA + kstep, cv0); PG8_STAGE(PG8_SB(1, 1), cB + hstepB + kstep, voffB);
    PG8_WAIT_V(6); PG8_BAR;
    for (;;) {
        const bool has_next = S.next(ui + 1, nxt);
        unsigned long long tk0_ = 0ull; if constexpr (Epi::HAS_PROF) { if (E.prof) tk0_ = __builtin_amdgcn_s_memrealtime(); }
        const char* nA = has_next ? ((const char*)g.A + (Sched::GATHER ? (size_t)0 : (size_t)nxt.pm * tstepA)) : cA; const char* nB = has_next ? (const char*)g.Bt + (size_t)nxt.pn * tstepB : cB;
        if (has_next) { PG8_VOFF(nxt, nv0, nv1); } else {
#pragma unroll
            for (int i = 0; i < 2; ++i) { nv0[i] = cv0[i]; nv1[i] = cv1[i]; } }
#pragma nounroll
        for (int t = 0; t < nt; t += 2) {
            const bool last = (t == nt - 2);
            if constexpr (Epi::HAS_PF) { if (t == (nt > 6 ? nt - 6 : 0)) E.prefetch(cur, wr, wc, fr, fq, pf_sink, false); if (Epi::HAS_MID && t == (nt / 2 > 4 ? nt / 2 - 4 : 0)) E.prefetch(cur, wr, wc, fr, fq, pf_sink, true); }
            if constexpr (Epi::HAS_MID) { if (t == nt / 2) E.mid(acc, cur, wr, wc, fr, fq); }
            const char* a1 = cA + (size_t)(t + 1) * kstep;
            const char* a2 = last ? nA : cA + (size_t)(t + 2) * kstep; const char* b2 = last ? nB : cB + (size_t)(t + 2) * kstep;
            const char* a3 = a2 + kstep; const char* b3 = b2 + kstep;
            unsigned f0[2], f1[2];
#pragma unroll
            for (int i = 0; i < 2; ++i) { f0[i] = last ? nv0[i] : cv0[i]; f1[i] = last ? nv1[i] : cv1[i]; }
            PG8_LDB(B0, 0, 0); PG8_LDB(B1, 0, 1); PG8_SCHED; PG8_LDA(At, 0, 0); PG8_STAGE(PG8_SA(1, 1), a1, cv1);
            PG8_WAIT_V(8); PG8_WAIT_L(0); PG8_BAR; PG8_MMA(0, 0, At, B0); PG8_MMA(0, 1, At, B1); PG8_BAR; PG8_SCHED;
            PG8_LDA(At, 0, 1); PG8_STAGE(PG8_SB(0, 0), b2, voffB); PG8_STAGE(PG8_SB(0, 1), b2 + hstepB, voffB); PG8_STAGE(PG8_SA(0, 0), a2, f0);
            PG8_WAIT_V(8); PG8_WAIT_L(0); PG8_BAR; PG8_MMA(1, 0, At, B0); PG8_MMA(1, 1, At, B1); PG8_BAR; PG8_SCHED;
            PG8_LDB(B0, 1, 0); PG8_LDB(B1, 1, 1); PG8_SCHED; PG8_LDA(At, 1, 0); PG8_STAGE(PG8_SA(0, 1), a2, f1);
            PG8_WAIT_V(8); PG8_WAIT_L(0); PG8_BAR; PG8_MMA(0, 0, At, B0); PG8_MMA(0, 1, At, B1); PG8_BAR; PG8_SCHED;
            PG8_LDA(At, 1, 1); PG8_STAGE(PG8_SB(1, 0), b3, voffB); PG8_STAGE(PG8_SB(1, 1), b3 + hstepB, voffB); PG8_STAGE(PG8_SA(1, 0), a3, f0);
            PG8_WAIT_V(8); PG8_WAIT_L(0); PG8_BAR; PG8_MMA(1, 0, At, B0); PG8_MMA(1, 1, At, B1); PG8_BAR; PG8_SCHED;
        }
        if constexpr (ALIGN_EPI) { if (wr == 0) PG8_BAR; }
        if constexpr (Epi::HAS_PROF) { if (E.prof && threadIdx.x == 0) atomicAdd(E.prof + 256, __builtin_amdgcn_s_memrealtime() - tk0_); }
        if constexpr (FP8) asm volatile("s_nop 15\n\ts_nop 15" ::: "memory");
        E(acc, cur, wr, wc, fr, fq);
        if constexpr (Epi::HAS_PF) asm volatile("" :: "v"(pf_sink));
        if (!has_next) break;
#pragma unroll
        for (int a = 0; a < 2; ++a)
#pragma unroll
            for (int b = 0; b < 2; ++b)
#pragma unroll
                for (int m = 0; m < 4; ++m)
#pragma unroll
                    for (int n = 0; n < 2; ++n) acc[a][b][m][n] = (f32x4){0.f, 0.f, 0.f, 0.f};
        cur = nxt; cA = nA; cB = nB; ++ui;
#pragma unroll
        for (int i = 0; i < 2; ++i) { cv0[i] = nv0[i]; cv1[i] = nv1[i]; }
        if constexpr (ALIGN_EPI) { if (wr == 1) PG8_BAR; }
    }
    PG8_WAIT_V(0);
    if constexpr (!ALIGN_EPI) { if (wr == 0) PG8_BAR; }
    PG8_BAR;
#undef PG8_SA
#undef PG8_SB
#undef PG8_STAGE
#undef PG8_LDA
#undef PG8_LDB
#undef PG8_MMA
#undef PG8_WAIT_V
#undef PG8_WAIT_L
#undef PG8_BAR
#undef PG8_SCHED
#undef PG8_VOFF
}
}
namespace attn_body {
typedef unsigned short bf16;
using bf16x8=__attribute__((ext_vector_type(8)))short;
using s16x4=__attribute__((ext_vector_type(4)))short;
using f32x16=__attribute__((ext_vector_type(16)))float;
using u32x4=__attribute__((ext_vector_type(4)))unsigned;
constexpr int D=64;
constexpr int NW=8,QBLK=32,QB=QBLK*NW,KVBLK=64;
__device__ __forceinline__ int crow(int r,int hi){return (r&3)+8*(r>>2)+4*hi;}
#define SBAR() __builtin_amdgcn_sched_barrier(0)
__device__ __forceinline__ void cmask(f32x16&p0,f32x16&p1,int jb,int qrel,int hi,int wid){
  const float NEG=-INFINITY; int kb=64*jb+4*hi;
  if(wid>=2*jb+2)return;
  #pragma unroll
  for(int r=0;r<16;++r){int kv=kb+(r&3)+8*(r>>2); if(kv>qrel)p0[r]=NEG; if(kv+32>qrel)p1[r]=NEG;}
}

constexpr int NSLOT=3, SLOTB=8192;
constexpr int LDS_K=0, LDS_V=NSLOT*SLOTB, LDS_WS=2*NSLOT*SLOTB, LDS_OST=LDS_WS+NW*64*4, LDS_AUG=LDS_OST+NW*4096, LDS_BYTES=LDS_AUG+65536;
constexpr float C2=0.125f*1.4426950408889634f;
__device__ __forceinline__ void glds16(const void*gsrc,unsigned lds_dst){unsigned keep;
  asm volatile("s_mov_b32 %0, m0\n\ts_mov_b32 m0, %2\n\ts_nop 0\n\tglobal_load_lds_dwordx4 %1, off\n\ts_mov_b32 m0, %0":"=&s"(keep):"v"(gsrc),"s"(lds_dst):"memory");}
__device__ __forceinline__ float max3f(float a,float b,float c){float r;asm("v_max3_f32 %0, %1, %2, %3":"=v"(r):"v"(a),"v"(b),"v"(c));return r;}
__device__ __forceinline__ float max2f(float a,float b){float r;asm("v_max_f32_e32 %0, %1, %2":"=v"(r):"v"(a),"v"(b));return r;}
__device__ __forceinline__ float fadd_s(float a,float b){float r;asm("v_add_f32_e32 %0, %1, %2":"=v"(r):"v"(a),"v"(b));return r;}
__device__ __forceinline__ float fsub_s(float a,float b){float r;asm("v_sub_f32_e32 %0, %1, %2":"=v"(r):"v"(a),"v"(b));return r;}
typedef float f32x2_t __attribute__((ext_vector_type(2))); typedef __bf16 bf16x2_t __attribute__((ext_vector_type(2)));
__device__ __forceinline__ unsigned cvtpk_s(float lo,float hi){f32x2_t v={lo,hi};bf16x2_t b=__builtin_convertvector(v,bf16x2_t);return __builtin_bit_cast(unsigned,b);}
#define WAIT_BAR(N) asm volatile("s_waitcnt vmcnt(" #N ") lgkmcnt(0)\n\ts_barrier":::"memory")

template<bool AUG> __device__ __forceinline__ void qkt(f32x16&p0,f32x16&p1,const char*Kslot,const bf16x8*qr,const f32x16&negm,int r32,int hi,bf16x8 ka0,bf16x8 ka1,bf16x8 qaug){
  const char*kb=Kslot+hi*1024+r32*16;
  #pragma unroll
  for(int d0=0;d0<4;++d0){
    const bf16x8 b0=*reinterpret_cast<const bf16x8*>(kb+d0*2048);
    const bf16x8 b1=*reinterpret_cast<const bf16x8*>(kb+d0*2048+512);
    if(d0==0){p0=__builtin_amdgcn_mfma_f32_32x32x16_bf16(b0,qr[0],negm,0,0,0);p1=__builtin_amdgcn_mfma_f32_32x32x16_bf16(b1,qr[0],negm,0,0,0);}
    else{p0=__builtin_amdgcn_mfma_f32_32x32x16_bf16(b0,qr[d0],p0,0,0,0);p1=__builtin_amdgcn_mfma_f32_32x32x16_bf16(b1,qr[d0],p1,0,0,0);}}
  if(AUG){p0=__builtin_amdgcn_mfma_f32_32x32x16_bf16(ka0,qaug,p0,0,0,0);p1=__builtin_amdgcn_mfma_f32_32x32x16_bf16(ka1,qaug,p1,0,0,0);}
}
typedef __attribute__((address_space(3))) const char* lds_cptr;
typedef short v4i16_t __attribute__((ext_vector_type(4)));
__device__ __forceinline__ void kload8(bf16x8*kf,lds_cptr kp){
  kf[0]=*(const __attribute__((address_space(3))) bf16x8*)(kp);      kf[1]=*(const __attribute__((address_space(3))) bf16x8*)(kp+512);
  kf[2]=*(const __attribute__((address_space(3))) bf16x8*)(kp+2048); kf[3]=*(const __attribute__((address_space(3))) bf16x8*)(kp+2560);
  kf[4]=*(const __attribute__((address_space(3))) bf16x8*)(kp+4096); kf[5]=*(const __attribute__((address_space(3))) bf16x8*)(kp+4608);
  kf[6]=*(const __attribute__((address_space(3))) bf16x8*)(kp+6144); kf[7]=*(const __attribute__((address_space(3))) bf16x8*)(kp+6656);
}
__device__ __forceinline__ void kload2(bf16x8*kf,lds_cptr kp,int j){ kf[2*j]=*(const __attribute__((address_space(3))) bf16x8*)(kp+j*2048); kf[2*j+1]=*(const __attribute__((address_space(3))) bf16x8*)(kp+j*2048+512); }
__device__ __forceinline__ s16x4 vtr(lds_cptr p){ return __builtin_bit_cast(s16x4,__builtin_amdgcn_ds_read_tr16_b64_v4i16((__attribute__((address_space(3))) v4i16_t*)p)); }
__device__ __forceinline__ float rowmax(const f32x16&p0,const f32x16&p1){
  float a=max3f(p0[0],p0[1],p1[0]),b=max3f(p0[2],p0[3],p1[1]);a=max3f(a,p1[2],p1[3]);
  #pragma unroll
  for(int r=4;r<16;r+=4){a=max3f(a,p0[r],p0[r+1]);b=max3f(b,p0[r+2],p0[r+3]);a=max3f(a,p1[r],p1[r+1]);b=max3f(b,p1[r+2],p1[r+3]);}
  const float m=max2f(a,b);
  auto rr=__builtin_amdgcn_permlane32_swap(__float_as_uint(m),__float_as_uint(m),false,false);
  return max2f(__uint_as_float(rr[0]),__uint_as_float(rr[1]));
}
__device__ __forceinline__ void pv(f32x16*o,int vb,bf16x8 pa0,bf16x8 pa1,bf16x8 pa2,bf16x8 pa3){
  #pragma unroll
  for(int d0=0;d0<2;++d0){s16x4 lo[4],hi[4];
    #pragma unroll
    for(int ks=0;ks<4;++ks){
      asm volatile("ds_read_b64_tr_b16 %0,%1 offset:%c2":"=&v"(lo[ks]):"v"(vb),"i"(d0*4096+ks*1024):"memory");
      asm volatile("ds_read_b64_tr_b16 %0,%1 offset:%c2":"=&v"(hi[ks]):"v"(vb),"i"(d0*4096+ks*1024+512):"memory");}
    asm volatile("s_waitcnt lgkmcnt(0)":::"memory");SBAR();
    #define PK(k) (bf16x8){lo[k][0],lo[k][1],lo[k][2],lo[k][3],hi[k][0],hi[k][1],hi[k][2],hi[k][3]}
    o[d0]=__builtin_amdgcn_mfma_f32_32x32x16_bf16(pa0,PK(0),o[d0],0,0,0);
    o[d0]=__builtin_amdgcn_mfma_f32_32x32x16_bf16(pa1,PK(1),o[d0],0,0,0);
    o[d0]=__builtin_amdgcn_mfma_f32_32x32x16_bf16(pa2,PK(2),o[d0],0,0,0);
    o[d0]=__builtin_amdgcn_mfma_f32_32x32x16_bf16(pa3,PK(3),o[d0],0,0,0);
    #undef PK
  }
}

#ifndef ATTN_STORE16
#define ATTN_STORE16(p,v) (*(u32x4*)(p)=(v))
#endif
template<bool CAUSAL,bool AUG,int THRL> __device__ __forceinline__ void attn_unit(const bf16*Qu,int ldq,const bf16*__restrict__ Kh,int ldk,const bf16*__restrict__ Vh,int ldv,bf16*Ou,int ldo,const bf16*__restrict__ aug,int NT,char*shm,bf16x8(&qr)[4],bool primed,int par,const bf16*Qn,const bf16*Kn,const bf16*augn,int NTn){
  int tid_=threadIdx.x; asm volatile("":"+v"(tid_));
  const int tid=tid_,lane=tid&63,r32=lane&31,hi=lane>>5; const int wid=__builtin_amdgcn_readfirstlane(tid>>6);
  const bf16*Qw=Qu+(long)(wid*QBLK)*ldq;
  const unsigned lds0=(unsigned)(uintptr_t)shm;
  float*wsf=(float*)(shm+LDS_WS)+wid*64;
  const bf16*ksrc=Kh+(long)lane*ldk+wid*8;
  const bf16*vsrc=Vh+(long)(16*(wid&3)+(lane>>2))*ldv+(wid>>2)*32+(lane&3)*8;
  const unsigned kdst=lds0+LDS_K+wid*1024, vdst=lds0+LDS_V+wid*1024;
  #define DMA_K(t,slot) glds16(ksrc+(long)(t)*KVBLK*ldk,(unsigned)__builtin_amdgcn_readfirstlane(kdst+(slot)))
  #define DMA_V(t,slot) glds16(vsrc+(long)(t)*KVBLK*ldv,(unsigned)__builtin_amdgcn_readfirstlane(vdst+(slot)))
  const int vb0=(int)(lds0+LDS_V)+((lane>>4)&1)*32+(lane&3)*8+(4*hi+((lane&15)>>2))*64;
  const char*Kbase=shm+LDS_K; bf16x8 kf[8];
  const lds_cptr shm3=(lds_cptr)shm; const lds_cptr kp0=shm3+LDS_K+hi*1024+r32*16; const lds_cptr vp0=shm3+LDS_V+((lane>>4)&1)*32+(lane&3)*8+(4*hi+((lane&15)>>2))*64;
  typedef __attribute__((address_space(3))) unsigned long long* lds_u64p; typedef __attribute__((address_space(3))) u32x4* lds_v4p;
  bf16x8 qaug=bf16x8{}; const lds_cptr augp=(lds_cptr)shm+LDS_AUG+par*32768+r32*8;
  u32x4 av_[4];
  if(AUG){
    if(!primed){
    #pragma unroll
    for(int k_=0;k_<4;++k_){ const int i=tid+512*k_; if(i<NT*32) av_[k_]=*(const u32x4*)(aug+(long)i*8); } }
    if(hi==0){qaug[0]=(short)0x3F80;qaug[1]=(short)0x3F80;qaug[2]=(short)0x3F80;} }
  #define KAUG(t,w) ({ bf16x8 r_=bf16x8{}; if(AUG){ const unsigned long long u_=*(const __attribute__((address_space(3))) unsigned long long*)(augp+(t)*512+(w)*256); const u32x4 q_={(unsigned)u_,(unsigned)(u_>>32),0u,0u}; r_=__builtin_bit_cast(bf16x8,q_);} r_; })
  if(!primed){
  DMA_K(0,0);DMA_V(0,0);DMA_K(1,SLOTB);
  #pragma unroll
  for(int d0=0;d0<4;++d0)qr[d0]=*reinterpret_cast<const bf16x8*>(&Qw[(long)r32*ldq+d0*16+hi*8]);
  } else { DMA_V(0,0); }
  float mhat=0.f,l_reg=0.f;float z_=0.f;asm volatile("":"+v"(z_));f32x16 o[2];f32x16 negm;
  #pragma unroll
  for(int r=0;r<16;++r){o[0][r]=z_;o[1][r]=z_;negm[r]=z_;}
  asm volatile("":"+v"(negm));
  const int qrel=wid*QBLK+r32;
  #define CMASK(P0,P1,t) do{ if(CAUSAL){int jb_=(t)-(NT-4); if(jb_>=0)cmask(P0,P1,jb_,qrel,hi,wid);} }while(0)
  bool resc=false;
  #define START(P0,P1) do{ const float rm=rowmax(P0,P1); resc=false; \
    { const float dl=rm; mhat=fadd_s(mhat,dl); \
      _Pragma("unroll") for(int r=0;r<16;++r){P0[r]=fsub_s(P0[r],dl);P1[r]=fsub_s(P1[r],dl);} \
      _Pragma("unroll") for(int r=0;r<16;++r)negm[r]=-mhat; asm volatile("":"+v"(negm)); } \
    _Pragma("unroll") for(int r=0;r<16;++r)P0[r]=__builtin_amdgcn_exp2f(P0[r]); }while(0)
  #define RESC() do{ if(resc){ asm volatile("s_waitcnt lgkmcnt(0)":::"memory"); \
      _Pragma("unroll") for(int d_=0;d_<2;++d_) _Pragma("unroll") for(int r=0;r<16;++r)o[d_][r]*=wsf[crow(r,hi)]; } }while(0)
  f32x16 pA0,pA1,pB0,pB1;
  int sl_prev=0,sl_cur=0,sl_next=SLOTB;
  #define ROT() do{sl_prev=sl_cur;sl_cur=sl_next;sl_next=(sl_next==(NSLOT-1)*SLOTB)?0:sl_next+SLOTB;}while(0)
  if(!primed){
  DMA_K(2,2*SLOTB);
  if(AUG){ asm volatile("s_waitcnt vmcnt(0)":::"memory");
    #pragma unroll
    for(int k_=0;k_<4;++k_){ const int i=tid+512*k_; if(i<NT*32) *(lds_v4p)((lds_cptr)shm+LDS_AUG+par*32768+i*16)=av_[k_]; }
    WAIT_BAR(0); }
  else { WAIT_BAR(3); }
  } else { WAIT_BAR(1); }
  { const bf16x8 ka0_=KAUG(0,0),ka1_=KAUG(0,1); qkt<AUG>(pA0,pA1,Kbase,qr,negm,r32,hi,ka0_,ka1_,qaug); } asm volatile("s_nop 15\n\ts_nop 7":"+v"(pA0),"+v"(pA1));CMASK(pA0,pA1,0);
  START(pA0,pA1);
  _Pragma("unroll") for(int r=0;r<16;++r)pA1[r]=__builtin_amdgcn_exp2f(pA1[r]);
  WAIT_BAR(0);
  DMA_K(3,0);DMA_V(1,SLOTB);
  ROT();
  kload8(kf,kp0+sl_cur);
  WAIT_BAR(2);
  s16x4 vlo[8],vhi[8]; u32x4 pw0,pw1,pw2,pw3;
  #define PKW(P,B) cvtpk_s(P[B],P[B+1])
  #define PAF(k) __builtin_bit_cast(bf16x8,pw##k)
  #define VFR(i) (bf16x8){vlo[i][0],vlo[i][1],vlo[i][2],vlo[i][3],vhi[i][0],vhi[i][1],vhi[i][2],vhi[i][3]}
  #define PIN(x) asm volatile("":"+v"(x))
  #define MX3(a,b,c) __builtin_fmaxf(__builtin_fmaxf((a),(b)),(c))
  #define GAPA(MF,A0,A1,A2,A3,W0,W1,PW) do{ MF; sacc+=A0; sacc+=A1; sacc+=A2; sacc+=A3; PIN(sacc); W0; W1; PIN(PW); SBAR(); }while(0)
  #define EX(v) __builtin_amdgcn_exp2f(v)
  #define GAPB(MF,X,B) do{ MF; X[B]=EX(X[B]); X[B+1]=EX(X[B+1]); X[B+2]=EX(X[B+2]); X[B+3]=EX(X[B+3]); PIN(X); SBAR(); }while(0)
  #define VRD(i) do{ vlo[i]=vtr(vp_+(((i)>>2)*4096+((i)&3)*1024)); vhi[i]=vtr(vp_+(((i)>>2)*4096+((i)&3)*1024+512)); }while(0)
  #define KRD(G,j) do{ if(G){ kload2(kf,kp0+sl_next,j); SBAR(); } }while(0)
  #define STEP(C0,C1,P0,P1,t,GK,GV,GL) do{ SBAR(); \
    const lds_cptr vp_=vp0+sl_prev; bf16x8 ka0_=bf16x8{},ka1_=bf16x8{}; \
    VRD(0); SBAR(); float sacc=(P0[0]+P0[1]); \
    GAPA(C0=__builtin_amdgcn_mfma_f32_32x32x16_bf16(kf[0],qr[0],negm,0,0,0), P0[2],P0[3],P0[4],P0[5],     pw0[0]=PKW(P0,0), pw0[1]=PKW(P0,2), pw0); \
    VRD(4); SBAR(); GAPA(C1=__builtin_amdgcn_mfma_f32_32x32x16_bf16(kf[1],qr[0],negm,0,0,0), P0[6],P0[7],P0[8],P0[9],     pw0[2]=PKW(P0,4), pw0[3]=PKW(P0,6), pw0); \
    VRD(1); SBAR(); GAPA(C0=__builtin_amdgcn_mfma_f32_32x32x16_bf16(kf[2],qr[1],C0,0,0,0),   P0[10],P0[11],P0[12],P0[13], pw1[0]=PKW(P0,8), pw1[1]=PKW(P0,10), pw1); \
    VRD(5); SBAR(); GAPA(C1=__builtin_amdgcn_mfma_f32_32x32x16_bf16(kf[3],qr[1],C1,0,0,0),   P0[14],P0[15],P1[0],P1[1],   pw1[2]=PKW(P0,12),pw1[3]=PKW(P0,14), pw1); \
    VRD(2); SBAR(); GAPA(C0=__builtin_amdgcn_mfma_f32_32x32x16_bf16(kf[4],qr[2],C0,0,0,0),   P1[2],P1[3],P1[4],P1[5],     pw2[0]=PKW(P1,0), pw2[1]=PKW(P1,2), pw2); \
    VRD(6); SBAR(); GAPA(C1=__builtin_amdgcn_mfma_f32_32x32x16_bf16(kf[5],qr[2],C1,0,0,0),   P1[6],P1[7],P1[8],P1[9],     pw2[2]=PKW(P1,4), pw2[3]=PKW(P1,6), pw2); \
    if(AUG){ ka0_=KAUG(t,0); ka1_=KAUG(t,1); SBAR(); } \
    VRD(3); SBAR(); GAPA(C0=__builtin_amdgcn_mfma_f32_32x32x16_bf16(kf[6],qr[3],C0,0,0,0),   P1[10],P1[11],P1[12],P1[13], pw3[0]=PKW(P1,8), pw3[1]=PKW(P1,10), pw3); \
    VRD(7); SBAR(); GAPA(C1=__builtin_amdgcn_mfma_f32_32x32x16_bf16(kf[7],qr[3],C1,0,0,0),   P1[14],P1[15],0.f,0.f,       pw3[2]=PKW(P1,12),pw3[3]=PKW(P1,14), pw3); \
    if(AUG){ C0=__builtin_amdgcn_mfma_f32_32x32x16_bf16(ka0_,qaug,C0,0,0,0); C1=__builtin_amdgcn_mfma_f32_32x32x16_bf16(ka1_,qaug,C1,0,0,0); } \
    l_reg+=sacc; \
    if(GK){DMA_K((t)+3,sl_cur);} if(GV){DMA_V((t)+1,sl_next);} \
    CMASK(C0,C1,t); \
    { float a=MX3(C0[0],C0[1],C1[0]),b=MX3(C0[2],C0[3],C1[1]); a=MX3(a,C1[2],C1[3]); \
      _Pragma("unroll") for(int r=4;r<16;r+=4){a=MX3(a,C0[r],C0[r+1]);b=MX3(b,C0[r+2],C0[r+3]);a=MX3(a,C1[r],C1[r+1]);b=MX3(b,C1[r+2],C1[r+3]);} \
      float rm=__builtin_fmaxf(a,b); { auto rr=__builtin_amdgcn_permlane32_swap(__float_as_uint(rm),__float_as_uint(rm),false,false); rm=__builtin_fmaxf(__uint_as_float(rr[0]),__uint_as_float(rr[1])); } \
      resc=false; \
      if(__builtin_expect(__any(rm>(float)THRL),0)){ const float dl=__builtin_fmaxf(rm,0.f); mhat+=dl; \
        _Pragma("unroll") for(int r=0;r<16;++r){C0[r]-=dl;C1[r]-=dl;} \
        _Pragma("unroll") for(int r=0;r<16;++r)negm[r]=-mhat; asm volatile("":"+v"(negm)); \
        const float f=__builtin_amdgcn_exp2f(-dl); l_reg*=f; if(hi==0)wsf[r32]=f; resc=true; } } \
    SBAR(); \
    GAPB(o[0]=__builtin_amdgcn_mfma_f32_32x32x16_bf16(PAF(0),VFR(0),o[0],0,0,0), C0,0); \
    GAPB(o[1]=__builtin_amdgcn_mfma_f32_32x32x16_bf16(PAF(0),VFR(4),o[1],0,0,0), C0,4); \
    KRD(GL,0); GAPB(o[0]=__builtin_amdgcn_mfma_f32_32x32x16_bf16(PAF(1),VFR(1),o[0],0,0,0), C0,8); \
    KRD(GL,1); GAPB(o[1]=__builtin_amdgcn_mfma_f32_32x32x16_bf16(PAF(1),VFR(5),o[1],0,0,0), C0,12); \
    KRD(GL,2); GAPB(o[0]=__builtin_amdgcn_mfma_f32_32x32x16_bf16(PAF(2),VFR(2),o[0],0,0,0), C1,0); \
    KRD(GL,3); GAPB(o[1]=__builtin_amdgcn_mfma_f32_32x32x16_bf16(PAF(2),VFR(6),o[1],0,0,0), C1,4); \
    GAPB(o[0]=__builtin_amdgcn_mfma_f32_32x32x16_bf16(PAF(3),VFR(3),o[0],0,0,0), C1,8); \
    GAPB(o[1]=__builtin_amdgcn_mfma_f32_32x32x16_bf16(PAF(3),VFR(7),o[1],0,0,0), C1,12); \
    }while(0)
  int t=1;
  #undef CMASK
  #define CMASK(P0,P1,t) do{}while(0)
  for(;t+5<NT;t+=2){
    STEP(pB0,pB1,pA0,pA1,t,true,true,true);     WAIT_BAR(2); RESC(); ROT();
    STEP(pA0,pA1,pB0,pB1,t+1,true,true,true);   WAIT_BAR(2); RESC(); ROT();
  }
  #undef CMASK
  #define CMASK(P0,P1,t) do{ if(CAUSAL){int jb_=(t)-(NT-4); if(jb_>=0)cmask(P0,P1,jb_,qrel,hi,wid);} }while(0)
  #define ENDW(tt) do{ if((tt)+3<NT){WAIT_BAR(2);} else if((tt)+2<NT){WAIT_BAR(1);} else {WAIT_BAR(0);} }while(0)
  for(;t+1<NT;t+=2){
    STEP(pB0,pB1,pA0,pA1,t,(t+3<NT),(t+1<NT),(t+1<NT));       ENDW(t);   RESC(); ROT();
    STEP(pA0,pA1,pB0,pB1,t+1,(t+4<NT),(t+2<NT),(t+2<NT));     ENDW(t+1); RESC(); ROT();
  }
  if(Qn){ const bf16*ksn=Kn+(long)lane*ldk+wid*8;
    glds16(ksn,(unsigned)__builtin_amdgcn_readfirstlane(kdst)); glds16(ksn+(long)KVBLK*ldk,(unsigned)__builtin_amdgcn_readfirstlane(kdst+SLOTB)); glds16(ksn+2L*KVBLK*ldk,(unsigned)__builtin_amdgcn_readfirstlane(kdst+2*SLOTB)); }
  STEP(pB0,pB1,pA0,pA1,NT-1,false,false,false); RESC();
  if(Qn){ const bf16*Qwn=Qn+(long)(wid*QBLK)*ldq;
    #pragma unroll
    for(int d0=0;d0<4;++d0)qr[d0]=*reinterpret_cast<const bf16x8*>(&Qwn[(long)r32*ldq+d0*16+hi*8]);
    if(AUG){
      #pragma unroll
      for(int k_=0;k_<4;++k_){ const int i=tid+512*k_; if(i<NTn*32) av_[k_]=*(const u32x4*)(augn+(long)i*8); } } }
  { float sacc=pB0[0]+pB0[1]; _Pragma("unroll") for(int r=2;r<16;++r)sacc+=pB0[r]; _Pragma("unroll") for(int r=0;r<16;++r)sacc+=pB1[r]; l_reg+=sacc;
    pw0=(u32x4){PKW(pB0,0),PKW(pB0,2),PKW(pB0,4),PKW(pB0,6)};pw1=(u32x4){PKW(pB0,8),PKW(pB0,10),PKW(pB0,12),PKW(pB0,14)};pw2=(u32x4){PKW(pB1,0),PKW(pB1,2),PKW(pB1,4),PKW(pB1,6)};pw3=(u32x4){PKW(pB1,8),PKW(pB1,10),PKW(pB1,12),PKW(pB1,14)};
    SBAR(); pv(o,vb0+sl_cur,PAF(0),PAF(1),PAF(2),PAF(3)); }
  #undef PKW
  #undef PAF
  #undef VFR
  #undef PIN
  #undef MX3
  #undef GAPA
  #undef GAPB
  #undef EX
  #undef VRD
  #undef KRD
  #undef STEP
  #undef ENDW
  {auto rr=__builtin_amdgcn_permlane32_swap(__float_as_uint(l_reg),__float_as_uint(l_reg),false,false);l_reg=__uint_as_float(rr[0])+__uint_as_float(rr[1]);}
  if(hi==0)wsf[32+r32]=l_reg;asm volatile("s_waitcnt lgkmcnt(0)":::"memory");
  float rli[16];
  #pragma unroll
  for(int r=0;r<16;++r)rli[r]=__builtin_amdgcn_rcpf(wsf[32+crow(r,hi)]);
  bf16*Ow=Ou+(long)(wid*QBLK)*ldo;
  { bf16*stg=(bf16*)(shm+LDS_OST)+wid*2048;
    #pragma unroll
    for(int r=0;r<16;++r){const int orow=crow(r,hi);
      #pragma unroll
      for(int d0=0;d0<2;++d0)stg[orow*64+d0*32+r32]=f2bf(o[d0][r]*rli[r]);}
    asm volatile("s_waitcnt lgkmcnt(0)":::"memory");
    #pragma unroll
    for(int i=0;i<4;++i){const int row=i*8+(lane>>3),ch=lane&7; const u32x4 v=*(const u32x4*)(stg+row*64+ch*8); ATTN_STORE16(Ow+(long)row*ldo+ch*8,v);} }
  if(AUG&&Qn){
    #pragma unroll
    for(int k_=0;k_<4;++k_){ const int i=tid+512*k_; if(i<NTn*32) *(lds_v4p)((lds_cptr)shm+LDS_AUG+(par^1)*32768+i*16)=av_[k_]; } }
  asm volatile("s_waitcnt lgkmcnt(0)\n\ts_barrier":::"memory");
  #undef DMA_K
  #undef DMA_V
  #undef KAUG
  #undef CMASK
  #undef START
  #undef RESC
  #undef ROT
}
template<int THRL> __device__ __forceinline__ void attn_unit128(const bf16*Qu,int ldq,const bf16*__restrict__ Kh,int ldk,const bf16*__restrict__ Vh,int ldv,bf16*Ou,int ldo,const bf16*__restrict__ aug,int NT,char*shm,bf16x8(&qr)[4],bool primed,int par,const bf16*Qn,const bf16*Kn,const bf16*augn,int NTn,int mode,float lam,const float*gsub){
  u32x4 av_[4]; (void)av_;
  constexpr bool CAUSAL=true, AUG=false; constexpr int LDS_WS=LDS_V+3*16384, LDS_OST=LDS_WS+NW*64*4;
  int tid_=threadIdx.x; asm volatile("":"+v"(tid_));
  const int tid=tid_,lane=tid&63,r32=lane&31,hi=lane>>5; const int wid=__builtin_amdgcn_readfirstlane(tid>>6);
  const bf16*Qw=Qu+(long)(wid*QBLK)*ldq;
  const unsigned lds0=(unsigned)(uintptr_t)shm;
  float*wsf=(float*)(shm+LDS_WS)+wid*64;
  const bf16*ksrc=Kh+(long)lane*ldk+wid*8;
  const bf16*vsrc=Vh+(long)(16*(wid&3)+(lane>>2))*ldv+(wid>>2)*32+(lane&3)*8;
  const unsigned kdst=lds0+LDS_K+wid*1024, vdst=lds0+LDS_V+wid*1024;
  #define DMA_K(t,slot) glds16(ksrc+(long)(t)*KVBLK*ldk,(unsigned)__builtin_amdgcn_readfirstlane(kdst+(slot)))
  #define DMA_V(t,slot) do{ glds16(vsrc+(long)(t)*KVBLK*ldv,(unsigned)__builtin_amdgcn_readfirstlane(vdst+2*(slot))); glds16(vsrc+(long)(t)*KVBLK*ldv+64,(unsigned)__builtin_amdgcn_readfirstlane(vdst+2*(slot)+8192)); }while(0)
  const int vb0=(int)(lds0+LDS_V)+((lane>>4)&1)*32+(lane&3)*8+(4*hi+((lane&15)>>2))*64;
  const char*Kbase=shm+LDS_K; bf16x8 kf[8];
  const lds_cptr shm3=(lds_cptr)shm; const lds_cptr kp0=shm3+LDS_K+hi*1024+r32*16; const lds_cptr vp0=shm3+LDS_V+((lane>>4)&1)*32+(lane&3)*8+(4*hi+((lane&15)>>2))*64;
  typedef __attribute__((address_space(3))) unsigned long long* lds_u64p; typedef __attribute__((address_space(3))) u32x4* lds_v4p;
  bf16x8 qaug=bf16x8{}; const lds_cptr augp=(lds_cptr)shm+LDS_AUG+par*32768+r32*8;
  if(AUG){ for(int i=tid;i<NT*32;i+=512){ const u32x4 v=*(const u32x4*)(aug+(long)i*8); *(lds_v4p)((lds_cptr)shm+LDS_AUG+i*16)=v; }
    asm volatile("s_waitcnt vmcnt(0)":::"memory");
    if(hi==0){qaug[0]=(short)0x3F80;qaug[1]=(short)0x3F80;qaug[2]=(short)0x3F80;} }
  #define KAUG(t,w) ({ bf16x8 r_=bf16x8{}; if(AUG){ const unsigned long long u_=*(const __attribute__((address_space(3))) unsigned long long*)(augp+(t)*512+(w)*256); const u32x4 q_={(unsigned)u_,(unsigned)(u_>>32),0u,0u}; r_=__builtin_bit_cast(bf16x8,q_);} r_; })
  if(!primed){
  DMA_K(0,0);DMA_V(0,0);DMA_K(1,SLOTB);
  #pragma unroll
  for(int d0=0;d0<4;++d0)qr[d0]=*reinterpret_cast<const bf16x8*>(&Qw[(long)r32*ldq+d0*16+hi*8]);
  } else { DMA_V(0,0); }
  float mhat=0.f,l_reg=0.f;float z_=0.f;asm volatile("":"+v"(z_));f32x16 o[4];f32x16 negm;
  #pragma unroll
  for(int r=0;r<16;++r){o[0][r]=z_;o[1][r]=z_;o[2][r]=z_;o[3][r]=z_;negm[r]=z_;}
  asm volatile("":"+v"(negm));
  const int qrel=wid*QBLK+r32;
  #define CMASK(P0,P1,t) do{ if(CAUSAL){int jb_=(t)-(NT-4); if(jb_>=0)cmask(P0,P1,jb_,qrel,hi,wid);} }while(0)
  bool resc=false;
  #define START(P0,P1) do{ const float rm=rowmax(P0,P1); resc=false; \
    { const float dl=rm; mhat=fadd_s(mhat,dl); \
      _Pragma("unroll") for(int r=0;r<16;++r){P0[r]=fsub_s(P0[r],dl);P1[r]=fsub_s(P1[r],dl);} \
      _Pragma("unroll") for(int r=0;r<16;++r)negm[r]=-mhat; asm volatile("":"+v"(negm)); } \
    _Pragma("unroll") for(int r=0;r<16;++r)P0[r]=__builtin_amdgcn_exp2f(P0[r]); }while(0)
  #define RESC() do{ if(resc){ asm volatile("s_waitcnt lgkmcnt(0)":::"memory"); \
      _Pragma("unroll") for(int d_=0;d_<4;++d_) _Pragma("unroll") for(int r=0;r<16;++r)o[d_][r]*=wsf[crow(r,hi)]; } }while(0)
  f32x16 pA0,pA1,pB0,pB1;
  int sl_prev=0,sl_cur=0,sl_next=SLOTB;
  #define ROT() do{sl_prev=sl_cur;sl_cur=sl_next;sl_next=(sl_next==(NSLOT-1)*SLOTB)?0:sl_next+SLOTB;}while(0)
  if(!primed){
  DMA_K(2,2*SLOTB);
  WAIT_BAR(4);
  } else { WAIT_BAR(2); }
  { const bf16x8 ka0_=KAUG(0,0),ka1_=KAUG(0,1); qkt<AUG>(pA0,pA1,Kbase,qr,negm,r32,hi,ka0_,ka1_,qaug); } asm volatile("s_nop 15\n\ts_nop 7":"+v"(pA0),"+v"(pA1));CMASK(pA0,pA1,0);
  START(pA0,pA1);
  _Pragma("unroll") for(int r=0;r<16;++r)pA1[r]=__builtin_amdgcn_exp2f(pA1[r]);
  WAIT_BAR(0);
  DMA_K(3,0);DMA_V(1,SLOTB);
  ROT();
  kload8(kf,kp0+sl_cur);
  WAIT_BAR(3);
  s16x4 vlo[8],vhi[8],wlo[8],whi[8]; u32x4 pw0,pw1,pw2,pw3;
  #define PKW(P,B) cvtpk_s(P[B],P[B+1])
  #define PAF(k) __builtin_bit_cast(bf16x8,pw##k)
  #define VFR(i) (bf16x8){vlo[i][0],vlo[i][1],vlo[i][2],vlo[i][3],vhi[i][0],vhi[i][1],vhi[i][2],vhi[i][3]}
  #define WFR(i) (bf16x8){wlo[i][0],wlo[i][1],wlo[i][2],wlo[i][3],whi[i][0],whi[i][1],whi[i][2],whi[i][3]}
  #define PIN(x) asm volatile("":"+v"(x))
  #define MX3(a,b,c) __builtin_fmaxf(__builtin_fmaxf((a),(b)),(c))
  #define GAPA(MF,A0,A1,A2,A3,W0,W1,PW) do{ MF; sacc+=A0; sacc+=A1; sacc+=A2; sacc+=A3; PIN(sacc); W0; W1; PIN(PW); SBAR(); }while(0)
  #define EX(v) __builtin_amdgcn_exp2f(v)
  #define GAPB(MF,X,B) do{ MF; X[B]=EX(X[B]); X[B+1]=EX(X[B+1]); PIN(X); SBAR(); }while(0)
  #define VRD(i) do{ vlo[i]=vtr(vp_+(((i)>>2)*4096+((i)&3)*1024)); vhi[i]=vtr(vp_+(((i)>>2)*4096+((i)&3)*1024+512)); }while(0)
  #define WRD(i) do{ wlo[i]=vtr(vp_+(8192+((i)>>2)*4096+((i)&3)*1024)); whi[i]=vtr(vp_+(8192+((i)>>2)*4096+((i)&3)*1024+512)); SBAR(); }while(0)
  #define KRD(G,j) do{ if(G){ kload2(kf,kp0+sl_next,j); SBAR(); } }while(0)
  #define STEP(C0,C1,P0,P1,t,GK,GV,GL) do{ SBAR(); \
    const lds_cptr vp_=vp0+2*sl_prev; bf16x8 ka0_=bf16x8{},ka1_=bf16x8{}; \
    VRD(0); SBAR(); float sacc=(P0[0]+P0[1]); \
    GAPA(C0=__builtin_amdgcn_mfma_f32_32x32x16_bf16(kf[0],qr[0],negm,0,0,0), P0[2],P0[3],P0[4],P0[5],     pw0[0]=PKW(P0,0), pw0[1]=PKW(P0,2), pw0); \
    VRD(4); SBAR(); GAPA(C1=__builtin_amdgcn_mfma_f32_32x32x16_bf16(kf[1],qr[0],negm,0,0,0), P0[6],P0[7],P0[8],P0[9],     pw0[2]=PKW(P0,4), pw0[3]=PKW(P0,6), pw0); \
    VRD(1); SBAR(); GAPA(C0=__builtin_amdgcn_mfma_f32_32x32x16_bf16(kf[2],qr[1],C0,0,0,0),   P0[10],P0[11],P0[12],P0[13], pw1[0]=PKW(P0,8), pw1[1]=PKW(P0,10), pw1); \
    VRD(5); SBAR(); GAPA(C1=__builtin_amdgcn_mfma_f32_32x32x16_bf16(kf[3],qr[1],C1,0,0,0),   P0[14],P0[15],P1[0],P1[1],   pw1[2]=PKW(P0,12),pw1[3]=PKW(P0,14), pw1); \
    VRD(2); SBAR(); GAPA(C0=__builtin_amdgcn_mfma_f32_32x32x16_bf16(kf[4],qr[2],C0,0,0,0),   P1[2],P1[3],P1[4],P1[5],     pw2[0]=PKW(P1,0), pw2[1]=PKW(P1,2), pw2); \
    VRD(6); SBAR(); GAPA(C1=__builtin_amdgcn_mfma_f32_32x32x16_bf16(kf[5],qr[2],C1,0,0,0),   P1[6],P1[7],P1[8],P1[9],     pw2[2]=PKW(P1,4), pw2[3]=PKW(P1,6), pw2); \
    if(AUG){ ka0_=KAUG(t,0); ka1_=KAUG(t,1); SBAR(); } \
    VRD(3); SBAR(); GAPA(C0=__builtin_amdgcn_mfma_f32_32x32x16_bf16(kf[6],qr[3],C0,0,0,0),   P1[10],P1[11],P1[12],P1[13], pw3[0]=PKW(P1,8), pw3[1]=PKW(P1,10), pw3); \
    VRD(7); SBAR(); GAPA(C1=__builtin_amdgcn_mfma_f32_32x32x16_bf16(kf[7],qr[3],C1,0,0,0),   P1[14],P1[15],0.f,0.f,       pw3[2]=PKW(P1,12),pw3[3]=PKW(P1,14), pw3); \
    if(AUG){ C0=__builtin_amdgcn_mfma_f32_32x32x16_bf16(ka0_,qaug,C0,0,0,0); C1=__builtin_amdgcn_mfma_f32_32x32x16_bf16(ka1_,qaug,C1,0,0,0); } \
    l_reg+=sacc; \
    if(GK){DMA_K((t)+3,sl_cur);} if(GV){DMA_V((t)+1,sl_next);} \
    CMASK(C0,C1,t); \
    { float a=MX3(C0[0],C0[1],C1[0]),b=MX3(C0[2],C0[3],C1[1]); a=MX3(a,C1[2],C1[3]); \
      _Pragma("unroll") for(int r=4;r<16;r+=4){a=MX3(a,C0[r],C0[r+1]);b=MX3(b,C0[r+2],C0[r+3]);a=MX3(a,C1[r],C1[r+1]);b=MX3(b,C1[r+2],C1[r+3]);} \
      float rm=__builtin_fmaxf(a,b); { auto rr=__builtin_amdgcn_permlane32_swap(__float_as_uint(rm),__float_as_uint(rm),false,false); rm=__builtin_fmaxf(__uint_as_float(rr[0]),__uint_as_float(rr[1])); } \
      resc=false; \
      if(__builtin_expect(__any(rm>(float)THRL),0)){ const float dl=__builtin_fmaxf(rm,0.f); mhat+=dl; \
        _Pragma("unroll") for(int r=0;r<16;++r){C0[r]-=dl;C1[r]-=dl;} \
        _Pragma("unroll") for(int r=0;r<16;++r)negm[r]=-mhat; asm volatile("":"+v"(negm)); \
        const float f=__builtin_amdgcn_exp2f(-dl); l_reg*=f; if(hi==0)wsf[r32]=f; resc=true; } } \
    SBAR(); \
    WRD(0); GAPB(o[0]=__builtin_amdgcn_mfma_f32_32x32x16_bf16(PAF(0),VFR(0),o[0],0,0,0), C0,0); \
    WRD(4); GAPB(o[1]=__builtin_amdgcn_mfma_f32_32x32x16_bf16(PAF(0),VFR(4),o[1],0,0,0), C0,2); \
    WRD(1); GAPB(o[0]=__builtin_amdgcn_mfma_f32_32x32x16_bf16(PAF(1),VFR(1),o[0],0,0,0), C0,4); \
    WRD(5); GAPB(o[1]=__builtin_amdgcn_mfma_f32_32x32x16_bf16(PAF(1),VFR(5),o[1],0,0,0), C0,6); \
    WRD(2); GAPB(o[0]=__builtin_amdgcn_mfma_f32_32x32x16_bf16(PAF(2),VFR(2),o[0],0,0,0), C0,8); \
    WRD(6); GAPB(o[1]=__builtin_amdgcn_mfma_f32_32x32x16_bf16(PAF(2),VFR(6),o[1],0,0,0), C0,10); \
    WRD(3); GAPB(o[0]=__builtin_amdgcn_mfma_f32_32x32x16_bf16(PAF(3),VFR(3),o[0],0,0,0), C0,12); \
    WRD(7); GAPB(o[1]=__builtin_amdgcn_mfma_f32_32x32x16_bf16(PAF(3),VFR(7),o[1],0,0,0), C0,14); \
    GAPB(o[2]=__builtin_amdgcn_mfma_f32_32x32x16_bf16(PAF(0),WFR(0),o[2],0,0,0), C1,0); \
    GAPB(o[3]=__builtin_amdgcn_mfma_f32_32x32x16_bf16(PAF(0),WFR(4),o[3],0,0,0), C1,2); \
    KRD(GL,0); GAPB(o[2]=__builtin_amdgcn_mfma_f32_32x32x16_bf16(PAF(1),WFR(1),o[2],0,0,0), C1,4); \
    KRD(GL,1); GAPB(o[3]=__builtin_amdgcn_mfma_f32_32x32x16_bf16(PAF(1),WFR(5),o[3],0,0,0), C1,6); \
    KRD(GL,2); GAPB(o[2]=__builtin_amdgcn_mfma_f32_32x32x16_bf16(PAF(2),WFR(2),o[2],0,0,0), C1,8); \
    KRD(GL,3); GAPB(o[3]=__builtin_amdgcn_mfma_f32_32x32x16_bf16(PAF(2),WFR(6),o[3],0,0,0), C1,10); \
    GAPB(o[2]=__builtin_amdgcn_mfma_f32_32x32x16_bf16(PAF(3),WFR(3),o[2],0,0,0), C1,12); \
    GAPB(o[3]=__builtin_amdgcn_mfma_f32_32x32x16_bf16(PAF(3),WFR(7),o[3],0,0,0), C1,14); \
    }while(0)
  int t=1;
  #undef CMASK
  #define CMASK(P0,P1,t) do{}while(0)
  for(;t+5<NT;t+=2){
    STEP(pB0,pB1,pA0,pA1,t,true,true,true);     WAIT_BAR(3); RESC(); ROT();
    STEP(pA0,pA1,pB0,pB1,t+1,true,true,true);   WAIT_BAR(3); RESC(); ROT();
  }
  #undef CMASK
  #define CMASK(P0,P1,t) do{ if(CAUSAL){int jb_=(t)-(NT-4); if(jb_>=0)cmask(P0,P1,jb_,qrel,hi,wid);} }while(0)
  #define ENDW(tt) do{ if((tt)+3<NT){WAIT_BAR(3);} else if((tt)+2<NT){WAIT_BAR(2);} else {WAIT_BAR(0);} }while(0)
  for(;t+1<NT;t+=2){
    STEP(pB0,pB1,pA0,pA1,t,(t+3<NT),(t+1<NT),(t+1<NT));       ENDW(t);   RESC(); ROT();
    STEP(pA0,pA1,pB0,pB1,t+1,(t+4<NT),(t+2<NT),(t+2<NT));     ENDW(t+1); RESC(); ROT();
  }
  if(Qn){ const bf16*ksn=Kn+(long)lane*ldk+wid*8;
    glds16(ksn,(unsigned)__builtin_amdgcn_readfirstlane(kdst)); glds16(ksn+(long)KVBLK*ldk,(unsigned)__builtin_amdgcn_readfirstlane(kdst+SLOTB)); glds16(ksn+2L*KVBLK*ldk,(unsigned)__builtin_amdgcn_readfirstlane(kdst+2*SLOTB)); }
  STEP(pB0,pB1,pA0,pA1,NT-1,false,false,false); RESC();
  if(Qn){ const bf16*Qwn=Qn+(long)(wid*QBLK)*ldq;
    #pragma unroll
    for(int d0=0;d0<4;++d0)qr[d0]=*reinterpret_cast<const bf16x8*>(&Qwn[(long)r32*ldq+d0*16+hi*8]);
    if(AUG){
      #pragma unroll
      for(int k_=0;k_<4;++k_){ const int i=tid+512*k_; if(i<NTn*32) av_[k_]=*(const u32x4*)(augn+(long)i*8); } } }
  { float sacc=pB0[0]+pB0[1]; _Pragma("unroll") for(int r=2;r<16;++r)sacc+=pB0[r]; _Pragma("unroll") for(int r=0;r<16;++r)sacc+=pB1[r]; l_reg+=sacc;
    pw0=(u32x4){PKW(pB0,0),PKW(pB0,2),PKW(pB0,4),PKW(pB0,6)};pw1=(u32x4){PKW(pB0,8),PKW(pB0,10),PKW(pB0,12),PKW(pB0,14)};pw2=(u32x4){PKW(pB1,0),PKW(pB1,2),PKW(pB1,4),PKW(pB1,6)};pw3=(u32x4){PKW(pB1,8),PKW(pB1,10),PKW(pB1,12),PKW(pB1,14)};
    SBAR(); pv(o,vb0+2*sl_cur,PAF(0),PAF(1),PAF(2),PAF(3)); pv(o+2,vb0+2*sl_cur+8192,PAF(0),PAF(1),PAF(2),PAF(3)); }
  #undef PKW
  #undef PAF
  #undef VFR
  #undef WFR
  #undef WRD
  #undef PIN
  #undef MX3
  #undef GAPA
  #undef GAPB
  #undef EX
  #undef VRD
  #undef KRD
  #undef STEP
  #undef ENDW
  {auto rr=__builtin_amdgcn_permlane32_swap(__float_as_uint(l_reg),__float_as_uint(l_reg),false,false);l_reg=__uint_as_float(rr[0])+__uint_as_float(rr[1]);}
  if(hi==0)wsf[32+r32]=l_reg;asm volatile("s_waitcnt lgkmcnt(0)":::"memory");
  float rli[16];
  #pragma unroll
  for(int r=0;r<16;++r)rli[r]=__builtin_amdgcn_rcpf(wsf[32+crow(r,hi)]);
  bf16*Ow=Ou+(long)(wid*QBLK)*ldo;
  { bf16*stg=(bf16*)(shm+LDS_OST)+wid*4096;
    if(mode!=2){
      #pragma unroll
      for(int r=0;r<16;++r){const int orow=crow(r,hi);
        #pragma unroll
        for(int d0=0;d0<4;++d0)stg[orow*128+d0*32+r32]=f2bf(o[d0][r]*rli[r]);}
      asm volatile("s_waitcnt lgkmcnt(0)":::"memory");
      if(mode==0){
        #pragma unroll
        for(int i=0;i<8;++i){const int row=i*4+(lane>>4),ch=lane&15; const u32x4 v=*(const u32x4*)(stg+row*128+ch*8); ATTN_STORE16(Ow+(long)row*ldo+ch*8,v);} }
    } else {
      #pragma unroll
      for(int r=0;r<16;++r){const int orow=crow(r,hi);
        #pragma unroll
        for(int d0=0;d0<4;++d0){ const int ix=orow*128+d0*32+r32; const float a1=bf2f(stg[ix]); stg[ix]=f2bf(a1-lam*(o[d0][r]*rli[r])); } }
      asm volatile("s_waitcnt lgkmcnt(0)":::"memory");
      const int ch=lane&15; float gsv[8];
      #pragma unroll
      for(int q=0;q<8;++q)gsv[q]=gsub[ch*8+q]*0.8f;
      #pragma unroll
      for(int i=0;i<8;++i){const int row=i*4+(lane>>4); const u32x4 v=*(const u32x4*)(stg+row*128+ch*8);
        const unsigned w_[4]={v.x,v.y,v.z,v.w}; float f[8]; float ss=0.f;
        #pragma unroll
        for(int q=0;q<4;++q){ f[2*q]=__uint_as_float(w_[q]<<16); f[2*q+1]=__uint_as_float(w_[q]&0xffff0000u); ss+=f[2*q]*f[2*q]+f[2*q+1]*f[2*q+1]; }
        ss+=__shfl_xor(ss,1); ss+=__shfl_xor(ss,2); ss+=__shfl_xor(ss,4); ss+=__shfl_xor(ss,8);
        const float rstd=rsqrtf(ss*(1.f/128.f)+1e-5f);
        u32x4 w; w.x=cvtpk_s(f[0]*rstd*gsv[0],f[1]*rstd*gsv[1]); w.y=cvtpk_s(f[2]*rstd*gsv[2],f[3]*rstd*gsv[3]); w.z=cvtpk_s(f[4]*rstd*gsv[4],f[5]*rstd*gsv[5]); w.w=cvtpk_s(f[6]*rstd*gsv[6],f[7]*rstd*gsv[7]);
        ATTN_STORE16(Ow+(long)row*ldo+ch*8,w); }
    } }
  asm volatile("s_waitcnt lgkmcnt(0)\n\ts_barrier":::"memory");
  #undef DMA_K
  #undef DMA_V
  #undef KAUG
  #undef CMASK
  #undef START
  #undef RESC
  #undef ROT
}

__device__ __forceinline__ void cross_panel(const bf16*Qp,int ldq,const bf16*__restrict__ Kp,int ldk,const bf16*__restrict__ Vp,int ldv,bf16*Op,int ldo,char*shm){
  int tid_=threadIdx.x; asm volatile("":"+v"(tid_));
  const int tid=tid_,lane=tid&63,r32=lane&31,hi=lane>>5; const int wid=__builtin_amdgcn_readfirstlane(tid>>6);
  const unsigned lds0=(unsigned)(uintptr_t)shm;
  float*wsf=(float*)(shm+147456)+wid*64;
  bf16*stg=(bf16*)(shm+131072)+wid*1024;
  const bf16*ksrc0=Kp+(long)lane*ldk+wid*8;
  const bf16*vsrc0=Vp+(long)(16*(wid&3)+(lane>>2))*ldv+(wid>>2)*32+(lane&3)*8;
  const int vlane=((lane>>4)&1)*32+(lane&3)*8+(4*hi+((lane&15)>>2))*64;
  #define XDMA(h_,b_) do{ _Pragma("unroll") for(int t_=0;t_<4;++t_){ \
      glds16(ksrc0+(h_)*64+(long)t_*64*ldk,(unsigned)__builtin_amdgcn_readfirstlane(lds0+(b_)*65536+t_*8192+wid*1024)); \
      glds16(vsrc0+(h_)*64+(long)t_*64*ldv,(unsigned)__builtin_amdgcn_readfirstlane(lds0+(b_)*65536+32768+t_*8192+wid*1024)); } }while(0)
  XDMA(0,0);
  float z_=0.f;asm volatile("":"+v"(z_));
  #pragma nounroll
  for(int h=0;h<4;++h){ const int b=h&1;
    bf16x8 qr[4]; const bf16*Qw=Qp+(long)(wid*QBLK)*ldq+h*64;
    #pragma unroll
    for(int d0=0;d0<4;++d0)qr[d0]=*reinterpret_cast<const bf16x8*>(&Qw[(long)r32*ldq+d0*16+hi*8]);
    asm volatile("s_waitcnt vmcnt(0) lgkmcnt(0)\n\ts_barrier":::"memory");
    if(h<3)XDMA(h+1,b^1);
    f32x16 o[2],zero; float l=0.f;
    #pragma unroll
    for(int r=0;r<16;++r){o[0][r]=z_;o[1][r]=z_;zero[r]=z_;}
    f32x16 s0[4],s1[4];
    #pragma unroll
    for(int t=0;t<4;++t) qkt<false>(s0[t],s1[t],shm+b*65536+t*8192,qr,zero,r32,hi,bf16x8{},bf16x8{},bf16x8{});
    #define MX3_(a,b,c) __builtin_fmaxf(__builtin_fmaxf((a),(b)),(c))
    float mA=MX3_(s0[0][0],s0[0][1],s1[0][0]),mB=MX3_(s0[0][2],s0[0][3],s1[0][1]); mA=MX3_(mA,s1[0][2],s1[0][3]);
    #pragma unroll
    for(int t=0;t<4;++t)
      #pragma unroll
      for(int r=(t==0?4:0);r<16;r+=4){mA=MX3_(mA,s0[t][r],s0[t][r+1]);mB=MX3_(mB,s0[t][r+2],s0[t][r+3]);mA=MX3_(mA,s1[t][r],s1[t][r+1]);mB=MX3_(mB,s1[t][r+2],s1[t][r+3]);}
    #undef MX3_
    float mn=__builtin_fmaxf(mA,mB);
    {auto rr=__builtin_amdgcn_permlane32_swap(__float_as_uint(mn),__float_as_uint(mn),false,false);mn=__builtin_fmaxf(__uint_as_float(rr[0]),__uint_as_float(rr[1]));}
    #pragma unroll
    for(int t=0;t<4;++t){
      float rs=0.f;
      #pragma unroll
      for(int r=0;r<16;++r){s0[t][r]=__builtin_amdgcn_exp2f(s0[t][r]-mn);s1[t][r]=__builtin_amdgcn_exp2f(s1[t][r]-mn);rs+=s0[t][r]+s1[t][r];}
      l+=rs;
      const u32x4 pw0={cvtpk_s(s0[t][0],s0[t][1]),cvtpk_s(s0[t][2],s0[t][3]),cvtpk_s(s0[t][4],s0[t][5]),cvtpk_s(s0[t][6],s0[t][7])},pw1={cvtpk_s(s0[t][8],s0[t][9]),cvtpk_s(s0[t][10],s0[t][11]),cvtpk_s(s0[t][12],s0[t][13]),cvtpk_s(s0[t][14],s0[t][15])};
      const u32x4 pw2={cvtpk_s(s1[t][0],s1[t][1]),cvtpk_s(s1[t][2],s1[t][3]),cvtpk_s(s1[t][4],s1[t][5]),cvtpk_s(s1[t][6],s1[t][7])},pw3={cvtpk_s(s1[t][8],s1[t][9]),cvtpk_s(s1[t][10],s1[t][11]),cvtpk_s(s1[t][12],s1[t][13]),cvtpk_s(s1[t][14],s1[t][15])};
      SBAR(); pv(o,(int)(lds0+b*65536+32768+t*8192)+vlane,__builtin_bit_cast(bf16x8,pw0),__builtin_bit_cast(bf16x8,pw1),__builtin_bit_cast(bf16x8,pw2),__builtin_bit_cast(bf16x8,pw3));
    }
    {auto rr=__builtin_amdgcn_permlane32_swap(__float_as_uint(l),__float_as_uint(l),false,false);l=__uint_as_float(rr[0])+__uint_as_float(rr[1]);}
    if(hi==0)wsf[32+r32]=l;asm volatile("s_waitcnt lgkmcnt(0)":::"memory");
    float rli[16];
    #pragma unroll
    for(int r=0;r<16;++r)rli[r]=__builtin_amdgcn_rcpf(wsf[32+crow(r,hi)]);
    bf16*Ow=Op+(long)(wid*QBLK)*ldo+h*64;
    #pragma unroll
    for(int d0=0;d0<2;++d0){
      #pragma unroll
      for(int r=0;r<16;++r)stg[crow(r,hi)*32+r32]=f2bf(o[d0][r]*rli[r]);
      asm volatile("s_waitcnt lgkmcnt(0)":::"memory");
      #pragma unroll
      for(int i=0;i<2;++i){const int row=i*16+(lane>>2),ch=lane&3; const u32x4 v=*(const u32x4*)(stg+row*32+ch*8); *(u32x4*)(Ow+(long)row*ldo+d0*32+ch*8)=v;}
      asm volatile("s_waitcnt lgkmcnt(0)":::"memory");
    }
  }
  asm volatile("s_waitcnt lgkmcnt(0)\n\ts_barrier":::"memory");
  #undef XDMA
}
constexpr int ATTN_LDS_BYTES=LDS_BYTES;
#undef SBAR
#undef WAIT_BAR
}
#include <hip/hip_cooperative_groups.h>
namespace cg = cooperative_groups;
#define LAS __attribute__((address_space(3)))
typedef float f32x4 __attribute__((ext_vector_type(4)));
typedef unsigned u32x4 __attribute__((ext_vector_type(4)));
constexpr int NWAVES = 8;
constexpr int RING_BYTES = 131072;
constexpr int STAT_OFF = RING_BYTES;
constexpr int MISC_OFF = STAT_OFF + 16384;
constexpr int LDS_BYTES = 151552;
constexpr size_t WT_IN = 0;
constexpr size_t WT_A = WT_IN + (size_t)5120 * 1024;
constexpr size_t WT_B = WT_A + (size_t)1024 * 512;
constexpr size_t WT_O = WT_B + (size_t)1024 * 512;
constexpr size_t WT_CQ = WT_O + (size_t)1024 * 1024;
constexpr size_t WT_CKV = WT_CQ + (size_t)256 * 1024;
constexpr size_t WT_CO = WT_CKV + (size_t)512 * 1024;
constexpr size_t WT_E1 = WT_CO + (size_t)1024 * 256;
constexpr size_t WT_E2 = WT_E1 + (size_t)32 * 1024 * 1024;
constexpr size_t WT_END = WT_E2 + (size_t)32 * 1024 * 512;
static_assert(WT_END * 2 <= 112 * MiB, "weights fit");

constexpr size_t WS_WIN8 = WS_WT + 2 * WT_E1 + 32 * MiB;
constexpr size_t WS_WG8 = 126 * MiB;
constexpr size_t WS_XN8 = 880 * MiB;
constexpr float WSCALE = 32.f;
struct Args {
    const float* in[28]; float* out; unsigned char* ws; int ph_lo, ph_hi, coop, pad;
};

__device__ __forceinline__ int wcol_in(int n) {
    const int tile = n >> 8, p = n & 255;
    if (tile < 6) return n;
    if (tile < 10) { const int base = tile < 8 ? 1544 : 2056, tl = (tile - 6) & 1; return base + (tl * 4 + ((p & 127) >> 5)) * 64 + (p >> 7) * 32 + (p & 31); }
    if (tile < 12) return 2568 + (n - 2560);
    return 3080 + (n - 3072);
}
__device__ __forceinline__ void p0_transpose_item(const float* W, int ldw, int sc, bf16_t* WT, int K, int n0, int k0, LAS float* scr, int lane, const float* gk = nullptr) {
#pragma unroll
    for (int i = 0; i < 32; ++i) { const int kk = 2 * i + (lane >> 5); const float gv = gk ? gk[k0 + kk] : 1.f; scr[kk * 33 + (lane & 31)] = W[(size_t)(k0 + kk) * ldw + sc + (lane & 31)] * gv; }
    asm volatile("s_waitcnt lgkmcnt(0)" ::: "memory");
    const int c = lane & 7;
#pragma unroll
    for (int j = 0; j < 4; ++j) { const int n = (lane >> 3) + 8 * j; const LAS float* s = scr + (8 * c) * 33 + n;
        u32x4 o; o.x = pg8::cvt_pk_bf16(s[0 * 33], s[1 * 33]); o.y = pg8::cvt_pk_bf16(s[2 * 33], s[3 * 33]); o.z = pg8::cvt_pk_bf16(s[4 * 33], s[5 * 33]); o.w = pg8::cvt_pk_bf16(s[6 * 33], s[7 * 33]);
        *(u32x4*)(WT + (size_t)(n0 + n) * K + k0 + 8 * c) = o; }
    asm volatile("s_waitcnt lgkmcnt(0)" ::: "memory");
}
__device__ __forceinline__ void p0_transpose_item_f8(const float* W, int ldw, int sc, unsigned char* WT8, int Kb, int n0, int k0, LAS float* scr, int lane, const float* gk, float scale) {
#pragma unroll
    for (int i = 0; i < 32; ++i) { const int kk = 2 * i + (lane >> 5); const float gv = (gk ? gk[k0 + kk] : 1.f) * scale; scr[kk * 33 + (lane & 31)] = W[(size_t)(k0 + kk) * ldw + sc + (lane & 31)] * gv; }
    asm volatile("s_waitcnt lgkmcnt(0)" ::: "memory");
    const int c = lane & 7;
#pragma unroll
    for (int j = 0; j < 4; ++j) { const int n = (lane >> 3) + 8 * j; const LAS float* s = scr + (8 * c) * 33 + n;
        unsigned w0 = 0u, w1 = 0u;
        w0 = __builtin_amdgcn_cvt_pk_fp8_f32(s[0 * 33], s[1 * 33], w0, false); w0 = __builtin_amdgcn_cvt_pk_fp8_f32(s[2 * 33], s[3 * 33], w0, true);
        w1 = __builtin_amdgcn_cvt_pk_fp8_f32(s[4 * 33], s[5 * 33], w1, false); w1 = __builtin_amdgcn_cvt_pk_fp8_f32(s[6 * 33], s[7 * 33], w1, true);
        *(uint2*)(WT8 + (size_t)(n0 + n) * Kb + k0 + 8 * c) = make_uint2(w0, w1); }
    asm volatile("s_waitcnt lgkmcnt(0)" ::: "memory");
}
__device__ __forceinline__ bool p0_job_plain(int& r, const float* W, int Kd, int Nd, bf16_t* WT, LAS float* scr, int lane, const float* gk = nullptr, int ldt = 0) {
    const int nblk = Nd / 32, items = (Kd / 64) * nblk;
    if (r >= items) { r -= items; return false; }
    const int kb = r / nblk, nb = r % nblk;
    p0_transpose_item(W, Nd, nb * 32, WT, ldt ? ldt : Kd, nb * 32, kb * 64, scr, lane, gk); return true;
}

template <bool E1MAP> __device__ __forceinline__ void p0_slab_f8(const float* W, int ldw, int c0, int k0, unsigned char* WT8, int Kb, int up, const float* gk, float scale, LAS float* scr, int tid) {
    const int col = (tid & 63) * 4;
    f32x4 v[16];
#pragma unroll
    for (int i = 0; i < 16; ++i) v[i] = *(const f32x4*)(W + (size_t)(k0 + (tid >> 6) + 8 * i) * ldw + c0 + col);
#pragma unroll
    for (int i = 0; i < 16; ++i) { const int r = (tid >> 6) + 8 * i; const float s = (gk ? gk[k0 + r] : 1.f) * scale; LAS float* d = scr + r * 257 + col;
        d[0] = v[i][0] * s; d[1] = v[i][1] * s; d[2] = v[i][2] * s; d[3] = v[i][3] * s; }
    asm volatile("s_waitcnt lgkmcnt(0)" ::: "memory");
    __syncthreads();
#pragma unroll
    for (int j = 0; j < 8; ++j) { const int idx = tid + 512 * j; const int kc = idx & 15, n = idx >> 4; const LAS float* s = scr + (8 * kc) * 257 + n;
        unsigned w0 = 0u, w1 = 0u;
        w0 = __builtin_amdgcn_cvt_pk_fp8_f32(s[0 * 257], s[1 * 257], w0, false); w0 = __builtin_amdgcn_cvt_pk_fp8_f32(s[2 * 257], s[3 * 257], w0, true);
        w1 = __builtin_amdgcn_cvt_pk_fp8_f32(s[4 * 257], s[5 * 257], w1, false); w1 = __builtin_amdgcn_cvt_pk_fp8_f32(s[6 * 257], s[7 * 257], w1, true);
        const int c = c0 + n; const int row = E1MAP ? ((c >> 7) * 256 + (c & 127) + 128 * up) : c;
        *(uint2*)(WT8 + (size_t)row * Kb + k0 + 8 * kc) = make_uint2(w0, w1); }
    asm volatile("s_waitcnt lgkmcnt(0)" ::: "memory");
    __syncthreads();
}
template <bool WIN> __device__ __forceinline__ void p0_slab_bf16(const float* W, int ldw, int c0, int k0, bf16_t* WT, int Kd, const float* gk, LAS float* scr, int tid, int kdst = 0) {
    const int col = (tid & 63) * 4; const int scol = WIN ? wcol_in(c0 + col) : c0 + col;
    f32x4 v[16];
#pragma unroll
    for (int i = 0; i < 16; ++i) v[i] = *(const f32x4*)(W + (size_t)(k0 + (tid >> 6) + 8 * i) * ldw + scol);
#pragma unroll
    for (int i = 0; i < 16; ++i) { const int r = (tid >> 6) + 8 * i; const float s = gk ? gk[k0 + r] : 1.f; LAS float* d = scr + r * 257 + col;
        d[0] = v[i][0] * s; d[1] = v[i][1] * s; d[2] = v[i][2] * s; d[3] = v[i][3] * s; }
    asm volatile("s_waitcnt lgkmcnt(0)" ::: "memory");
    __syncthreads();
#pragma unroll
    for (int j = 0; j < 8; ++j) { const int idx = tid + 512 * j; const int kc = idx & 15, n = idx >> 4; const LAS float* s = scr + (8 * kc) * 257 + n;
        u32x4 o; o.x = pg8::cvt_pk_bf16(s[0 * 257], s[1 * 257]); o.y = pg8::cvt_pk_bf16(s[2 * 257], s[3 * 257]); o.z = pg8::cvt_pk_bf16(s[4 * 257], s[5 * 257]); o.w = pg8::cvt_pk_bf16(s[6 * 257], s[7 * 257]);
        *(u32x4*)(WT + (size_t)(c0 + n) * Kd + kdst + k0 + 8 * kc) = o; }
    asm volatile("s_waitcnt lgkmcnt(0)" ::: "memory");
    __syncthreads();
}
__device__ __forceinline__ void p0_slab_f8w(const float* W, int ldw, int c0, int k0, unsigned char* WT8, LAS float* scr, int tid) {
    const int col = (tid & 63) * 4; const int scol = wcol_in(c0 + col);
    f32x4 v[16];
#pragma unroll
    for (int i = 0; i < 16; ++i) v[i] = *(const f32x4*)(W + (size_t)(k0 + (tid >> 6) + 8 * i) * ldw + scol);
#pragma unroll
    for (int i = 0; i < 16; ++i) { const int r = (tid >> 6) + 8 * i; LAS float* d = scr + r * 257 + col;
        d[0] = v[i][0] * WSCALE; d[1] = v[i][1] * WSCALE; d[2] = v[i][2] * WSCALE; d[3] = v[i][3] * WSCALE; }
    asm volatile("s_waitcnt lgkmcnt(0)" ::: "memory");
    __syncthreads();
#pragma unroll
    for (int j = 0; j < 8; ++j) { const int idx = tid + 512 * j; const int kc = idx & 15, n = idx >> 4; const LAS float* s = scr + (8 * kc) * 257 + n;
        unsigned w0 = 0u, w1 = 0u;
        w0 = __builtin_amdgcn_cvt_pk_fp8_f32(s[0 * 257], s[1 * 257], w0, false); w0 = __builtin_amdgcn_cvt_pk_fp8_f32(s[2 * 257], s[3 * 257], w0, true);
        w1 = __builtin_amdgcn_cvt_pk_fp8_f32(s[4 * 257], s[5 * 257], w1, false); w1 = __builtin_amdgcn_cvt_pk_fp8_f32(s[6 * 257], s[7 * 257], w1, true);
        *(uint2*)(WT8 + (size_t)(c0 + n) * 1024 + k0 + 8 * kc) = make_uint2(w0, w1); }
    asm volatile("s_waitcnt lgkmcnt(0)" ::: "memory");
    __syncthreads();
}
struct SlabItem { const float* W; int ldw, c0, k0; unsigned char* WT8; int Kb, up; const float* gk; bool e1; };
__device__ __forceinline__ SlabItem slab_item(const Args& a, bf16_t* wt, int it) {
    SlabItem s;
    if (it < 1024) { const int e = it >> 5, q = it & 31, up = q >> 4, ks = (q >> 1) & 7, cs = q & 1;
        s.W = (up ? a.in[25] : a.in[24]) + (size_t)e * 1024 * 512; s.ldw = 512; s.c0 = cs * 256; s.k0 = ks * 128; s.WT8 = (unsigned char*)(wt + WT_E1) + (size_t)e * 1024 * 1024; s.Kb = 1024; s.up = up; s.gk = a.in[19]; s.e1 = true; }
    else { const int r2 = it - 1024, e = r2 >> 4, q = r2 & 15, ks = q >> 2, cs = q & 3;
        s.W = a.in[26] + (size_t)e * 512 * 1024; s.ldw = 1024; s.c0 = cs * 256; s.k0 = ks * 128; s.WT8 = (unsigned char*)(wt + WT_E2) + (size_t)e * 1024 * 512; s.Kb = 512; s.up = 0; s.gk = nullptr; s.e1 = false; }
    return s;
}
__device__ __forceinline__ void slab_load(const SlabItem& s, f32x4 (&v)[16], int tid) {
    const int col = (tid & 63) * 4;
#pragma unroll
    for (int i = 0; i < 16; ++i) v[i] = __builtin_nontemporal_load((const f32x4*)(s.W + (size_t)(s.k0 + (tid >> 6) + 8 * i) * s.ldw + s.c0 + col));
}
__device__ __forceinline__ void slab_store_f8(const SlabItem& s, const f32x4 (&v)[16], LAS float* scr, int tid) {
    const int col = (tid & 63) * 4;
#pragma unroll
    for (int i = 0; i < 16; ++i) { const int r = (tid >> 6) + 8 * i; const float sc = (s.gk ? s.gk[s.k0 + r] : 1.f) * WSCALE; LAS float* d = scr + r * 257 + col;
        d[0] = v[i][0] * sc; d[1] = v[i][1] * sc; d[2] = v[i][2] * sc; d[3] = v[i][3] * sc; }
    asm volatile("s_waitcnt lgkmcnt(0)" ::: "memory");
    __syncthreads();
#pragma unroll
    for (int j = 0; j < 8; ++j) { const int idx = tid + 512 * j; const int kc = idx & 15, n = idx >> 4; const LAS float* q = scr + (8 * kc) * 257 + n;
        unsigned w0 = 0u, w1 = 0u;
        w0 = __builtin_amdgcn_cvt_pk_fp8_f32(q[0 * 257], q[1 * 257], w0, false); w0 = __builtin_amdgcn_cvt_pk_fp8_f32(q[2 * 257], q[3 * 257], w0, true);
        w1 = __builtin_amdgcn_cvt_pk_fp8_f32(q[4 * 257], q[5 * 257], w1, false); w1 = __builtin_amdgcn_cvt_pk_fp8_f32(q[6 * 257], q[7 * 257], w1, true);
        const int c = s.c0 + n; const int row = s.e1 ? ((c >> 7) * 256 + (c & 127) + 128 * s.up) : c;
        { typedef unsigned u32x2_ __attribute__((ext_vector_type(2))); const u32x2_ w_ = {w0, w1}; __builtin_nontemporal_store(w_, (u32x2_*)(s.WT8 + (size_t)row * s.Kb + s.k0 + 8 * kc)); } }
    asm volatile("s_waitcnt lgkmcnt(0)" ::: "memory");
    __syncthreads();
}
__device__ __forceinline__ bool slab_take_one(const Args& a, LAS unsigned char* lds, int tid_) {
    int tid = tid_; asm volatile("" : "+v"(tid));
    unsigned char* ws = a.ws; bf16_t* wt = (bf16_t*)(ws + WS_WT);
    volatile LAS unsigned* slot = (volatile LAS unsigned*)(lds + MISC_OFF + 3072 + 64);
    if (tid == 0) *slot = __hip_atomic_fetch_add((unsigned*)(ws + WS_CTL + 20480), 1u, __ATOMIC_RELAXED, __HIP_MEMORY_SCOPE_AGENT);
    __syncthreads();
    const unsigned it = *slot;
    __syncthreads();
    if (it >= 1536u) return false;
    const SlabItem s = slab_item(a, wt, (int)it);
    f32x4 v[16];
    slab_load(s, v, tid);
    slab_store_f8(s, v, (LAS float*)lds, tid);
    return true;
}
__device__ __forceinline__ void p0_prologue(const Args& a, LAS unsigned char* lds, int vcu, int G, int wave, int lane, int tid) {
    unsigned char* ws = a.ws;
    bf16_t* wt = (bf16_t*)(ws + WS_WT);
    LAS float* scr = (LAS float*)(lds + wave * 16384);
    const int gw = vcu * NWAVES + wave, NGW = G * NWAVES;
    constexpr int I_IN = 16 * 160, I_A = 8 * 32, I_O = 16 * 32, I_CQ = 16 * 8, I_CKV = 16 * 16, I_CO = 4 * 32, I_E1 = 16 * 32, I_E2 = 8 * 32;
    constexpr int NITEMS = I_IN + 2 * I_A + I_O + I_CQ + I_CKV + I_CO;
    if ((REP_PHASE) >= 60 && (REP_PHASE) < 70) { __syncthreads(); if (tid == 0) ((unsigned long long*)(ws + WS_CTL + 65536))[(16 + 0) * 256 + blockIdx.x] = __builtin_amdgcn_s_memrealtime(); }
    if ((REP_PHASE) >= 60 && (REP_PHASE) < 70) { __syncthreads(); if (tid == 0) ((unsigned long long*)(ws + WS_CTL + 65536))[(16 + 1) * 256 + blockIdx.x] = __builtin_amdgcn_s_memrealtime(); }
    for (int it = vcu; it < 256; it += G) {
        int r = it; LAS float* sl = (LAS float*)lds;
        if (r < 160) { const int pnl = r % 20;
            if (pnl >= 6 && pnl < 12) p0_slab_bf16<true>(a.in[4], INW, pnl * 256, (r / 20) * 128, wt + WT_IN, 1024, nullptr, sl, tid);
            else p0_slab_f8w(a.in[4], INW, pnl * 256, (r / 20) * 128, ws + WS_WIN8, sl, tid);
            continue; } r -= 160;
        if (r < 16) { p0_slab_bf16<false>(a.in[6], 1024, (r & 3) * 256, (r >> 2) * 128, wt + WT_A, 1024, nullptr, sl, tid, 0); continue; } r -= 16;
        if (r < 16) { p0_slab_bf16<false>(a.in[7], 1024, (r & 3) * 256, (r >> 2) * 128, wt + WT_A, 1024, nullptr, sl, tid, 512); continue; } r -= 16;
        if (r < 32) { p0_slab_bf16<false>(a.in[8], 1024, (r & 3) * 256, (r >> 2) * 128, wt + WT_O, 1024, nullptr, sl, tid); continue; } r -= 32;
        if (r < 8) { p0_slab_bf16<false>(a.in[16], 256, 0, r * 128, wt + WT_CQ, 1024, a.in[14], sl, tid); continue; } r -= 8;
        if (r < 16) { p0_slab_bf16<false>(a.in[17], 512, (r & 1) * 256, (r >> 1) * 128, wt + WT_CKV, 1024, nullptr, sl, tid); continue; } r -= 16;
        p0_slab_bf16<false>(a.in[18], 1024, (r & 3) * 256, (r >> 2) * 128, wt + WT_CO, 256, nullptr, sl, tid);
    }
    if ((REP_PHASE) >= 60 && (REP_PHASE) < 70) { __syncthreads(); if (tid == 0) ((unsigned long long*)(ws + WS_CTL + 65536))[(16 + 2) * 256 + blockIdx.x] = __builtin_amdgcn_s_memrealtime(); }
    {
        const float* w_in = a.in[4]; const float* x = a.in[0]; const float* g = a.in[3]; const float* bfg = a.in[5];
        bf16_t* xn = (bf16_t*)(ws + WS_R1); float* logf = (float*)(ws + WS_LOGF); unsigned char* xn8 = ws + WS_XN8;
        float wf[16][8]; f32x4 gg[4];
#pragma unroll
        for (int j = 0; j < 4; ++j) { const int c = (lane + 64 * j) * 4; gg[j] = *(const f32x4*)(g + c);
#pragma unroll
            for (int q = 0; q < 4; ++q) { const f32x4 w0 = *(const f32x4*)(w_in + (size_t)(c + q) * INW + 1536), w1 = *(const f32x4*)(w_in + (size_t)(c + q) * INW + 1540);
                wf[j * 4 + q][0] = w0[0]; wf[j * 4 + q][1] = w0[1]; wf[j * 4 + q][2] = w0[2]; wf[j * 4 + q][3] = w0[3]; wf[j * 4 + q][4] = w1[0]; wf[j * 4 + q][5] = w1[1]; wf[j * 4 + q][6] = w1[2]; wf[j * 4 + q][7] = w1[3]; } }
        float bb[8];
#pragma unroll
        for (int h = 0; h < 8; ++h) bb[h] = bfg[h];
        const int hsel = ((lane >> 5) & 1) * 4 + ((lane >> 4) & 1) * 2 + ((lane >> 3) & 1);
        for (int rq_ = 0; rq_ < ((REP_PHASE) == 31 ? 2 : 1); ++rq_)
        for (int base = gw; base < T_; base += 4 * NGW) {
            f32x4 v[4][4];
#pragma unroll
            for (int q4 = 0; q4 < 4; ++q4) { const int row = base + q4 * NGW; if (row < T_) { const f32x4* xr = (const f32x4*)(x + (size_t)row * D_);
#pragma unroll
                for (int j = 0; j < 4; ++j) v[q4][j] = xr[lane + 64 * j]; } }
#pragma unroll
            for (int q4 = 0; q4 < 4; ++q4) { const int row = base + q4 * NGW; if (row < T_) {
                float ss = 0.f;
#pragma unroll
                for (int j = 0; j < 4; ++j) ss += v[q4][j][0] * v[q4][j][0] + v[q4][j][1] * v[q4][j][1] + v[q4][j][2] * v[q4][j][2] + v[q4][j][3] * v[q4][j][3];
                ss = wave_sum_dpp(ss);
                const float rstd = rsqrtf(ss * (1.f / D_) + 1e-6f);
                float fl[8];
#pragma unroll
                for (int h = 0; h < 8; ++h) fl[h] = 0.f;
#pragma unroll
                for (int j = 0; j < 4; ++j) {
                    const int c = (lane + 64 * j) * 4;
                    const f32x4 o = v[q4][j] * rstd * gg[j];
                    uint2 pk; pk.x = pg8::cvt_pk_bf16(o[0], o[1]); pk.y = pg8::cvt_pk_bf16(o[2], o[3]);
                    *(uint2*)(xn + (size_t)row * D_ + c) = pk;
                    unsigned p8 = 0u; p8 = __builtin_amdgcn_cvt_pk_fp8_f32(o[0], o[1], p8, false); p8 = __builtin_amdgcn_cvt_pk_fp8_f32(o[2], o[3], p8, true);
                    *(unsigned*)(xn8 + (size_t)row * D_ + c) = p8;
#pragma unroll
                    for (int q = 0; q < 4; ++q)
#pragma unroll
                        for (int h = 0; h < 8; ++h) fl[h] += o[q] * wf[j * 4 + q][h];
                }
                float zsel = 0.f;
#pragma unroll
                for (int h = 0; h < 8; ++h) { const float t = wave_sum_dpp(fl[h]) + bb[h]; zsel = (lane == h) ? t : zsel; }
                const float ls = fminf(zsel, 0.f) - log1pf(__expf(-fabsf(zsel)));
                const int b = row / S_, s = row % S_;
                if (lane < 8) logf[((size_t)b * 8 + lane) * S_ + s] = ls;
            } }
        }
    }
    if ((REP_PHASE) >= 60 && (REP_PHASE) < 70) { __syncthreads(); if (tid == 0) ((unsigned long long*)(ws + WS_CTL + 65536))[(16 + 3) * 256 + blockIdx.x] = __builtin_amdgcn_s_memrealtime(); }
    {
        const float* x = a.in[1]; const float* g = a.in[15]; bf16_t* mn = (bf16_t*)(ws + WS_MEMN);
        for (int row = gw; row < B_ * MEML; row += NGW) {
            const f32x4* xr = (const f32x4*)(x + (size_t)row * D_);
            f32x4 v[4]; float ss = 0.f;
#pragma unroll
            for (int j = 0; j < 4; ++j) { v[j] = xr[lane + 64 * j]; ss += v[j][0] * v[j][0] + v[j][1] * v[j][1] + v[j][2] * v[j][2] + v[j][3] * v[j][3]; }
            ss = wave_sum(ss);
            const float rstd = rsqrtf(ss * (1.f / D_) + 1e-6f);
#pragma unroll
            for (int j = 0; j < 4; ++j) { const int c = (lane + 64 * j) * 4; const f32x4 o = v[j] * rstd * *(const f32x4*)(g + c);
                uint2 pk; pk.x = pg8::cvt_pk_bf16(o[0], o[1]); pk.y = pg8::cvt_pk_bf16(o[2], o[3]); *(uint2*)(mn + (size_t)row * D_ + c) = pk; }
        }
    }
    if ((REP_PHASE) >= 60 && (REP_PHASE) < 70) { __syncthreads(); if (tid == 0) ((unsigned long long*)(ws + WS_CTL + 65536))[(16 + 4) * 256 + blockIdx.x] = __builtin_amdgcn_s_memrealtime(); }
    {
        bf16_t* wrh = (bf16_t*)(ws + (size_t)116 * MiB); bf16_t* wrl = wrh + 48 * 1024;
        const int gt = gw * 64 + lane, NGT = NGW * 64;
        for (int i = gt; i < 48 * 1024; i += NGT) { const int o = i >> 10, k = i & 1023;
            const float w = (o < 4 ? a.in[20][k * 4 + o] : (o < 36 ? a.in[22][k * 32 + o - 4] : 0.f)) * a.in[19][k];
            const bf16_t h = f2bf(w); wrh[i] = h; wrl[i] = f2bf(w - bf2f(h)); }
    }
    if ((REP_PHASE) >= 60 && (REP_PHASE) < 70) { __syncthreads(); if (tid == 0) ((unsigned long long*)(ws + WS_CTL + 65536))[(16 + 5) * 256 + blockIdx.x] = __builtin_amdgcn_s_memrealtime(); }
    {
        const int* pos = (const int*)a.in[2]; float* tab = (float*)(ws + WS_ROPE);
        const int gt = gw * 64 + lane, NGT = NGW * 64;
        for (int i = gt; i < T_ * 32; i += NGT) {
            const int f = i & 31, r = i >> 5;
            const float inv = exp2f(-(float)f * (2.0f / 64.0f) * 13.287712379549449f);
            const float ang = (float)pos[r] * inv;
            float sn, cs; sincosf(ang, &sn, &cs);
            *(float2*)(tab + (size_t)i * 2) = make_float2(cs, sn);
        }
    }
    if ((REP_PHASE) >= 60 && (REP_PHASE) < 70) { __syncthreads(); if (tid == 0) ((unsigned long long*)(ws + WS_CTL + 65536))[(16 + 6) * 256 + blockIdx.x] = __builtin_amdgcn_s_memrealtime(); }
}

__device__ __forceinline__ void p1_cumsum(float* c, bf16_t* kaug, int bh, LAS float* part, int tid) {
    float* p = c + (size_t)bh * S_ + tid * 8;
    float v[8]; float s = 0.f;
    const f32x4 a0 = *(const f32x4*)p, a1 = *(const f32x4*)(p + 4);
    const float in[8] = {a0[0], a0[1], a0[2], a0[3], a1[0], a1[1], a1[2], a1[3]};
#pragma unroll
    for (int i = 0; i < 8; ++i) { s += in[i]; v[i] = s; }
    part[tid] = s; __syncthreads();
    float pre = 0.f;
    for (int i = 0; i < tid; ++i) pre += part[i];
    __syncthreads();
#pragma unroll
    for (int i = 0; i < 8; ++i) {
        const float cv = v[i] + pre; p[i] = cv;
        const float bia = -cv * LOG2E;
        const bf16_t h0 = f2bf(bia); const float r1 = bia - bf2f(h0); const bf16_t h1 = f2bf(r1); const float r2 = r1 - bf2f(h1); const bf16_t h2 = f2bf(r2);
        uint2 pk; pk.x = (unsigned)h0 | ((unsigned)h1 << 16); pk.y = (unsigned)h2;
        *(uint2*)(kaug + ((size_t)bh * S_ + tid * 8 + i) * 4) = pk;
    }
}

struct EpiIn {
    static constexpr bool PERM = true, HAS_MID = false, HAS_PF = false, HAS_PROF = false;
    bf16_t *fq, *fk, *fv, *dq, *dk, *dv, *sig; const float* rope;
    __device__ __forceinline__ void operator()(const f32x4 (&acc)[2][2][4][2], const pg8::Unit& u, int wr, int wc, int fr_, int fq_) const {
        int fr = fr_; asm volatile("" : "+v"(fr));
        const int row0 = u.pm * 256 + wr * 64 + fr; const int pn = u.pn;
        if (pn >= 6 && pn < 10) {
            bf16_t* base = pn < 8 ? dq : dk; const float sc = pn < 8 ? C2 : 1.f; const int tl = (pn - 6) & 1;
            const int colL = (tl * 4 + wc) * 64 + 8 * fq_;
#pragma unroll
            for (int ai = 0; ai < 2; ++ai)
#pragma unroll
                for (int m = 0; m < 4; ++m) {
                    const int row = row0 + ai * 128 + m * 16;
                    const f32x4* tb = (const f32x4*)(rope + ((size_t)row * 32 + 8 * fq_) * 2);
                    const f32x4 t0 = tb[0], t1 = tb[1], t2 = tb[2], t3 = tb[3];
                    const float cs[8] = {t0[0], t0[2], t1[0], t1[2], t2[0], t2[2], t3[0], t3[2]}, sn[8] = {t0[1], t0[3], t1[1], t1[3], t2[1], t2[3], t3[1], t3[3]};
                    const float x1[8] = {acc[ai][0][m][0][0], acc[ai][0][m][0][1], acc[ai][0][m][0][2], acc[ai][0][m][0][3], acc[ai][0][m][1][0], acc[ai][0][m][1][1], acc[ai][0][m][1][2], acc[ai][0][m][1][3]};
                    const float x2[8] = {acc[ai][1][m][0][0], acc[ai][1][m][0][1], acc[ai][1][m][0][2], acc[ai][1][m][0][3], acc[ai][1][m][1][0], acc[ai][1][m][1][1], acc[ai][1][m][1][2], acc[ai][1][m][1][3]};
                    float o1[8], o2[8];
#pragma unroll
                    for (int j = 0; j < 8; ++j) { o1[j] = (x1[j] * cs[j] - x2[j] * sn[j]) * sc; o2[j] = (x2[j] * cs[j] + x1[j] * sn[j]) * sc; }
                    u32x4 w1, w2;
                    w1.x = pg8::cvt_pk_bf16(o1[0], o1[1]); w1.y = pg8::cvt_pk_bf16(o1[2], o1[3]); w1.z = pg8::cvt_pk_bf16(o1[4], o1[5]); w1.w = pg8::cvt_pk_bf16(o1[6], o1[7]);
                    w2.x = pg8::cvt_pk_bf16(o2[0], o2[1]); w2.y = pg8::cvt_pk_bf16(o2[2], o2[3]); w2.z = pg8::cvt_pk_bf16(o2[4], o2[5]); w2.w = pg8::cvt_pk_bf16(o2[6], o2[7]);
                    bf16_t* rp = base + (size_t)row * 512 + colL;
                    __builtin_nontemporal_store(w1, (u32x4*)rp); __builtin_nontemporal_store(w2, (u32x4*)(rp + 32));
                }
        } else if (pn >= 12) {
                unsigned char* sb8 = (unsigned char*)sig; const int col0 = (pn - 12) * 256 + wc * 32 + 8 * fq_;
#pragma unroll
                for (int ai = 0; ai < 2; ++ai)
#pragma unroll
                    for (int m = 0; m < 4; ++m) { unsigned char* rowp = sb8 + (size_t)(row0 + ai * 128 + m * 16) * 4096 + col0;
#pragma unroll
                        for (int bj = 0; bj < 2; ++bj) { const f32x4 v0 = acc[ai][bj][m][0], v1 = acc[ai][bj][m][1]; unsigned w0 = 0u, w1 = 0u;
                            constexpr float KE = -LOG2E / WSCALE;
#pragma unroll
                            for (int q = 0; q < 4; ++q) { w0 = __builtin_amdgcn_cvt_pk_u8_f32(__builtin_amdgcn_rcpf(1.f + __builtin_amdgcn_exp2f(v0[q] * KE)) * 255.f, q, w0);
                                                          w1 = __builtin_amdgcn_cvt_pk_u8_f32(__builtin_amdgcn_rcpf(1.f + __builtin_amdgcn_exp2f(v1[q] * KE)) * 255.f, q, w1); }
                            *(uint2*)(rowp + bj * 128) = make_uint2(w0, w1); } }
        } else {
            bf16_t* base; int ld, colt; float sc = 1.f / WSCALE; bool sg = false;
            if (pn < 2) { base = fq; ld = 512; colt = pn * 256; sc = C2 / WSCALE; }
            else if (pn < 4) { base = fk; ld = 512; colt = (pn - 2) * 256; }
            else if (pn < 6) { base = fv; ld = 512; colt = (pn - 4) * 256; }
            else { base = dv; ld = 512; colt = (pn - 10) * 256; sc = 1.f; }
            const int col0 = colt + wc * 32 + 8 * fq_;
#pragma unroll
            for (int ai = 0; ai < 2; ++ai)
#pragma unroll
                for (int m = 0; m < 4; ++m) { bf16_t* rowp = base + (size_t)(row0 + ai * 128 + m * 16) * ld + col0;
#pragma unroll
                    for (int bj = 0; bj < 2; ++bj) { f32x4 v0 = acc[ai][bj][m][0], v1 = acc[ai][bj][m][1];
                        if (sg) {
#pragma unroll
                            for (int q = 0; q < 4; ++q) { v0[q] = __builtin_amdgcn_rcpf(1.f + __expf(-v0[q])); v1[q] = __builtin_amdgcn_rcpf(1.f + __expf(-v1[q])); } }
                        else { v0 = v0 * sc; v1 = v1 * sc; }
                        u32x4 w; w.x = pg8::cvt_pk_bf16(v0[0], v0[1]); w.y = pg8::cvt_pk_bf16(v0[2], v0[3]); w.z = pg8::cvt_pk_bf16(v1[0], v1[1]); w.w = pg8::cvt_pk_bf16(v1[2], v1[3]);
                        __builtin_nontemporal_store(w, (u32x4*)(rowp + bj * 128)); } }
        }
    }
};
struct EpiGate8 {
    static constexpr bool PERM = true, HAS_MID = false, HAS_PF = false, HAS_PROF = false;
    bf16_t* sig;
    __device__ __forceinline__ void operator()(const f32x4 (&acc)[2][2][4][2], const pg8::Unit& u, int wr, int wc, int fr_, int fq_) const {
        int fr = fr_; asm volatile("" : "+v"(fr));
        const int row0 = u.pm * 256 + wr * 64 + fr; const int col0 = u.pn * 256 + wc * 32 + 8 * fq_;
#pragma unroll
        for (int ai = 0; ai < 2; ++ai)
#pragma unroll
            for (int m = 0; m < 4; ++m) { bf16_t* rowp = sig + (size_t)(row0 + ai * 128 + m * 16) * 2048 + col0;
#pragma unroll
                for (int bj = 0; bj < 2; ++bj) { f32x4 v0 = acc[ai][bj][m][0], v1 = acc[ai][bj][m][1];
#pragma unroll
                    for (int q = 0; q < 4; ++q) { v0[q] = __builtin_amdgcn_rcpf(1.f + __expf(v0[q] * (-1.f / WSCALE))); v1[q] = __builtin_amdgcn_rcpf(1.f + __expf(v1[q] * (-1.f / WSCALE))); }
                    u32x4 w; w.x = pg8::cvt_pk_bf16(v0[0], v0[1]); w.y = pg8::cvt_pk_bf16(v0[2], v0[3]); w.z = pg8::cvt_pk_bf16(v1[0], v1[1]); w.w = pg8::cvt_pk_bf16(v1[2], v1[3]);
                    *(u32x4*)(rowp + bj * 128) = w; } }
    }
};
struct EpiBf {
    static constexpr bool PERM = true, HAS_MID = false, HAS_PF = false, HAS_PROF = false;
    bf16_t* O; int ldc; float sc;
    __device__ __forceinline__ void operator()(const f32x4 (&acc)[2][2][4][2], const pg8::Unit& u, int wr, int wc, int fr_, int fq_) const {
        int fr = fr_; asm volatile("" : "+v"(fr));
        const int row0 = u.pm * 256 + wr * 64 + fr; const int col0 = u.pn * 256 + wc * 32 + 8 * fq_;
#pragma unroll
        for (int ai = 0; ai < 2; ++ai)
#pragma unroll
            for (int m = 0; m < 4; ++m) { bf16_t* rowp = O + (size_t)(row0 + ai * 128 + m * 16) * ldc + col0;
#pragma unroll
                for (int bj = 0; bj < 2; ++bj) { const f32x4 v0 = acc[ai][bj][m][0] * sc, v1 = acc[ai][bj][m][1] * sc;
                    u32x4 w; w.x = pg8::cvt_pk_bf16(v0[0], v0[1]); w.y = pg8::cvt_pk_bf16(v0[2], v0[3]); w.z = pg8::cvt_pk_bf16(v1[0], v1[1]); w.w = pg8::cvt_pk_bf16(v1[2], v1[3]);
                    *(u32x4*)(rowp + bj * 128) = w; } }
    }
};

constexpr size_t WS_RT = 116 * MiB;
constexpr size_t WS_LRS = 118 * MiB;
__device__ __forceinline__ float shx(float v, int mask, int lane) { return __int_as_float(__builtin_amdgcn_ds_bpermute((lane ^ mask) << 2, __float_as_int(v))); }
__device__ __forceinline__ float wave_sum_l(float v, int lane) {
#pragma unroll
    for (int o = 1; o < 64; o <<= 1) v += shx(v, o, lane);
    return v;
}
__device__ __forceinline__ void wg_fence() {
    asm volatile("s_waitcnt vmcnt(0) lgkmcnt(0)" ::: "memory");
    __builtin_amdgcn_fence(__ATOMIC_ACQ_REL, "workgroup");
    __syncthreads();
}
__device__ __forceinline__ float bflo(unsigned w) { return __uint_as_float(w << 16); }
__device__ __forceinline__ float bfhi(unsigned w) { return __uint_as_float(w & 0xffff0000u); }
#define EPI_FENCE() asm volatile("" ::: "memory")
__device__ __forceinline__ void pf_touch(const void* p, unsigned& sink) { asm volatile("global_load_dword %0, %1, off" : "+v"(sink) : "v"(p) : "memory"); }
template <bool SECOND> struct EpiGate {
    static constexpr bool PERM = true, HAS_MID = false, HAS_PF = false, HAS_PROF = false;
    const bf16_t* sig; bf16_t* merged;
    __device__ __forceinline__ void operator()(const f32x4 (&acc)[2][2][4][2], const pg8::Unit& u, int wr, int wc, int fr_, int fq_) const {
        int fr = fr_; asm volatile("" : "+v"(fr));
        const int row0 = u.pm * 256 + wr * 64 + fr; const int col0 = u.pn * 256 + wc * 32 + 8 * fq_;
        u32x4 sgb[4][2], mob[4][2];
#define EG_LOAD(g, s) do { const size_t row_ = (size_t)(row0 + ((g) >> 2) * 128 + ((g) & 3) * 16); _Pragma("unroll") for (int bj = 0; bj < 2; ++bj) { \
            sgb[s][bj] = *(const u32x4*)(sig + row_ * 2048 + (SECOND ? 1024 : 0) + col0 + bj * 128); if (SECOND) mob[s][bj] = *(const u32x4*)(merged + row_ * 1024 + col0 + bj * 128); } } while (0)
        EG_LOAD(0, 0); EG_LOAD(1, 1); EG_LOAD(2, 2);
#pragma unroll
        for (int g = 0; g < 8; ++g) {
            const int s = g & 3, ai = g >> 2, m = g & 3;
            if (g + 3 < 8) EG_LOAD(g + 3, (g + 3) & 3);
            EPI_FENCE();
            const size_t row = (size_t)(row0 + ai * 128 + m * 16);
#pragma unroll
            for (int bj = 0; bj < 2; ++bj) {
                const f32x4 v0 = acc[ai][bj][m][0], v1 = acc[ai][bj][m][1];
                float r[8] = {v0[0], v0[1], v0[2], v0[3], v1[0], v1[1], v1[2], v1[3]};
                const unsigned sw[4] = {sgb[s][bj].x, sgb[s][bj].y, sgb[s][bj].z, sgb[s][bj].w};
#pragma unroll
                for (int q = 0; q < 4; ++q) { r[2 * q] *= bflo(sw[q]); r[2 * q + 1] *= bfhi(sw[q]); }
                if (SECOND) { const unsigned mw[4] = {mob[s][bj].x, mob[s][bj].y, mob[s][bj].z, mob[s][bj].w};
#pragma unroll
                    for (int q = 0; q < 4; ++q) { r[2 * q] += bflo(mw[q]); r[2 * q + 1] += bfhi(mw[q]); } }
                u32x4 w; w.x = pg8::cvt_pk_bf16(r[0], r[1]); w.y = pg8::cvt_pk_bf16(r[2], r[3]); w.z = pg8::cvt_pk_bf16(r[4], r[5]); w.w = pg8::cvt_pk_bf16(r[6], r[7]);
                *(u32x4*)(merged + row * 1024 + col0 + bj * 128) = w; }
            EPI_FENCE();
        }
#undef EG_LOAD
    }
};
struct EpiGate2 {
    static constexpr bool PERM = true, HAS_MID = true, HAS_PF = false, HAS_PROF = false;
    const unsigned char* sig8; bf16_t* merged;
    static __device__ __forceinline__ float ub(unsigned w, int k) { return (float)((w >> (8 * k)) & 0xffu) * (1.f / 255.f); }
    __device__ __forceinline__ void mid(f32x4 (&acc)[2][2][4][2], const pg8::Unit& u, int wr, int wc, int fr_, int fq_) const {
        int fr = fr_; asm volatile("" : "+v"(fr));
        const int row0 = u.pm * 256 + wr * 64 + fr; const int col0 = u.pn * 256 + wc * 32 + 8 * fq_;
        uint2 ab[4][2], bb[4][2];
#define EG_LOAD(g, s) do { const size_t row_ = (size_t)(row0 + ((g) >> 2) * 128 + ((g) & 3) * 16); _Pragma("unroll") for (int bj = 0; bj < 2; ++bj) { \
            ab[s][bj] = *(const uint2*)(sig8 + row_ * 4096 + col0 + bj * 128); bb[s][bj] = *(const uint2*)(sig8 + row_ * 4096 + 1024 + col0 + bj * 128); } } while (0)
        EG_LOAD(0, 0); EG_LOAD(1, 1); EG_LOAD(2, 2);
#pragma unroll
        for (int g = 0; g < 8; ++g) {
            const int s = g & 3, ai = g >> 2, m = g & 3;
            if (g + 3 < 8) EG_LOAD(g + 3, (g + 3) & 3);
            EPI_FENCE();
#pragma unroll
            for (int bj = 0; bj < 2; ++bj) {
                const unsigned aw[2] = {ab[s][bj].x, ab[s][bj].y}, bw[2] = {bb[s][bj].x, bb[s][bj].y};
#pragma unroll
                for (int q = 0; q < 8; ++q) { const float r = ub(aw[q >> 2], q & 3) * __builtin_amdgcn_rcpf(fmaxf(ub(bw[q >> 2], q & 3), 1e-20f)); acc[ai][bj][m][q >> 2][q & 3] *= r; }
            }
            EPI_FENCE();
        }
#undef EG_LOAD
    }
    __device__ __forceinline__ void operator()(const f32x4 (&acc)[2][2][4][2], const pg8::Unit& u, int wr, int wc, int fr_, int fq_) const {
        int fr = fr_; asm volatile("" : "+v"(fr));
        const int row0 = u.pm * 256 + wr * 64 + fr; const int col0 = u.pn * 256 + wc * 32 + 8 * fq_;
        uint2 bb[4][2];
#define EG_LOAD(g, s) do { const size_t row_ = (size_t)(row0 + ((g) >> 2) * 128 + ((g) & 3) * 16); _Pragma("unroll") for (int bj = 0; bj < 2; ++bj) \
            bb[s][bj] = *(const uint2*)(sig8 + row_ * 4096 + 1024 + col0 + bj * 128); } while (0)
        EG_LOAD(0, 0); EG_LOAD(1, 1); EG_LOAD(2, 2);
#pragma unroll
        for (int g = 0; g < 8; ++g) {
            const int s = g & 3, ai = g >> 2, m = g & 3;
            if (g + 3 < 8) EG_LOAD(g + 3, (g + 3) & 3);
            EPI_FENCE();
            const size_t row = (size_t)(row0 + ai * 128 + m * 16);
#pragma unroll
            for (int bj = 0; bj < 2; ++bj) {
                const f32x4 v0 = acc[ai][bj][m][0], v1 = acc[ai][bj][m][1];
                float r[8] = {v0[0], v0[1], v0[2], v0[3], v1[0], v1[1], v1[2], v1[3]};
                const unsigned bw[2] = {bb[s][bj].x, bb[s][bj].y};
#pragma unroll
                for (int q = 0; q < 8; ++q) r[q] *= fmaxf(ub(bw[q >> 2], q & 3), 1e-20f);
                u32x4 w; w.x = pg8::cvt_pk_bf16(r[0], r[1]); w.y = pg8::cvt_pk_bf16(r[2], r[3]); w.z = pg8::cvt_pk_bf16(r[4], r[5]); w.w = pg8::cvt_pk_bf16(r[6], r[7]);
                *(u32x4*)(merged + row * 1024 + col0 + bj * 128) = w; }
            EPI_FENCE();
        }
#undef EG_LOAD
    }
};
template <bool BASE_BF16, bool Q8 = BASE_BF16> struct EpiRes {
    static constexpr bool PERM = true, HAS_MID = false, HAS_PF = false, HAS_PROF = true;
    const void* base; bf16_t* xo; LAS float* stats; unsigned char* q8;
    unsigned long long* prof;
    __device__ __forceinline__ void operator()(const f32x4 (&acc)[2][2][4][2], const pg8::Unit& u, int wr, int wc, int fr_, int fq_) const {
        const unsigned long long t0_ = prof ? __builtin_amdgcn_s_memrealtime() : 0ull;
        int fr = fr_; asm volatile("" : "+v"(fr));
        const int col0 = u.pn * 256 + wc * 32 + 8 * fq_; const int rl0 = wr * 64 + fr;
        constexpr int NS = BASE_BF16 ? 8 : 5;
        f32x4 fb[BASE_BF16 ? 1 : NS][2][2]; u32x4 hb[BASE_BF16 ? NS : 1][2];
#define ER_LOAD(g, s) do { const size_t row_ = (size_t)(u.pm * 256 + rl0 + ((g) >> 2) * 128 + ((g) & 3) * 16); _Pragma("unroll") for (int bj = 0; bj < 2; ++bj) { \
            if (BASE_BF16) hb[s][bj] = *(const u32x4*)((const bf16_t*)base + row_ * 2048 + col0 + bj * 128); \
            else { const float* p_ = (const float*)base + row_ * 1024 + col0 + bj * 128; fb[s][bj][0] = *(const f32x4*)p_; fb[s][bj][1] = *(const f32x4*)(p_ + 4); } } } while (0)
#pragma unroll
        for (int g0 = 0; g0 < NS - 1; ++g0) ER_LOAD(g0, g0);
#pragma unroll
        for (int g = 0; g < 8; ++g) {
            const int s = g % NS, ai = g >> 2, m = g & 3;
            if (g + NS - 1 < 8) ER_LOAD(g + NS - 1, (g + NS - 1) % NS);
            EPI_FENCE();
            const int rl = rl0 + ai * 128 + m * 16; const size_t row = (size_t)(u.pm * 256 + rl); float ss = 0.f;
#pragma unroll
            for (int bj = 0; bj < 2; ++bj) {
                f32x4 o0, o1;
                if (BASE_BF16) { const u32x4 h = hb[s][bj]; o0 = (f32x4){bflo(h.x), bfhi(h.x), bflo(h.y), bfhi(h.y)}; o1 = (f32x4){bflo(h.z), bfhi(h.z), bflo(h.w), bfhi(h.w)}; }
                else { o0 = fb[s][bj][0]; o1 = fb[s][bj][1]; }
                o0 = o0 + acc[ai][bj][m][0]; o1 = o1 + acc[ai][bj][m][1];
                ss += (o0[0] * o0[0] + o0[1] * o0[1]) + (o0[2] * o0[2] + o0[3] * o0[3]) + (o1[0] * o1[0] + o1[1] * o1[1]) + (o1[2] * o1[2] + o1[3] * o1[3]);
                u32x4 w; w.x = pg8::cvt_pk_bf16(o0[0], o0[1]); w.y = pg8::cvt_pk_bf16(o0[2], o0[3]); w.z = pg8::cvt_pk_bf16(o1[0], o1[1]); w.w = pg8::cvt_pk_bf16(o1[2], o1[3]);
                *(u32x4*)(xo + row * 2048 + col0 + bj * 128) = w;
                if constexpr (Q8) { unsigned q0 = 0u, q1 = 0u;
#define CL8(v) __builtin_amdgcn_fmed3f((v), -448.f, 448.f)
                    q0 = __builtin_amdgcn_cvt_pk_fp8_f32(CL8(o0[0]), CL8(o0[1]), q0, false); q0 = __builtin_amdgcn_cvt_pk_fp8_f32(CL8(o0[2]), CL8(o0[3]), q0, true);
                    q1 = __builtin_amdgcn_cvt_pk_fp8_f32(CL8(o1[0]), CL8(o1[1]), q1, false); q1 = __builtin_amdgcn_cvt_pk_fp8_f32(CL8(o1[2]), CL8(o1[3]), q1, true);
                    *(uint2*)(q8 + row * 2048 + col0 + bj * 128) = make_uint2(q0, q1); } }
            ss += shx(ss, 16, fq_ * 16 + fr); ss += shx(ss, 32, fq_ * 16 + fr);
            if (fq_ == 0) stats[(u.pn * 256 + rl) * 4 + wc] = ss;
            EPI_FENCE();
        }
#undef ER_LOAD
        if (prof && threadIdx.x == 0) atomicAdd(prof, __builtin_amdgcn_s_memrealtime() - t0_);
    }
};
__device__ __forceinline__ float row_rstd(const LAS float* stats, int rl, float eps) {
    float s = 0.f;
#pragma unroll
    for (int pn = 0; pn < 4; ++pn) { const f32x4 v = *(const LAS f32x4*)(stats + (pn * 256 + rl) * 4); s += (v[0] + v[1]) + (v[2] + v[3]); }
    return rsqrtf(s * (1.f / 1024.f) + eps);
}
struct EpiQ {
    static constexpr bool PERM = true, HAS_MID = false, HAS_PF = false, HAS_PROF = false;
    bf16_t* O; int ldc; float sc; const LAS float* stats;
    __device__ __forceinline__ void operator()(const f32x4 (&acc)[2][2][4][2], const pg8::Unit& u, int wr, int wc, int fr_, int fq_) const {
        int fr = fr_; asm volatile("" : "+v"(fr));
        const int col0 = u.pn * 256 + wc * 32 + 8 * fq_;
#pragma unroll
        for (int ai = 0; ai < 2; ++ai)
#pragma unroll
            for (int m = 0; m < 4; ++m) { const int rl = ai * 128 + wr * 64 + m * 16 + fr; const float rs = row_rstd(stats, rl, 1e-6f) * sc;
                bf16_t* rowp = O + (size_t)(u.pm * 256 + rl) * ldc + col0;
#pragma unroll
                for (int bj = 0; bj < 2; ++bj) { const f32x4 v0 = acc[ai][bj][m][0] * rs, v1 = acc[ai][bj][m][1] * rs;
                    u32x4 w; w.x = pg8::cvt_pk_bf16(v0[0], v0[1]); w.y = pg8::cvt_pk_bf16(v0[2], v0[3]); w.z = pg8::cvt_pk_bf16(v1[0], v1[1]); w.w = pg8::cvt_pk_bf16(v1[2], v1[3]);
                    *(u32x4*)(rowp + bj * 128) = w; } }
    }
};
__device__ __forceinline__ void c0_diffcomb(const Args& a, unsigned char* ws, int panel, int wave, int lane_) {
    int lane = lane_; asm volatile("" : "+v"(lane));
    const bf16_t* od = (const bf16_t*)(ws + WS_OD); bf16_t* y = (bf16_t*)(ws + WS_Y);
    const float lam = __expf(wave_sum_l(a.in[9][lane] * a.in[10][lane], lane)) - __expf(wave_sum_l(a.in[11][lane] * a.in[12][lane], lane)) + 0.2f;
    const int h = lane >> 4, d0 = (lane & 15) * 8;
    float gs[8];
#pragma unroll
    for (int i = 0; i < 8; ++i) gs[i] = a.in[13][d0 + i] * 0.8f;
#pragma unroll 1
    for (int r0 = 0; r0 < 32; r0 += 16) {
        u32x4 pav[16], pbv[16];
#pragma unroll
        for (int r = 0; r < 16; ++r) { const size_t row = (size_t)panel * 256 + wave * 32 + r0 + r;
            pav[r] = *(const u32x4*)(od + row * 1024 + (h * 2 + 0) * 128 + d0); pbv[r] = *(const u32x4*)(od + row * 1024 + (h * 2 + 1) * 128 + d0); }
#pragma unroll
        for (int r = 0; r < 16; ++r) { const size_t row = (size_t)panel * 256 + wave * 32 + r0 + r;
            const unsigned aw[4] = {pav[r].x, pav[r].y, pav[r].z, pav[r].w}, bw[4] = {pbv[r].x, pbv[r].y, pbv[r].z, pbv[r].w};
            float v[8]; float ss = 0.f;
#pragma unroll
            for (int q = 0; q < 4; ++q) { v[2 * q] = bflo(aw[q]) - lam * bflo(bw[q]); v[2 * q + 1] = bfhi(aw[q]) - lam * bfhi(bw[q]); }
#pragma unroll
            for (int i = 0; i < 8; ++i) ss += v[i] * v[i];
            ss += shx(ss, 1, lane); ss += shx(ss, 2, lane); ss += shx(ss, 4, lane); ss += shx(ss, 8, lane);
            const float rstd = rsqrtf(ss * (1.f / 128.f) + 1e-5f);
            u32x4 w; w.x = pg8::cvt_pk_bf16(v[0] * rstd * gs[0], v[1] * rstd * gs[1]); w.y = pg8::cvt_pk_bf16(v[2] * rstd * gs[2], v[3] * rstd * gs[3]);
            w.z = pg8::cvt_pk_bf16(v[4] * rstd * gs[4], v[5] * rstd * gs[5]); w.w = pg8::cvt_pk_bf16(v[6] * rstd * gs[6], v[7] * rstd * gs[7]);
            *(u32x4*)(y + row * 1024 + 512 + h * 128 + d0) = w;
        }
    }
}
typedef short bf16x8_t __attribute__((ext_vector_type(8)));
__device__ __forceinline__ void c6_route(const Args& a, unsigned char* ws, LAS unsigned char* lds, const LAS float* stats, int panel, int wave, int lane_, int tid_) {
    int lane = lane_, tid = tid_; asm volatile("" : "+v"(lane), "+v"(tid));
    const bf16_t* x2b = (const bf16_t*)a.out + 1024;
    const bf16_t* wrh = (const bf16_t*)(ws + WS_RT); const bf16_t* wrl = wrh + 48 * 1024;
    LAS float* lg = (LAS float*)(lds + wave * 6144);
    LAS unsigned* hist = (LAS unsigned*)(lds + 49152);
    const int fr = lane & 15, fq = lane >> 4;
    f32x4 acc[2][3];
#pragma unroll
    for (int rb = 0; rb < 2; ++rb)
#pragma unroll
        for (int ob = 0; ob < 3; ++ob) acc[rb][ob] = (f32x4){0.f, 0.f, 0.f, 0.f};
    const size_t rowb = (size_t)panel * 256 + wave * 32;
    constexpr int WP = 1040, WHL = 48 * WP;
#pragma unroll 1
    for (int c = 0; c < 2; ++c) {
        u32x4 wv[12];
#pragma unroll
        for (int i = 0; i < 12; ++i) { const int p = tid + 512 * i; const int hl = p >= 3072 ? 1 : 0, q = p - hl * 3072; const int row = q >> 6, pc = q & 63;
            wv[i] = *(const u32x4*)((hl ? wrl : wrh) + (size_t)row * 1024 + c * 512 + pc * 8); }
        bf16x8_t xv[2][16];
#pragma unroll
        for (int rb = 0; rb < 2; ++rb)
#pragma unroll
            for (int s = 0; s < 16; ++s) xv[rb][s] = *(const bf16x8_t*)(x2b + (rowb + rb * 16 + fr) * 2048 + c * 512 + s * 32 + 8 * fq);
        if (c > 0) __syncthreads();
#pragma unroll
        for (int i = 0; i < 12; ++i) { const int p = tid + 512 * i; const int hl = p >= 3072 ? 1 : 0, q = p - hl * 3072; const int row = q >> 6, pc = q & 63;
            *(LAS u32x4*)(lds + hl * WHL + row * WP + pc * 16) = wv[i]; }
        asm volatile("s_waitcnt lgkmcnt(0)" ::: "memory");
        __syncthreads();
#pragma unroll
        for (int s = 0; s < 16; ++s) {
#pragma unroll
            for (int ob = 0; ob < 3; ++ob) {
                const bf16x8_t wh = *(const LAS bf16x8_t*)(lds + (ob * 16 + fr) * WP + (s * 32 + 8 * fq) * 2), wl = *(const LAS bf16x8_t*)(lds + WHL + (ob * 16 + fr) * WP + (s * 32 + 8 * fq) * 2);
#pragma unroll
                for (int rb = 0; rb < 2; ++rb) {
                    acc[rb][ob] = __builtin_amdgcn_mfma_f32_16x16x32_bf16(wh, xv[rb][s], acc[rb][ob], 0, 0, 0);
                    acc[rb][ob] = __builtin_amdgcn_mfma_f32_16x16x32_bf16(wl, xv[rb][s], acc[rb][ob], 0, 0, 0);
                }
            }
        }
    }
    asm volatile("s_waitcnt lgkmcnt(0)" ::: "memory");
    __syncthreads();
    if (tid < 64) hist[tid] = 0u;
#pragma unroll
    for (int rb = 0; rb < 2; ++rb) { const float rs = row_rstd(stats, wave * 32 + rb * 16 + fr, 1e-6f);
#pragma unroll
        for (int ob = 0; ob < 3; ++ob) *(LAS f32x4*)(lg + (rb * 16 + fr) * 48 + ob * 16 + 4 * fq) = acc[rb][ob] * rs; }
    asm volatile("s_waitcnt lgkmcnt(0)" ::: "memory");
    __syncthreads();
    int ex0 = 0, ex1 = 0; float w0 = 0.f, w1 = 0.f; unsigned rk0 = 0, rk1 = 0;
    if (lane < 32) {
        const LAS float* lr = lg + lane * 48;
        float l4[4], le[32];
#pragma unroll
        for (int i = 0; i < 4; ++i) l4[i] = lr[i] + a.in[21][i];
#pragma unroll
        for (int i = 0; i < 32; ++i) le[i] = lr[4 + i] + a.in[23][i];
        int gs = 0; float gm = l4[0];
#pragma unroll
        for (int i = 1; i < 4; ++i) if (l4[i] > gm) { gm = l4[i]; gs = i; }
        float gsum = 0.f;
#pragma unroll
        for (int i = 0; i < 4; ++i) gsum += __expf(l4[i] - gm);
        const float gw = 1.f / gsum;
        float sl[8];
#pragma unroll
        for (int e = 0; e < 8; ++e) { sl[e] = le[e];
#pragma unroll
            for (int gq = 1; gq < 4; ++gq) if (gs == gq) sl[e] = le[gq * 8 + e]; }
        int i0 = 0; float v0 = sl[0];
#pragma unroll
        for (int e = 1; e < 8; ++e) if (sl[e] > v0) { v0 = sl[e]; i0 = e; }
        int i1 = -1; float v1 = -INFINITY;
#pragma unroll
        for (int e = 0; e < 8; ++e) if (e != i0 && sl[e] > v1) { v1 = sl[e]; i1 = e; }
        const float e1 = __expf(v1 - v0); w0 = gw / (1.f + e1); w1 = gw * e1 / (1.f + e1);
        ex0 = gs * 8 + i0; ex1 = gs * 8 + i1;
        rk0 = __hip_atomic_fetch_add(hist + ex0, 1u, __ATOMIC_RELAXED, __HIP_MEMORY_SCOPE_WORKGROUP); rk1 = __hip_atomic_fetch_add(hist + ex1, 1u, __ATOMIC_RELAXED, __HIP_MEMORY_SCOPE_WORKGROUP);
    }
    asm volatile("s_waitcnt lgkmcnt(0)" ::: "memory");
    __syncthreads();
    if (tid < 32) { const unsigned c = hist[tid]; hist[32 + tid] = c ? atomicAdd((unsigned*)(ws + WS_CTL) + tid, c) : 0u; }
    asm volatile("s_waitcnt vmcnt(0) lgkmcnt(0)" ::: "memory");
    __syncthreads();
    if (lane < 32) {
        int* ltok = (int*)(ws + WS_LTOK); float* lwp = (float*)(ws + WS_LW); float* lrs = (float*)(ws + WS_LRS);
        const int row = (int)rowb + lane; const float rs2 = row_rstd(stats, wave * 32 + lane, 1e-6f);
        const size_t p0 = (size_t)ex0 * T_ + hist[32 + ex0] + rk0, p1 = (size_t)ex1 * T_ + hist[32 + ex1] + rk1;
        ltok[p0] = row * 2 + 0; lwp[p0] = w0; lrs[p0] = rs2; ltok[p1] = row * 2 + 1; lwp[p1] = w1; lrs[p1] = rs2;
    }
    __syncthreads();
}
__device__ __forceinline__ void p3_chain(const Args& a, LAS unsigned char* lds, unsigned char* lds_raw, int panel, int wave, int lane, int tid) {
    OPAQUE_GLOBAL(ws, a.ws);
    bf16_t* wt = (bf16_t*)(ws + WS_WT);
    LAS float* stats = (LAS float*)(lds + STAT_OFF);
    bf16_t* R1 = (bf16_t*)(ws + WS_R1); const bf16_t* Yp = (const bf16_t*)(ws + WS_Y);
    bf16_t* QC = (bf16_t*)(ws + WS_QC); bf16_t* OC = (bf16_t*)(ws + WS_OC); const bf16_t* MKV = (const bf16_t*)(ws + WS_MKV);
    bf16_t* XB = (bf16_t*)a.out;
    pg8::PanelOrder S4{panel, 4, (panel >> 3) & 3}, S1{panel, 1, 0};
#ifndef REP_PHASE
#define REP_PHASE -1
#endif
#define RP3(k) for (int rp3_ = 0; rp3_ < ((REP_PHASE) == (k) ? 2 : 1); ++rp3_)
#define P3STAMP(i) do { if ((REP_PHASE) >= 90 && (REP_PHASE) < 100 && tid == 0) ((unsigned long long*)(ws + WS_CTL + 65536))[(16 + (i)) * 256 + blockIdx.x] = __builtin_amdgcn_s_memrealtime(); } while (0)
    P3STAMP(0);
    P3STAMP(1);
    RP3(41) {
    { pg8::Gemm g{Yp, wt + WT_A, 1024, 1024, 1024}; EpiGate2 E{(const unsigned char*)a.out, R1}; pg8::gemm_phase<EpiGate2, pg8::PanelOrder, true>(lds, g, S4, E); }
    wg_fence(); }
    P3STAMP(2);
    RP3(42) {
    { pg8::Gemm g{R1, wt + WT_O, 1024, 1024, 1024}; EpiRes<false> E{(const void*)a.in[0], XB, stats, nullptr, ((REP_PHASE) == 97 || (REP_PHASE) == 89) ? (unsigned long long*)(ws + WS_CTL + 65536) + 30 * 256 + blockIdx.x : nullptr}; pg8::gemm_phase<EpiRes<false>, pg8::PanelOrder, true>(lds, g, S4, E); }
    wg_fence(); }
    P3STAMP(3);
    RP3(43) {
    { pg8::Gemm g{XB, wt + WT_CQ, 2048, 1024, 1024}; EpiQ E{QC, 256, C2, stats}; pg8::gemm_phase<EpiQ, pg8::PanelOrder, true>(lds, g, S1, E); }
    wg_fence(); }
    P3STAMP(4);
    RP3(44) {
    { const int b = panel >> 4; const size_t r0 = (size_t)panel * 256;
      attn_body::cross_panel(QC + r0 * 256, 256, MKV + (size_t)b * 256 * 512, 512, MKV + (size_t)b * 256 * 512 + 256, 512, OC + r0 * 256, 256, (char*)lds_raw); }
    wg_fence(); }
    P3STAMP(5);
    RP3(45) {
    { pg8::Gemm g{OC, wt + WT_CO, 256, 256, 256}; EpiRes<true> E{(const void*)XB, XB + 1024, stats, (unsigned char*)R1, ((REP_PHASE) == 98 || (REP_PHASE) == 99) ? (unsigned long long*)(ws + WS_CTL + 65536) + 30 * 256 + blockIdx.x : nullptr};   pg8::gemm_phase<EpiRes<true>, pg8::PanelOrder, true>(lds, g, S4, E); }
    wg_fence(); }
    P3STAMP(6);
    c6_route(a, ws, lds, stats, panel, wave, lane, tid);
    P3STAMP(7);
}
constexpr int TAB_OFF = MISC_OFF;
template <bool GATHER_> struct GroupOrder {
    static constexpr bool GATHER = GATHER_;
    const LAS unsigned* tab; int NTl, G, c; const int* ltok; const unsigned* counts;
    __device__ bool next(int i, pg8::Unit& u) const {
        const int L = i * G + c; if (L >= NTl * 4) return false;
        const int ct = L & 3, t = L >> 2;     const unsigned w = (unsigned)__builtin_amdgcn_readfirstlane((int)tab[t]);
        u.e = (int)(w & 31u); u.rt = (int)((w >> 5) & 0x7ffu); u.pm = (int)(w >> 16); u.pn = u.e * 4 + ct; u.i = i; return true;
    }
    __device__ __forceinline__ unsigned arow(const pg8::Unit& u, int r) const {
        const unsigned idx = (unsigned)(u.rt * 256 + r); const unsigned cnt = counts[u.e];
        return idx < cnt ? (unsigned)(ltok[(size_t)u.e * T_ + idx] >> 1) : 0u;
    }
};
__device__ __forceinline__ int build_tile_table(const unsigned* counts, LAS unsigned* tab, int tid) {
    if (tid == 0) {
        unsigned nt = 0;
        for (int e = 0; e < 32; ++e) { const unsigned ntl = (counts[e] + 255u) >> 8;
            for (unsigned rt = 0; rt < ntl; ++rt) { tab[nt] = (unsigned)e | (rt << 5) | (nt << 16); ++nt; } }
        tab[600] = nt;
    }
    asm volatile("s_waitcnt vmcnt(0) lgkmcnt(0)" ::: "memory");
    __syncthreads();
    return __builtin_amdgcn_readfirstlane((int)tab[600]);
}
template <bool E2M> __device__ __forceinline__ void stage_unit_meta(LAS float* meta, const LAS unsigned* tab, int NTl, int G, int c, const unsigned* counts, const int* ltok, const float* lw, const float* lrs, int tid) {
    const int r = tid & 255;
#pragma unroll 1
    for (int i = (tid >> 8); i < 8; i += 2) { const int L = i * G + c; if (L < NTl * 4) { const unsigned w = tab[L >> 2]; const int e = (int)(w & 31u), rt = (int)((w >> 5) & 0x7ffu);
            const unsigned idx = (unsigned)(rt * 256 + r); const bool valid = idx < counts[e]; const size_t li = (size_t)e * T_ + idx;
            if (E2M) { meta[(i * 256 + r) * 2] = __int_as_float(valid ? ltok[li] : -1); meta[(i * 256 + r) * 2 + 1] = valid ? lw[li] * (1.f / WSCALE) : 0.f; }
            else meta[i * 256 + r] = valid ? lrs[li] * (1.f / WSCALE) : 0.f; } }
    asm volatile("s_waitcnt vmcnt(0) lgkmcnt(0)" ::: "memory");
    __syncthreads();
}
struct EpiE1 {
    static constexpr bool PERM = true, HAS_MID = false, HAS_PF = false, HAS_PROF = false;
    unsigned char* H; const float* lrs; const unsigned* counts;
    const LAS float* meta;
    __device__ __forceinline__ void operator()(const f32x4 (&acc)[2][2][4][2], const pg8::Unit& u, int wr, int wc, int fr_, int fq_) const {
        int fr = fr_; asm volatile("" : "+v"(fr));
        const int row0 = u.pm * 256 + wr * 64 + fr; const int col0 = (u.pn & 3) * 128 + wc * 32 + 8 * fq_;
        const unsigned cnt = counts[u.e]; float rs[8];
        if (u.i < 8) {
#pragma unroll
            for (int g = 0; g < 8; ++g) rs[g] = meta[u.i * 256 + (g >> 2) * 128 + wr * 64 + (g & 3) * 16 + fr];
        } else {
#pragma unroll
            for (int g = 0; g < 8; ++g) { const unsigned idx = (unsigned)(u.rt * 256 + (g >> 2) * 128 + wr * 64 + (g & 3) * 16 + fr); rs[g] = idx < cnt ? lrs[(size_t)u.e * T_ + idx] * (1.f / WSCALE) : 0.f; }
        }
#pragma unroll
        for (int ai = 0; ai < 2; ++ai)
#pragma unroll
            for (int m = 0; m < 4; ++m) { const float s = rs[ai * 4 + m];
                const f32x4 g0 = acc[ai][0][m][0] * s, g1 = acc[ai][0][m][1] * s, u0 = acc[ai][1][m][0] * s, u1 = acc[ai][1][m][1] * s;
                float r[8];
#pragma unroll
                for (int q = 0; q < 4; ++q) { r[q] = g0[q] * __builtin_amdgcn_rcpf(1.f + __expf(-g0[q])) * u0[q]; r[4 + q] = g1[q] * __builtin_amdgcn_rcpf(1.f + __expf(-g1[q])) * u1[q]; }
                unsigned q0 = 0u, q1 = 0u;
                q0 = __builtin_amdgcn_cvt_pk_fp8_f32(CL8(r[0]), CL8(r[1]), q0, false); q0 = __builtin_amdgcn_cvt_pk_fp8_f32(CL8(r[2]), CL8(r[3]), q0, true);
                q1 = __builtin_amdgcn_cvt_pk_fp8_f32(CL8(r[4]), CL8(r[5]), q1, false); q1 = __builtin_amdgcn_cvt_pk_fp8_f32(CL8(r[6]), CL8(r[7]), q1, true);
                *(uint2*)(H + (size_t)(row0 + ai * 128 + m * 16) * 512 + col0) = make_uint2(q0, q1); }
    }
};
constexpr float YSCALE = 16.f;
struct EpiE2 {
    static constexpr bool PERM = true, HAS_MID = false, HAS_PF = false, HAS_PROF = true;
    unsigned char* ys; const int* ltok; const float* lw; const unsigned* counts;
    unsigned long long* prof; const LAS float* meta;
    __device__ __forceinline__ void operator()(const f32x4 (&acc)[2][2][4][2], const pg8::Unit& u, int wr, int wc, int fr_, int fq_) const {
        const unsigned long long t0_ = prof ? __builtin_amdgcn_s_memrealtime() : 0ull;
        int fr = fr_; asm volatile("" : "+v"(fr));
        const unsigned cnt = counts[u.e]; const int col0 = (u.pn & 3) * 256 + wc * 32 + 8 * fq_;
        int tk[8]; float wg[8];
        if (u.i < 8) {
#pragma unroll
            for (int g = 0; g < 8; ++g) { const int rl = (g >> 2) * 128 + wr * 64 + (g & 3) * 16 + fr; tk[g] = __float_as_int(meta[(u.i * 256 + rl) * 2]); wg[g] = meta[(u.i * 256 + rl) * 2 + 1] * YSCALE; }
        } else {
#pragma unroll
            for (int g = 0; g < 8; ++g) { const unsigned idx = (unsigned)(u.rt * 256 + (g >> 2) * 128 + wr * 64 + (g & 3) * 16 + fr); const size_t li = (size_t)u.e * T_ + idx;
                tk[g] = idx < cnt ? ltok[li] : -1; wg[g] = idx < cnt ? lw[li] * (YSCALE / WSCALE) : 0.f; }
        }
#pragma unroll
        for (int ai = 0; ai < 2; ++ai)
#pragma unroll
            for (int m = 0; m < 4; ++m) {
                const int tok2 = tk[ai * 4 + m]; const float wgt = wg[ai * 4 + m];
                if (tok2 >= 0) {
                    unsigned char* rowp = ys + (size_t)tok2 * 1024 + col0;
#pragma unroll
                    for (int bj = 0; bj < 2; ++bj) { const f32x4 v0 = acc[ai][bj][m][0] * wgt, v1 = acc[ai][bj][m][1] * wgt;
                        unsigned q0 = 0u, q1 = 0u;
                        q0 = __builtin_amdgcn_cvt_pk_fp8_f32(CL8(v0[0]), CL8(v0[1]), q0, false); q0 = __builtin_amdgcn_cvt_pk_fp8_f32(CL8(v0[2]), CL8(v0[3]), q0, true);
                        q1 = __builtin_amdgcn_cvt_pk_fp8_f32(CL8(v1[0]), CL8(v1[1]), q1, false); q1 = __builtin_amdgcn_cvt_pk_fp8_f32(CL8(v1[2]), CL8(v1[3]), q1, true);
                        *(uint2*)(rowp + bj * 128) = make_uint2(q0, q1); }
                }
            }
        if (prof && threadIdx.x == 0) atomicAdd(prof, __builtin_amdgcn_s_memrealtime() - t0_);
    }
};
__device__ __forceinline__ void p6_final(const Args& a, unsigned char* ws, int gw, int NGW, int lane_) {
    int lane = lane_; asm volatile("" : "+v"(lane));
    float* xo = a.out; const bf16_t* x2b = (const bf16_t*)a.out + 1024; const unsigned char* ys = ws + WS_YS; const float* g = a.in[27];
    typedef float f32x2_ __attribute__((ext_vector_type(2)));
    f32x4 gg[4];
#pragma unroll
    for (int j = 0; j < 4; ++j) gg[j] = *(const f32x4*)(g + (lane + 64 * j) * 4);
    for (int base = gw; base < T_; base += 4 * NGW) {
        uint2 xq[4][4]; unsigned pq[4][4], qq[4][4];
#pragma unroll
        for (int r4 = 0; r4 < 4; ++r4) { const int row = base + r4 * NGW; if (row < T_) {
#pragma unroll
            for (int j = 0; j < 4; ++j) { const int c = (lane + 64 * j) * 4;
                xq[r4][j] = *(const uint2*)(x2b + (size_t)row * 2048 + c);
                pq[r4][j] = *(const unsigned*)(ys + (size_t)(row * 2) * D_ + c); qq[r4][j] = *(const unsigned*)(ys + (size_t)(row * 2 + 1) * D_ + c); } } }
#pragma unroll
        for (int r4 = 0; r4 < 4; ++r4) { const int row = base + r4 * NGW; if (row < T_) {
            f32x4* xr = (f32x4*)(xo + (size_t)row * D_);
            f32x4 v[4]; float ss = 0.f;
#pragma unroll
            for (int j = 0; j < 4; ++j) { const uint2 x = xq[r4][j]; const unsigned p = pq[r4][j], q2 = qq[r4][j];
                const f32x2_ p0 = __builtin_amdgcn_cvt_pk_f32_fp8(p, false), p1 = __builtin_amdgcn_cvt_pk_f32_fp8(p, true), q0 = __builtin_amdgcn_cvt_pk_f32_fp8(q2, false), q1 = __builtin_amdgcn_cvt_pk_f32_fp8(q2, true);
                v[j][0] = bflo(x.x) + (p0[0] + q0[0]) * (1.f / YSCALE); v[j][1] = bfhi(x.x) + (p0[1] + q0[1]) * (1.f / YSCALE);
                v[j][2] = bflo(x.y) + (p1[0] + q1[0]) * (1.f / YSCALE); v[j][3] = bfhi(x.y) + (p1[1] + q1[1]) * (1.f / YSCALE);
                ss += v[j][0] * v[j][0] + v[j][1] * v[j][1] + v[j][2] * v[j][2] + v[j][3] * v[j][3]; }
            ss = wave_sum_l(ss, lane);
            const float rstd = rsqrtf(ss * (1.f / D_) + 1e-6f);
#pragma unroll
            for (int j = 0; j < 4; ++j) xr[lane + 64 * j] = v[j] * rstd * gg[j];
        } }
    }
}
#define XB_TMO      128
#define XB_XCNT(j)  (256  + 64 * (j))
#define XB_XSUB(j)  (1280 + 64 * (j))
#define XB_XGEN(j)  (2304 + 64 * (j))
#define XB_TOP      3328
#define XB_TOPGEN   3392
#define XCD_BAR_WORDS 3456
#define XB_SPIN_CAP (1u << 18)

__device__ __forceinline__ unsigned xb_ld(unsigned* p)              { return __hip_atomic_load(p, __ATOMIC_RELAXED, __HIP_MEMORY_SCOPE_AGENT); }
__device__ __forceinline__ unsigned xb_add(unsigned* p, unsigned v) { return __hip_atomic_fetch_add(p, v, __ATOMIC_RELAXED, __HIP_MEMORY_SCOPE_AGENT); }
__device__ __forceinline__ unsigned xb_xcc_id() { return (unsigned)__builtin_amdgcn_s_getreg((3 << 11) | 20) & 0xFu; }
#define XB_SPIN(cond, bar) do { unsigned _sp = 0; while (cond) { __builtin_amdgcn_s_sleep(1); \
    if ((++_sp & 255u) == 0u) { if (xb_ld(&(bar)[XB_TMO])) break; if (_sp > XB_SPIN_CAP) { atomicAdd(&(bar)[XB_TMO], 1u); break; } } } } while (0)

struct XcdBarrier {
    unsigned* bar; unsigned x;
    volatile LAS unsigned* st;
};

__device__ __forceinline__ XcdBarrier xcd_barrier_post(unsigned* bar, volatile LAS unsigned* st) {
    XcdBarrier b; b.bar = bar; b.x = xb_xcc_id(); b.st = st;
    if (threadIdx.x == 0) (void)xb_add(&bar[XB_XCNT(b.x)], 1u);
    return b;
}
__device__ __forceinline__ void xcd_barrier_complete(unsigned* bar, unsigned x, unsigned& nloc, unsigned& nx) {
    const unsigned G = gridDim.x * gridDim.y * gridDim.z;
    unsigned sum, cnt, mine, sp = 0u;
    for (;;) {
        sum = 0u; cnt = 0u; mine = 0u;
#pragma unroll
        for (unsigned j = 0; j < 16; ++j) { const unsigned c = xb_ld(&bar[XB_XCNT(j)]); sum += c; cnt += (c > 0u) ? 1u : 0u; mine = (j == x) ? c : mine; }
        if (sum == G) break;
        __builtin_amdgcn_s_sleep(1);
        if ((++sp & 255u) == 0u) { if (xb_ld(&bar[XB_TMO])) break; if (sp > XB_SPIN_CAP) { atomicAdd(&bar[XB_TMO], 1u); break; } }
    }
    nloc = mine > 0u ? mine : 1u; nx = cnt > 0u ? cnt : 1u;
}

__device__ __forceinline__ void xcd_barrier(const XcdBarrier& b) {
    asm volatile("s_waitcnt vmcnt(0)" ::: "memory");
    __syncthreads();
    if (threadIdx.x == 0) {
        unsigned* bar = b.bar;
        __builtin_amdgcn_s_waitcnt(0);
        unsigned nloc = b.st[0], nx = b.st[1];
        if (nloc == 0u) { xcd_barrier_complete(bar, b.x, nloc, nx); b.st[0] = nloc; b.st[1] = nx; }
        const unsigned old = xb_add(&bar[XB_XSUB(b.x)], 1u);
        const unsigned gen = old / nloc;
        if (old + 1u == (gen + 1u) * nloc) {
            __builtin_amdgcn_fence(__ATOMIC_RELEASE, "agent");
            asm volatile("s_waitcnt vmcnt(0)" ::: "memory");
            const unsigned og = xb_add(&bar[XB_TOP], 1u);
            const unsigned tg = og / nx;
            if (og + 1u == (tg + 1u) * nx) xb_add(&bar[XB_TOPGEN], 1u);
            else XB_SPIN(xb_ld(&bar[XB_TOPGEN]) == tg, bar);
            __builtin_amdgcn_fence(__ATOMIC_ACQUIRE, "agent");
            xb_add(&bar[XB_XGEN(b.x)], 1u);
            asm volatile("s_waitcnt vmcnt(0)" ::: "memory");
        } else {
            XB_SPIN(xb_ld(&bar[XB_XGEN(b.x)]) == gen, bar);
            __builtin_amdgcn_fence(__ATOMIC_ACQUIRE, "agent");
            asm volatile("s_waitcnt vmcnt(0)" ::: "memory");
        }
    }
    __syncthreads();
}

template <class Work> __device__ __forceinline__ void xcd_barrier_work(const XcdBarrier& b, volatile LAS unsigned* sw, Work&& work) {
    asm volatile("s_waitcnt vmcnt(0)" ::: "memory");
    __syncthreads();
    if (threadIdx.x == 0) {
        unsigned* bar = b.bar;
        __builtin_amdgcn_s_waitcnt(0);
        unsigned nloc = b.st[0], nx = b.st[1];
        if (nloc == 0u) { xcd_barrier_complete(bar, b.x, nloc, nx); b.st[0] = nloc; b.st[1] = nx; }
        const unsigned old = xb_add(&bar[XB_XSUB(b.x)], 1u);
        const unsigned gen = old / nloc;
        sw[0] = (old + 1u == (gen + 1u) * nloc) ? 1u : 0u; sw[1] = gen; sw[2] = nx;
    }
    __syncthreads();
    const bool leader = sw[0] != 0u; const unsigned gen = sw[1];
    if (leader) {
        if (threadIdx.x == 0) {
            unsigned* bar = b.bar; const unsigned nx = sw[2];
            __builtin_amdgcn_fence(__ATOMIC_RELEASE, "agent");
            asm volatile("s_waitcnt vmcnt(0)" ::: "memory");
            const unsigned og = xb_add(&bar[XB_TOP], 1u);
            const unsigned tg = og / nx;
            if (og + 1u == (tg + 1u) * nx) xb_add(&bar[XB_TOPGEN], 1u);
            else XB_SPIN(xb_ld(&bar[XB_TOPGEN]) == tg, bar);
            __builtin_amdgcn_fence(__ATOMIC_ACQUIRE, "agent");
            xb_add(&bar[XB_XGEN(b.x)], 1u);
            asm volatile("s_waitcnt vmcnt(0)" ::: "memory");
        }
    } else {
        for (;;) {
            if (threadIdx.x == 0) sw[3] = (xb_ld(&b.bar[XB_XGEN(b.x)]) != gen) ? 1u : 0u;
            __syncthreads();
            const bool done = sw[3] != 0u;
            __syncthreads();
            if (done) break;
            if (!work()) {
                if (threadIdx.x == 0) { unsigned* bar = b.bar; XB_SPIN(xb_ld(&bar[XB_XGEN(b.x)]) == gen, bar); }
                break;
            }
        }
        if (threadIdx.x == 0) { __builtin_amdgcn_fence(__ATOMIC_ACQUIRE, "agent"); asm volatile("s_waitcnt vmcnt(0)" ::: "memory"); }
    }
    __syncthreads();
}
__global__ void __launch_bounds__(NWAVES * 64, 2) mk_fwd(Args args_unused) {
    __builtin_assume(__builtin_amdgcn_workitem_id_y() == 0); __builtin_assume(__builtin_amdgcn_workitem_id_z() == 0);
    const Args& args = *(const Args*)(const __attribute__((address_space(4))) void*)__builtin_amdgcn_kernarg_segment_ptr();
    extern __shared__ __attribute__((aligned(16))) unsigned char lds_raw[];
    LAS unsigned char* lds = (LAS unsigned char*)lds_raw;
    const int tid = threadIdx.x, lane = tid & 63, wave = __builtin_amdgcn_readfirstlane(tid >> 6);
    const int G = gridDim.x; const int bx = blockIdx.x; const int vcu = (G % 8 == 0) ? (bx % 8) * (G / 8) + bx / 8 : bx;
    unsigned char* ws = args.ws;
    const int lo = args.ph_lo, hi = args.ph_hi;
    volatile LAS unsigned* xst = (volatile LAS unsigned*)(lds + MISC_OFF + 3072);
    if (tid < 2) xst[tid] = 0u;
    __syncthreads();
    XcdBarrier xbar = xcd_barrier_post((unsigned*)(ws + WS_CTL + 4096), xst);
#ifndef REP_PHASE
#define REP_PHASE -1
#endif
#define IN(k) (lo <= (k) && (k) < hi)
#define REPS(k) for (int rp_ = 0; rp_ < ((REP_PHASE) == (k) ? 2 : 1); ++rp_)
#define PROBE_ON ((REP_PHASE) >= 60 && (REP_PHASE) < 100)
#define STAMP(k) do { if (PROBE_ON) { __syncthreads(); if (tid == 0) ((unsigned long long*)(ws + WS_CTL + 65536))[((k) + 1) * 256 + bx] = __builtin_amdgcn_s_memrealtime(); } } while (0)
#define GRID_SYNC(k) do { STAMP(k); if (args.coop && IN(k) && IN((k) + 1)) { if ((k) == 4) cg::this_grid().sync(); else if ((k) <= 2) xcd_barrier_work(xbar, (volatile LAS unsigned*)(lds + MISC_OFF + 3072 + 32), [&]() { return slab_take_one(args, lds, tid); }); else { xcd_barrier(xbar); if ((REP_PHASE) == 50) xcd_barrier(xbar); } } } while (0)
    bf16_t* wt = (bf16_t*)(ws + WS_WT);
#ifndef SKIP_P0
    if (PROBE_ON && tid == 0) ((unsigned long long*)(ws + WS_CTL + 65536))[bx] = __builtin_amdgcn_s_memrealtime();
    if (PROBE_ON && tid == 0) { ((unsigned long long*)(ws + WS_CTL + 65536))[30 * 256 + bx] = 0ull; ((unsigned long long*)(ws + WS_CTL + 65536))[31 * 256 + bx] = 0ull; }
    if (IN(0)) REPS(0) { p0_prologue(args, lds, vcu, G, wave, lane, tid); __syncthreads(); }
#endif
    GRID_SYNC(0);
#ifndef SKIP_P1
    if (IN(1)) REPS(1) {
        if (rp_ == 0) for (int bh = bx; bh < B_ * 8; bh += G) { p1_cumsum((float*)(ws + WS_LOGF), (bf16_t*)(ws + WS_KAUG), bh, (LAS float*)lds, tid); }
        __syncthreads();
        {
            EpiIn E{(bf16_t*)(ws + WS_FQ), (bf16_t*)(ws + WS_FK), (bf16_t*)(ws + WS_FV), (bf16_t*)(ws + WS_DQ), (bf16_t*)(ws + WS_DK), (bf16_t*)(ws + WS_DV), (bf16_t*)args.out, (const float*)(ws + WS_ROPE)};
            { pg8::Gemm g{(const bf16_t*)(ws + WS_R1), wt + WT_IN, 1024, 1024, 1024}; pg8::StaticOrder S; S.init(T_, 1536, G, bx); S.mode = 1;
              pg8::gemm_phase<EpiIn, pg8::StaticOrder, true>(lds, g, S, E); }
            { pg8::Gemm g{(const bf16_t*)(ws + WS_XN8), (const bf16_t*)(ws + WS_WIN8), 512, 512, 512}; pg8::StaticOrder S; S.init(T_, 3584, G, bx); S.mode = 2;
              pg8::gemm_phase<EpiIn, pg8::StaticOrder, true, true>(lds, g, S, E); }
        }
        {
            pg8::Gemm g{(const bf16_t*)(ws + WS_MEMN), wt + WT_CKV, 1024, 1024, 1024}; pg8::StaticOrder S; S.init(B_ * MEML, 512, G, bx);
            EpiBf E{(bf16_t*)(ws + WS_MKV), 512, 1.f};
            pg8::gemm_phase<EpiBf, pg8::StaticOrder, true>(lds, g, S, E);
        }
    }
#endif
    GRID_SYNC(1);
    if (IN(2)) REPS(2) {
        char* shm = (char*)lds_raw;
        const bf16_t *FQ = (const bf16_t*)(ws + WS_FQ), *FK = (const bf16_t*)(ws + WS_FK), *FV = (const bf16_t*)(ws + WS_FV), *DQ = (const bf16_t*)(ws + WS_DQ), *DK = (const bf16_t*)(ws + WS_DK), *DVp = (const bf16_t*)(ws + WS_DV);
        bf16_t *Yp = (bf16_t*)(ws + WS_Y), *ODp = (bf16_t*)(ws + WS_OD); const bf16_t* KA = (const bf16_t*)(ws + WS_KAUG);
        int lam_s;
        { int l2_ = threadIdx.x; asm volatile("" : "+v"(l2_)); const int ln_ = l2_ & 63;
          const float lam_ = __expf(wave_sum_l(args.in[9][ln_] * args.in[10][ln_], ln_)) - __expf(wave_sum_l(args.in[11][ln_] * args.in[12][ln_], ln_)) + 0.2f;
          lam_s = __builtin_amdgcn_readfirstlane(__float_as_int(lam_)); }
        for (int it = vcu; it < 256; it += G) {
            attn_body::bf16x8 qrs[4]; bool primed = false;
#pragma nounroll
            for (int j = 0; j < 8; ++j) {
                const int seq = (it >> 3) * 4 + (j >> 1), s = it & 7;
                const int qb = (j & 1) ? 15 - s : s; const int NT = 4 * (qb + 1);
                const int b = seq >> 3, h = seq & 7; const size_t r0 = (size_t)b * S_;
                const int jn = j + 1; const int seqn = (it >> 3) * 4 + (jn >> 1), sn = s;
                const int qbn = (jn & 1) ? 15 - sn : sn; const int bn = seqn >> 3, hn = seqn & 7; const size_t r0n = (size_t)bn * S_; const bool hasn = jn < 8;
                attn_body::attn_unit<true, true, 40>(FQ + (r0 + qb * 256) * 512 + h * 64, 512, FK + r0 * 512 + h * 64, 512, FV + r0 * 512 + h * 64, 512,
                                                     Yp + (r0 + qb * 256) * 1024 + h * 64, 1024, KA + ((size_t)seq * S_) * 4, NT, shm,
                                                     qrs, primed, j & 1, hasn ? FQ + (r0n + qbn * 256) * 512 + hn * 64 : nullptr, FK + r0n * 512 + hn * 64, KA + ((size_t)seqn * S_) * 4, 4 * (qbn + 1));
                primed = hasn;
            }
            primed = false;
#pragma nounroll
            for (int j = 0; j < 8; ++j) {
                const int bhq = (it >> 3) * 2 + (j >> 2); const int b = bhq >> 2, head = bhq & 3, s = it & 7;
                const int uq = j & 3; const int qb = (uq >> 1) ? 15 - s : s; const int hh = head * 2 + (uq & 1); const int NT = 4 * (qb + 1);
                const size_t r0 = (size_t)b * S_;
                const int jn = j + 1; const int bhqn = (it >> 3) * 2 + (jn >> 2); const int bn = bhqn >> 2, headn = bhqn & 3, sn = s;
                const int uqn = jn & 3; const int qbn = (uqn >> 1) ? 15 - sn : sn; const int hhn = headn * 2 + (uqn & 1); const size_t r0n = (size_t)bn * S_; const bool hasn = jn < 8;
                attn_body::attn_unit128<8>(DQ + (r0 + qb * 256) * 512 + hh * 64, 512, DK + r0 * 512 + hh * 64, 512, DVp + r0 * 512 + head * 128, 512,
                                           Yp + (r0 + qb * 256) * 1024 + 512 + head * 128, 1024, nullptr, NT, shm,
                                           qrs, primed, 0, hasn ? DQ + (r0n + qbn * 256) * 512 + hhn * 64 : nullptr, DK + r0n * 512 + hhn * 64, nullptr, 0,
                                           (uq & 1) ? 2 : 1, __int_as_float(lam_s), args.in[13]);
                primed = hasn;
            }
        }
    }
    GRID_SYNC(2);
    if (IN(3)) {
#ifdef P3_STAGGER
        if (bx & 1) { for (int i_ = 0; i_ < P3_STAGGER; ++i_) __builtin_amdgcn_s_sleep(127); }
#endif
        for (int panel = vcu; panel < 256; panel += G) { int l3_ = threadIdx.x; asm volatile("" : "+v"(l3_)); p3_chain(args, lds, lds_raw, panel, wave, l3_ & 63, l3_); }
        while (slab_take_one(args, lds, tid)) { }
    }
    GRID_SYNC(3);
    if (IN(4)) REPS(4) {
        OPAQUE_GLOBAL(wsq, args.ws);
        const unsigned* counts = (const unsigned*)(wsq + WS_CTL); LAS unsigned* tab = (LAS unsigned*)(lds + TAB_OFF);
        const int NTl = build_tile_table(counts, tab, tid);
        pg8::Gemm g{(const bf16_t*)(wsq + WS_R1), (const bf16_t*)(wsq + WS_WT) + WT_E1, 1024, 512, 512};
        GroupOrder<true> S{tab, NTl, G, vcu, (const int*)(wsq + WS_LTOK), counts};
        stage_unit_meta<false>((LAS float*)(lds + STAT_OFF), tab, NTl, G, vcu, counts, (const int*)(wsq + WS_LTOK), (const float*)(wsq + WS_LW), (const float*)(wsq + WS_LRS), tid);
        EpiE1 E{(unsigned char*)(wsq + WS_H), (const float*)(wsq + WS_LRS), counts, (const LAS float*)(lds + STAT_OFF)};
        pg8::gemm_phase<EpiE1, GroupOrder<true>, true, true>(lds, g, S, E);
    }
    GRID_SYNC(4);
    if (IN(5)) REPS(5) {
        OPAQUE_GLOBAL(wsq, args.ws);
        const unsigned* counts = (const unsigned*)(wsq + WS_CTL); LAS unsigned* tab = (LAS unsigned*)(lds + TAB_OFF);
        const int NTl = build_tile_table(counts, tab, tid);
        pg8::Gemm g{(const bf16_t*)(wsq + WS_H), (const bf16_t*)(wsq + WS_WT) + WT_E2, 256, 256, 256};
        GroupOrder<false> S{tab, NTl, G, vcu, (const int*)(wsq + WS_LTOK), counts};
        stage_unit_meta<true>((LAS float*)(lds + STAT_OFF), tab, NTl, G, vcu, counts, (const int*)(wsq + WS_LTOK), (const float*)(wsq + WS_LW), (const float*)(wsq + WS_LRS), tid);
        EpiE2 E{(unsigned char*)(wsq + WS_YS), (const int*)(wsq + WS_LTOK), (const float*)(wsq + WS_LW), counts, ((REP_PHASE) == 78 || (REP_PHASE) == 79) ? (unsigned long long*)(wsq + WS_CTL + 65536) + 30 * 256 + blockIdx.x : nullptr, (const LAS float*)(lds + STAT_OFF)};
        pg8::gemm_phase<EpiE2, GroupOrder<false>, true, true>(lds, g, S, E);
    }
    GRID_SYNC(5);
    if (IN(6)) { OPAQUE_GLOBAL(wsq, args.ws); int l6_ = threadIdx.x; asm volatile("" : "+v"(l6_)); p6_final(args, wsq, vcu * NWAVES + wave, G * NWAVES, l6_ & 63); }
    if (PROBE_ON) {
        STAMP(6); xcd_barrier(xbar);
        if (bx == 0 && tid == 0) {
            const unsigned long long* ts = (const unsigned long long*)(ws + WS_CTL + 65536);
            const int ph = ((REP_PHASE) - 70) % 10; const bool dur = (REP_PHASE) >= 80;
            unsigned long long mx = 0ull, mn = ~0ull, pmx = 0ull;
            for (int i = 0; i < G; ++i) { const unsigned long long v = __hip_atomic_load(ts + (ph + 1) * 256 + i, __ATOMIC_RELAXED, __HIP_MEMORY_SCOPE_AGENT), p = __hip_atomic_load(ts + ph * 256 + i, __ATOMIC_RELAXED, __HIP_MEMORY_SCOPE_AGENT);
                mx = v > mx ? v : mx; mn = v < mn ? v : mn; pmx = p > pmx ? p : pmx; }
            unsigned long long wait = dur ? 4ull * (mx - pmx) : 10ull * (mx - mn);
            if ((REP_PHASE) == 78 || (REP_PHASE) == 79) { unsigned long long acc_ = 0ull; const int rw = (REP_PHASE) == 78 ? 30 : 31; for (int i = 0; i < G; ++i) acc_ += __hip_atomic_load(ts + rw * 256 + i, __ATOMIC_RELAXED, __HIP_MEMORY_SCOPE_AGENT); wait = 4ull * (acc_ / (unsigned long long)G); }
            else if ((REP_PHASE) >= 60 && (REP_PHASE) < 70) { const int si = (REP_PHASE) - 60; unsigned long long acc_ = 0ull;
                for (int i = 0; i < G; ++i) acc_ += __hip_atomic_load(ts + (17 + si) * 256 + i, __ATOMIC_RELAXED, __HIP_MEMORY_SCOPE_AGENT) - __hip_atomic_load(ts + (16 + si) * 256 + i, __ATOMIC_RELAXED, __HIP_MEMORY_SCOPE_AGENT);
                wait = 4ull * (acc_ / (unsigned long long)G); }
            else if ((REP_PHASE) == 99 || (REP_PHASE) == 89) { unsigned long long acc_ = 0ull; for (int i = 0; i < G; ++i) acc_ += __hip_atomic_load(ts + 31 * 256 + i, __ATOMIC_RELAXED, __HIP_MEMORY_SCOPE_AGENT); wait = 4ull * (acc_ / (unsigned long long)G); }
            else if ((REP_PHASE) == 97 || (REP_PHASE) == 98) { unsigned long long acc_ = 0ull; for (int i = 0; i < G; ++i) acc_ += __hip_atomic_load(ts + 30 * 256 + i, __ATOMIC_RELAXED, __HIP_MEMORY_SCOPE_AGENT); wait = 4ull * (acc_ / (unsigned long long)G); }
            else if ((REP_PHASE) >= 90) { const int si = (REP_PHASE) - 90; unsigned long long acc_ = 0ull;
                for (int i = 0; i < G; ++i) acc_ += __hip_atomic_load(ts + (17 + si) * 256 + i, __ATOMIC_RELAXED, __HIP_MEMORY_SCOPE_AGENT) - __hip_atomic_load(ts + (16 + si) * 256 + i, __ATOMIC_RELAXED, __HIP_MEMORY_SCOPE_AGENT);
                wait = 4ull * (acc_ / (unsigned long long)G); }
            const unsigned long long t0 = __builtin_amdgcn_s_memrealtime();
            while (__builtin_amdgcn_s_memrealtime() - t0 < wait) __builtin_amdgcn_s_sleep(8);
        }
    }
#undef IN
#undef GRID_SYNC
}
extern "C" void kernel_launch(void* const* d_in, const int* in_sizes, int n_in, void* d_out, int out_size, void* d_ws, size_t ws_size, hipStream_t stream) {
    static int grid = 0;
    if (grid == 0) {
        int dev = 0, cus = 0, per_cu = 0; (void)hipGetDevice(&dev); (void)hipDeviceGetAttribute(&cus, hipDeviceAttributeMultiprocessorCount, dev);
        (void)hipFuncSetAttribute((const void*)mk_fwd, hipFuncAttributeMaxDynamicSharedMemorySize, LDS_BYTES);
        if (hipOccupancyMaxActiveBlocksPerMultiprocessor(&per_cu, (const void*)mk_fwd, NWAVES * 64, LDS_BYTES) != hipSuccess || per_cu < 1) per_cu = 1;
        (void)hipGetLastError();
        if (cus <= 0) cus = 256;
        grid = cus * (per_cu > 1 ? 1 : per_cu);
        if (grid > 256) grid = 256;
    }
    unsigned char* ws = (unsigned char*)d_ws;
    (void)hipMemsetAsync(ws + WS_CTL, 0, 32768, stream);
    Args a{}; for (int i = 0; i < 28; ++i) a.in[i] = (const float*)d_in[i]; a.out = (float*)d_out; a.ws = ws; a.coop = 1; a.ph_lo = 0; a.ph_hi = 7; a.pad = 0;
    void* kargs[] = {&a};
    hipError_t e = hipLaunchCooperativeKernel((const void*)mk_fwd, dim3(grid), dim3(NWAVES * 64), kargs, LDS_BYTES, stream);
    if (e != hipSuccess) fprintf(stderr, "cooperative launch failed: %s (grid %d)\n", hipGetErrorString(e), grid);
}
```
